# Optimizing an MI355X kernel written in HIP

```python
import jax
import jax.numpy as jnp
from jax import lax
import numpy as np

D_MODEL = 1024
BATCH = 8
SEQ = 4096
DEPTH = 2

GRID_W = 64
CTX_LEN = 256
N_RET_HEADS = 4
RET_HEAD_DIM = 128
N_GLA_HEADS = 4
GLA_KEY_DIM = 64
GLA_VAL_DIM = 128
GLA_GATE_RANK = 16
GLA_GATE_NORM = 16.0
D_FF = 4 * D_MODEL
CHUNK = 64
ROPE_BASE = 10000.0
LN2 = 0.6931471805599453
EPS = 1e-6

RET_W = N_RET_HEADS * RET_HEAD_DIM
GLA_K = N_GLA_HEADS * GLA_KEY_DIM
GLA_V = N_GLA_HEADS * GLA_VAL_DIM
MIX_W = RET_W + GLA_V
IN_SPLITS = (RET_W, RET_W, RET_W, RET_W, GLA_K, GLA_K, GLA_V, GLA_V, GLA_GATE_RANK, GLA_GATE_RANK)
IN_W = 4 * RET_W + 2 * GLA_K + 2 * GLA_V + 2 * GLA_GATE_RANK

kernel_name = 'hybrid_retention_gla_dit_block'


def rmsnorm(x, g):
    xf = x.astype(jnp.float32)
    y = xf * lax.rsqrt(jnp.mean(xf * xf, axis=-1, keepdims=True) + EPS)
    return (y * g.astype(jnp.float32)).astype(x.dtype)


def head_layernorm(o):
    of = o.astype(jnp.float32)
    mu = jnp.mean(of, axis=-1, keepdims=True)
    var = jnp.mean(jnp.square(of - mu), axis=-1, keepdims=True)
    return ((of - mu) * lax.rsqrt(var + EPS)).astype(o.dtype)


def modulate(h, shift, scale):
    return h * (1.0 + scale) + shift


def to_heads(t, n_heads):
    b, l, _ = t.shape
    return t.reshape(b, l, n_heads, -1).transpose(0, 2, 1, 3)


def from_heads(t):
    b, h, l, d = t.shape
    return t.transpose(0, 2, 1, 3).reshape(b, l, h * d)


def grid_positions(n_rows):
    row = jnp.repeat(jnp.arange(n_rows), GRID_W).astype(jnp.float32)
    col = jnp.tile(jnp.arange(GRID_W), n_rows).astype(jnp.float32)
    return row, col


def rotary_2d(t, row_pos, col_pos):
    d = t.shape[-1]
    half = d // 2
    nf = half // 2
    inv = ROPE_BASE ** (-jnp.arange(nf, dtype=jnp.float32) / nf)

    def rot(u, p):
        ang = p[:, None] * inv[None, :]
        cos, sin = jnp.cos(ang), jnp.sin(ang)
        u1, u2 = u[..., :nf], u[..., nf:]
        return jnp.concatenate([u1 * cos - u2 * sin, u1 * sin + u2 * cos], axis=-1)

    tf = t.astype(jnp.float32)
    out = jnp.concatenate([rot(tf[..., :half], row_pos), rot(tf[..., half:], col_pos)], axis=-1)
    return out.astype(t.dtype)


def chunked_gated_linear_attention(q, k, v, log_a, s0, strict):
    b_, h_, l_, _ = q.shape
    dv = v.shape[-1]
    n_chunks = l_ // CHUNK
    f32 = jnp.float32

    def blocks(t):
        return t.astype(f32).reshape(b_, h_, n_chunks, CHUNK, t.shape[-1]).transpose(2, 0, 1, 3, 4)

    qs, ks, vs, gs = blocks(q), blocks(k), blocks(v), blocks(log_a)
    mask = jnp.tril(jnp.ones((CHUNK, CHUNK), dtype=bool), -1 if strict else 0)

    def step(s, blk):
        qc, kc, vc, gc = blk
        cum = jnp.cumsum(gc, axis=-2)
        cum_last = cum[..., -1:, :]
        q_dec = qc * jnp.exp(cum)
        k_inv = kc * jnp.exp(-cum)
        k_end = kc * jnp.exp(cum_last - cum)
        scores = jnp.where(mask, jnp.einsum('bhtd,bhsd->bhts', q_dec, k_inv), 0.0)
        o = jnp.einsum('bhts,bhsv->bhtv', scores, vc) + jnp.einsum('bhtd,bhdv->bhtv', q_dec, s)
        s_new = jnp.exp(cum_last[..., 0, :])[..., :, None] * s + jnp.einsum('bhsd,bhsv->bhdv', k_end, vc)
        return s_new, o

    s_fin, o = lax.scan(step, s0.astype(f32), (qs, ks, vs, gs))
    o = o.transpose(1, 2, 0, 3, 4).reshape(b_, h_, l_, dv)
    return o.astype(v.dtype), s_fin


def bidirectional_scan(lat_in, ctx_in):
    q, k, v, a_f, a_b = lat_in
    cq, ck, cv, ca_f, ca_b = ctx_in
    b_, h_, _, dk = q.shape
    dv = v.shape[-1]
    zero = jnp.zeros((b_, h_, dk, dv), jnp.float32)

    def flip(t):
        return jnp.flip(t, axis=2)

    c_f, s_f = chunked_gated_linear_attention(cq, ck, cv, ca_f, zero, False)
    x_f, _ = chunked_gated_linear_attention(q, k, v, a_f, s_f, False)
    c_b, s_b = chunked_gated_linear_attention(flip(cq), flip(ck), flip(cv), flip(ca_b), zero, True)
    x_b, _ = chunked_gated_linear_attention(flip(q), flip(k), flip(v), flip(a_b), s_b, True)
    return x_f + flip(x_b), c_f + flip(c_b)


def project_in(h, w_in):
    offsets = np.cumsum(np.array(IN_SPLITS))[:-1].tolist()
    return jnp.split(h @ w_in, offsets, axis=-1)


def gla_log_gate(d, up, ub):
    return jax.nn.log_sigmoid((d @ up + ub).astype(jnp.float32)) / GLA_GATE_NORM


def hybrid_mixer(h, hc, w_in, ret_decay, gate_up, gate_b, gla_norm_g, row_pos, col_pos, need_ctx):
    lat = project_in(h, w_in)
    cx = project_in(hc, w_in)
    log_gamma = jnp.log1p(-jnp.exp(ret_decay.astype(jnp.float32)))

    def retention_inputs(parts, rotate):
        q = to_heads(parts[0], N_RET_HEADS) * (RET_HEAD_DIM ** -0.5)
        k = to_heads(parts[1], N_RET_HEADS)
        if rotate:
            q = rotary_2d(q, row_pos, col_pos)
            k = rotary_2d(k, row_pos, col_pos)
        v = to_heads(parts[2], N_RET_HEADS)
        shape = q.shape[:3] + (1,)
        a_f = jnp.broadcast_to(log_gamma[0][None, :, None, None], shape)
        a_b = jnp.broadcast_to(log_gamma[1][None, :, None, None], shape)
        return q, k, v, a_f, a_b

    def gla_inputs(parts):
        q = to_heads(parts[4], N_GLA_HEADS) * (GLA_KEY_DIM ** -0.5)
        k = to_heads(parts[5], N_GLA_HEADS)
        v = to_heads(parts[6], N_GLA_HEADS)
        a_f = to_heads(gla_log_gate(parts[8], gate_up[0], gate_b[0]), N_GLA_HEADS)
        a_b = to_heads(gla_log_gate(parts[9], gate_up[1], gate_b[1]), N_GLA_HEADS)
        return q, k, v, a_f, a_b

    r_lat, r_ctx = bidirectional_scan(retention_inputs(lat, True), retention_inputs(cx, False))
    g_lat, g_ctx = bidirectional_scan(gla_inputs(lat), gla_inputs(cx))

    def merge(r, g, parts):
        ret = from_heads(head_layernorm(r)) * jax.nn.silu(parts[3])
        gla = from_heads(rmsnorm(g, gla_norm_g)) * jax.nn.silu(parts[7])
        return jnp.concatenate([ret, gla], axis=-1)

    y_lat = merge(r_lat, g_lat, lat)
    y_ctx = merge(r_ctx, g_ctx, cx) if need_ctx else None
    return y_lat, y_ctx


def squared_relu_mlp(h, w1, w2):
    return jnp.square(jax.nn.relu(h @ w1)) @ w2


def setup_inputs(seed: int = 0) -> dict:
    key = jax.random.key(seed)
    ks = jax.random.split(key, 17)
    f32 = jnp.float32

    def nrm(k, shape, s):
        return jax.random.normal(k, shape, f32) * s

    heads = jnp.arange(N_RET_HEADS, dtype=f32)
    base = jnp.stack([-(5.0 + heads) * LN2, -(5.5 + heads) * LN2], axis=0)
    ret_decay = base[None] + nrm(ks[8], (DEPTH, 2, N_RET_HEADS), 0.01)
    return {
        'x': nrm(ks[0], (BATCH, SEQ, D_MODEL), 1.0),
        'c': nrm(ks[1], (BATCH, D_MODEL), 1.0),
        'ctx': nrm(ks[2], (BATCH, CTX_LEN, D_MODEL), 1.0),
        'c_ctx': nrm(ks[3], (D_MODEL,), 1.0),
        'ada_w': nrm(ks[4], (DEPTH, D_MODEL, 6 * D_MODEL), 0.5 * D_MODEL ** -0.5),
        'ada_b': nrm(ks[5], (DEPTH, 6 * D_MODEL), 0.02),
        'norm1_g': 1.0 + nrm(ks[6], (DEPTH, D_MODEL), 0.02),
        'w_in': nrm(ks[7], (DEPTH, D_MODEL, IN_W), D_MODEL ** -0.5),
        'ret_decay': ret_decay,
        'gla_gate_up': nrm(ks[9], (DEPTH, 2, GLA_GATE_RANK, GLA_K), GLA_GATE_RANK ** -0.5),
        'gla_gate_b': nrm(ks[10], (DEPTH, 2, GLA_K), 0.1),
        'gla_norm_g': 1.0 + nrm(ks[11], (DEPTH, GLA_VAL_DIM), 0.02),
        'w_out': nrm(ks[12], (DEPTH, MIX_W, D_MODEL), MIX_W ** -0.5),
        'norm2_g': 1.0 + nrm(ks[13], (DEPTH, D_MODEL), 0.02),
        'w_mlp1': nrm(ks[14], (DEPTH, D_MODEL, D_FF), D_MODEL ** -0.5),
        'w_mlp2': nrm(ks[15], (DEPTH, D_FF, D_MODEL), D_FF ** -0.5),
        'final_g': 1.0 + nrm(ks[16], (D_MODEL,), 0.02),
    }


def reference(x, c, ctx, c_ctx, ada_w, ada_b, norm1_g, w_in, ret_decay, gla_gate_up, gla_gate_b,
              gla_norm_g, w_out, norm2_g, w_mlp1, w_mlp2, final_g):
    n_rows = x.shape[1] // GRID_W
    row_pos, col_pos = grid_positions(n_rows)
    silu_c = jax.nn.silu(c)
    silu_cc = jax.nn.silu(c_ctx)
    for layer in range(DEPTH):
        need_ctx = layer < DEPTH - 1
        mod_x = silu_c @ ada_w[layer] + ada_b[layer]
        mod_c = silu_cc @ ada_w[layer] + ada_b[layer]
        sh1, sc1, g1, sh2, sc2, g2 = [m[:, None, :] for m in jnp.split(mod_x, 6, axis=-1)]
        csh1, csc1, cg1, csh2, csc2, cg2 = jnp.split(mod_c, 6, axis=-1)

        hx = modulate(rmsnorm(x, norm1_g[layer]), sh1, sc1)
        hc = modulate(rmsnorm(ctx, norm1_g[layer]), csh1, csc1)
        mx, mc = hybrid_mixer(hx, hc, w_in[layer], ret_decay[layer], gla_gate_up[layer], gla_gate_b[layer],
                              gla_norm_g[layer], row_pos, col_pos, need_ctx)
        x = x + g1 * (mx @ w_out[layer])
        hx = modulate(rmsnorm(x, norm2_g[layer]), sh2, sc2)
        x = x + g2 * squared_relu_mlp(hx, w_mlp1[layer], w_mlp2[layer])

        if need_ctx:
            ctx = ctx + cg1 * (mc @ w_out[layer])
            hc = modulate(rmsnorm(ctx, norm2_g[layer]), csh2, csc2)
            ctx = ctx + cg2 * squared_relu_mlp(hc, w_mlp1[layer], w_mlp2[layer])
    return rmsnorm(x, final_g)
```

```cpp
#include <hip/hip_runtime.h>
#include <hip/hip_cooperative_groups.h>
#include <cstdio>
namespace cg = cooperative_groups;

#ifndef MULTI
#define MULTI 1
#endif

#define LAS __attribute__((address_space(3)))
typedef unsigned short bf16_t;
typedef short bf16x8 __attribute__((ext_vector_type(8)));
typedef float f32x4 __attribute__((ext_vector_type(4)));
typedef unsigned u32x2 __attribute__((ext_vector_type(2)));
typedef unsigned u32x4 __attribute__((ext_vector_type(4)));

constexpr int DM = 1024, NB = 8, SEQ = 4096, CTXL = 256, NLAT = NB * SEQ, NCTX = NB * CTXL, MTOT = NLAT + NCTX;
constexpr int INW = 3616, INWP = 3840, DFF = 4096;
constexpr int NPHASE = 18;
constexpr int LDS_BYTES = 131072;

constexpr size_t WS_WIN = 0;
constexpr size_t WS_WOUT = WS_WIN + (size_t)2 * INWP * DM * 2;
constexpr size_t WS_W1 = WS_WOUT + (size_t)2 * DM * DM * 2;
constexpr size_t WS_W2 = WS_W1 + (size_t)2 * DFF * DM * 2;
constexpr size_t WS_MOD = WS_W2 + (size_t)2 * DM * DFF * 2;
constexpr size_t WS_TAB = WS_MOD + (size_t)2 * 9 * 6 * DM * 4;
constexpr size_t WS_XCTX = WS_TAB + (size_t)2 * 2048 * 4;
constexpr size_t WS_H = WS_XCTX + (size_t)NCTX * DM * 4;
constexpr size_t WS_P = WS_H + (size_t)MTOT * DM * 2;
constexpr size_t WS_OB = WS_P + (size_t)MTOT * INW * 2;
constexpr size_t WS_END = WS_OB + (size_t)MTOT * DM * 2;
static_assert((size_t)MTOT * DFF * 2 <= WS_END - WS_P, "hmlp alias");
static_assert(WS_END <= (size_t)536870912, "ws");

struct Params {
    const float* x; const float* c; const float* ctx; const float* c_ctx; const float* ada_w; const float* ada_b; const float* norm1_g;
    const float* w_in; const float* ret_decay; const float* gate_up; const float* gate_b; const float* gla_norm_g; const float* w_out;
    const float* norm2_g; const float* w_mlp1; const float* w_mlp2; const float* final_g;
    float* out; unsigned char* ws; int ph_lo, ph_hi;
};

typedef float f32x2_t __attribute__((ext_vector_type(2)));
typedef __bf16 bf16x2_t __attribute__((ext_vector_type(2)));
__device__ __forceinline__ unsigned cvt_pk_bf16(float lo, float hi) { f32x2_t v = {lo, hi}; bf16x2_t b = __builtin_convertvector(v, bf16x2_t); return __builtin_bit_cast(unsigned, b); }
__device__ __forceinline__ bf16_t f2bf(float f) { return (bf16_t)(cvt_pk_bf16(f, 0.f) & 0xffffu); }
__device__ __forceinline__ float bf2f(short b) { return __uint_as_float(((unsigned)(unsigned short)b) << 16); }
__device__ __forceinline__ int otid() { int t = threadIdx.x; asm volatile("" : "+v"(t)); return t; }
__device__ __forceinline__ float silu_f(float v) { return v / (1.f + __expf(-v)); }

namespace pg8 {
constexpr int BM = 256, BK = 64, HALF = 128, HTB = HALF * BK * 2, STAGE_BYTES = 8 * HTB, NXCD = 8, WGM = 8;
__host__ __device__ __forceinline__ int lds_byte(int r, int c) { const int st = (r >> 4) * 2 + (c >> 5), rr = r & 15, cc = c & 31, ob = rr * 64 + cc * 2; return st * 1024 + (ob ^ (((ob >> 9) & 1) << 5)); }
__host__ __device__ __forceinline__ void stage_rc(int b, int& R, int& C) { const int st = b / 1024, sb = b % 1024, swz = sb ^ (((sb >> 9) & 1) << 5); R = (st >> 1) * 16 + swz / 64; C = (st & 1) * 32 + (swz % 64) / 2; }
__host__ __device__ __forceinline__ int perm32(int rho) { const int n = rho >> 4, i = rho & 15; return 8 * (i >> 2) + 4 * n + (i & 3); }
struct Unit { int pm, pn; };
struct Gemm { const bf16_t* A; const bf16_t* Bt; int M, N, K; };
struct StaticOrder {
    int nM, nN, nwg, G, c;
    __host__ __device__ void init(int M, int N, int G_, int c_) { nM = M / BM; nN = N / BM; nwg = nM * nN; G = G_; c = c_; }
    __host__ __device__ bool next(int i, Unit& u) const {
        const long L = (long)i * G + c; if (L >= nwg) return false;
        int wgid = (int)L; { const int q = nwg / NXCD, r = nwg % NXCD, xcd = wgid % NXCD, off = wgid / NXCD; wgid = (xcd < r ? xcd * (q + 1) : r * (q + 1) + (xcd - r) * q) + off; }
        const int nig = WGM * nN, gid = wgid / nig, fm = gid * WGM, gsz = (nM - fm) < WGM ? (nM - fm) : WGM;
        u.pm = fm + ((wgid % nig) % gsz); u.pn = (wgid % nig) / gsz; return true;
    }
    __device__ __forceinline__ void a_ready(const Unit&) const {}
    __device__ __forceinline__ void done(const Unit&) const {}
};

template <class Epi, class Sched>
__device__ __forceinline__ void gemm_phase(LAS unsigned char* lds, const Gemm g, const Sched& S, const Epi& E) {
    const int tid = otid(), wid = __builtin_amdgcn_readfirstlane(tid >> 6), lane = tid & 63, wr = wid >> 2, wc = wid & 3, fr = lane & 15, fq = lane >> 4;
    const int K = g.K, nt = K / BK;
    unsigned voffA[2], voffB[2];
#pragma unroll
    for (int i = 0; i < 2; ++i) { int R, C; stage_rc(tid * 16 + i * 8192, R, C); const int Rb = Epi::PERM ? ((R & ~31) + perm32(R & 31)) : R;
        voffA[i] = (unsigned)(R * K + C) * 2u; voffB[i] = (unsigned)(Rb * K + C) * 2u; }
    const size_t kstep = (size_t)(BK * 2);
    const size_t hstep = (size_t)HALF * K * 2;
    const size_t tstep = 2 * hstep;
    const unsigned ldsw = (unsigned)wid * 1024u;
    const int aoff = lds_byte(wr * 64 + fr, fq * 8), boff = lds_byte(wc * 32 + fr, fq * 8);
#define PG8_SA(b, h) (((b) * 2 + (h)) * HTB)
#define PG8_SB(b, h) ((4 + (b) * 2 + (h)) * HTB)
#define PG8_STAGE(bufoff, gbase, voff) do { _Pragma("unroll") for (int _i = 0; _i < 2; ++_i) \
        __builtin_amdgcn_global_load_lds((const unsigned*)((const char*)(gbase) + (voff)[_i]), (LAS unsigned*)(lds + (bufoff) + ldsw + _i * 8192), 16, 0, 0); } while (0)
#define PG8_LDA(dst, b, h) do { _Pragma("unroll") for (int m = 0; m < 4; ++m) _Pragma("unroll") for (int k = 0; k < 2; ++k) dst[m][k] = *(const LAS bf16x8*)(lds + PG8_SA(b, h) + aoff + m * 2048 + k * 1024); } while (0)
#define PG8_LDB(dst, b, h) do { _Pragma("unroll") for (int n = 0; n < 2; ++n) _Pragma("unroll") for (int k = 0; k < 2; ++k) dst[n][k] = *(const LAS bf16x8*)(lds + PG8_SB(b, h) + boff + n * 2048 + k * 1024); } while (0)
#define PG8_MMA(ai, bj, At, Bt) do { __builtin_amdgcn_s_setprio(1); _Pragma("unroll") for (int m = 0; m < 4; ++m) _Pragma("unroll") for (int n = 0; n < 2; ++n) _Pragma("unroll") for (int k = 0; k < 2; ++k) \
        acc[ai][bj][m][n] = __builtin_amdgcn_mfma_f32_16x16x32_bf16(Bt[n][k], At[m][k], acc[ai][bj][m][n], 0, 0, 0); __builtin_amdgcn_s_setprio(0); } while (0)
#define PG8_WAIT_V(n) asm volatile("s_waitcnt vmcnt(" #n ")" ::: "memory")
#define PG8_WAIT_L(n) asm volatile("s_waitcnt lgkmcnt(" #n ")" ::: "memory")
#define PG8_BAR __builtin_amdgcn_s_barrier()
#define PG8_SCHED __builtin_amdgcn_sched_barrier(0)
    Unit cur, nxt; int ui = 0;
    if (!S.next(0, cur)) return;
    f32x4 acc[2][2][4][2];
#pragma unroll
    for (int a = 0; a < 2; ++a)
#pragma unroll
        for (int b = 0; b < 2; ++b)
#pragma unroll
            for (int m = 0; m < 4; ++m)
#pragma unroll
                for (int n = 0; n < 2; ++n) acc[a][b][m][n] = (f32x4){0.f, 0.f, 0.f, 0.f};
    bf16x8 At[4][2], B0[2][2], B1[2][2];
    const char* cA = (const char*)g.A + (size_t)cur.pm * tstep; const char* cB = (const char*)g.Bt + (size_t)cur.pn * tstep;
    S.a_ready(cur);
    PG8_STAGE(PG8_SB(0, 0), cB, voffB); PG8_STAGE(PG8_SA(0, 0), cA, voffA); PG8_STAGE(PG8_SB(0, 1), cB + hstep, voffB); PG8_STAGE(PG8_SA(0, 1), cA + hstep, voffA);
    if (wr == 1) PG8_BAR;
    PG8_WAIT_V(4); PG8_BAR;
    PG8_STAGE(PG8_SB(1, 0), cB + kstep, voffB); PG8_STAGE(PG8_SA(1, 0), cA + kstep, voffA); PG8_STAGE(PG8_SB(1, 1), cB + hstep + kstep, voffB);
    PG8_WAIT_V(6); PG8_BAR;
    for (;;) {
        const bool has_next = S.next(ui + 1, nxt);
        const char* nA = has_next ? (const char*)g.A + (size_t)nxt.pm * tstep : cA; const char* nB = has_next ? (const char*)g.Bt + (size_t)nxt.pn * tstep : cB;
        for (int t = 0; t < nt; t += 2) {
            const bool last = (t == nt - 2);
            const char* a1 = cA + (size_t)(t + 1) * kstep;
            const char* a2 = last ? nA : cA + (size_t)(t + 2) * kstep; const char* b2 = last ? nB : cB + (size_t)(t + 2) * kstep;
            const char* a3 = a2 + kstep; const char* b3 = b2 + kstep;
            if (last && has_next) S.a_ready(nxt);
            PG8_LDB(B0, 0, 0); PG8_SCHED; PG8_LDA(At, 0, 0); PG8_STAGE(PG8_SA(1, 1), a1 + hstep, voffA);
            PG8_WAIT_L(8); PG8_BAR; PG8_WAIT_L(0); PG8_MMA(0, 0, At, B0); PG8_BAR; PG8_SCHED;
            PG8_LDB(B1, 0, 1); PG8_STAGE(PG8_SB(0, 0), b2, voffB);
            PG8_BAR; PG8_WAIT_L(0); PG8_MMA(0, 1, At, B1); PG8_BAR;
            PG8_LDA(At, 0, 1); PG8_STAGE(PG8_SA(0, 0), a2, voffA);
            PG8_BAR; PG8_WAIT_L(0); PG8_MMA(1, 0, At, B0); PG8_BAR; PG8_SCHED;
            PG8_STAGE(PG8_SB(0, 1), b2 + hstep, voffB);
            PG8_WAIT_V(6); PG8_BAR; PG8_MMA(1, 1, At, B1); PG8_BAR;
            PG8_LDB(B0, 1, 0); PG8_SCHED; PG8_LDA(At, 1, 0); PG8_STAGE(PG8_SA(0, 1), a2 + hstep, voffA);
            PG8_WAIT_L(8); PG8_BAR; PG8_WAIT_L(0); PG8_MMA(0, 0, At, B0); PG8_BAR; PG8_SCHED;
            PG8_LDB(B1, 1, 1); PG8_STAGE(PG8_SB(1, 0), b3, voffB);
            PG8_BAR; PG8_WAIT_L(0); PG8_MMA(0, 1, At, B1); PG8_BAR;
            PG8_LDA(At, 1, 1); PG8_STAGE(PG8_SA(1, 0), a3, voffA);
            PG8_BAR; PG8_WAIT_L(0); PG8_MMA(1, 0, At, B0); PG8_BAR; PG8_SCHED;
            PG8_STAGE(PG8_SB(1, 1), b3 + hstep, voffB);
            PG8_WAIT_V(6); PG8_BAR; PG8_MMA(1, 1, At, B1); PG8_BAR;
        }
        E(acc, cur, wr, wc, fr, fq);
        if (!has_next) break;
#pragma unroll
        for (int a = 0; a < 2; ++a)
#pragma unroll
            for (int b = 0; b < 2; ++b)
#pragma unroll
                for (int m = 0; m < 4; ++m)
#pragma unroll
                    for (int n = 0; n < 2; ++n) acc[a][b][m][n] = (f32x4){0.f, 0.f, 0.f, 0.f};
        cur = nxt; cA = nA; cB = nB; ++ui;
    }
    PG8_WAIT_V(0);
    if (wr == 0) PG8_BAR;
    PG8_BAR;
#undef PG8_SA
#undef PG8_SB
#undef PG8_STAGE
#undef PG8_LDA
#undef PG8_LDB
#undef PG8_MMA
#undef PG8_WAIT_V
#undef PG8_WAIT_L
#undef PG8_BAR
#undef PG8_SCHED
}
}

struct EpiP {
    static constexpr bool PERM = false;
    bf16_t* P;
    __device__ __forceinline__ void operator()(const f32x4 (&acc)[2][2][4][2], const pg8::Unit& u, int wr, int wc, int fr, int fq) const {
        const int row0 = u.pm * 256 + wr * 64 + fr, col0 = u.pn * 256 + wc * 32 + 4 * fq;
#pragma unroll
        for (int ai = 0; ai < 2; ++ai)
#pragma unroll
            for (int m = 0; m < 4; ++m) { bf16_t* rowp = P + (size_t)(row0 + ai * 128 + m * 16) * INW;
#pragma unroll
                for (int bj = 0; bj < 2; ++bj)
#pragma unroll
                    for (int n = 0; n < 2; ++n) { const int c = col0 + bj * 128 + n * 16; const f32x4 v = acc[ai][bj][m][n];
                        if (c < INW) { u32x2 w2; w2.x = cvt_pk_bf16(v[0], v[1]); w2.y = cvt_pk_bf16(v[2], v[3]); *(u32x2*)(rowp + c) = w2; } } }
    }
};
struct EpiRelu2 {
    static constexpr bool PERM = false;
    bf16_t* O;
    __device__ __forceinline__ void operator()(const f32x4 (&acc)[2][2][4][2], const pg8::Unit& u, int wr, int wc, int fr, int fq) const {
        const int row0 = u.pm * 256 + wr * 64 + fr, col0 = u.pn * 256 + wc * 32 + 4 * fq;
#pragma unroll
        for (int ai = 0; ai < 2; ++ai)
#pragma unroll
            for (int m = 0; m < 4; ++m) { bf16_t* rowp = O + (size_t)(row0 + ai * 128 + m * 16) * DFF;
#pragma unroll
                for (int bj = 0; bj < 2; ++bj)
#pragma unroll
                    for (int n = 0; n < 2; ++n) { const int c = col0 + bj * 128 + n * 16; f32x4 v = acc[ai][bj][m][n];
#pragma unroll
                        for (int j = 0; j < 4; ++j) { const float r = fmaxf(v[j], 0.f); v[j] = r * r; }
                        u32x2 w2; w2.x = cvt_pk_bf16(v[0], v[1]); w2.y = cvt_pk_bf16(v[2], v[3]); *(u32x2*)(rowp + c) = w2; } }
    }
};
struct EpiRes {
    static constexpr bool PERM = false;
    const float* xin_lat; const float* xin_ctx; float* xout_lat; float* xout_ctx; const float* gate;
    __device__ __forceinline__ void operator()(const f32x4 (&acc)[2][2][4][2], const pg8::Unit& u, int wr, int wc, int fr, int fq) const {
        const int row0 = u.pm * 256 + wr * 64 + fr, col0 = u.pn * 256 + wc * 32 + 4 * fq;
        const int rb = u.pm * 256;
        const bool isctx = rb >= NLAT;
        const int bidx = isctx ? 8 : (rb >> 12);
        const float* xi = isctx ? xin_ctx - (size_t)NLAT * DM : xin_lat;
        float* xo = isctx ? xout_ctx - (size_t)NLAT * DM : xout_lat;
        const float* gp = gate + (size_t)bidx * 6 * DM;
        f32x4 gv[2][2];
#pragma unroll
        for (int bj = 0; bj < 2; ++bj)
#pragma unroll
            for (int n = 0; n < 2; ++n) gv[bj][n] = *(const f32x4*)(gp + col0 + bj * 128 + n * 16);
#pragma unroll
        for (int ai = 0; ai < 2; ++ai)
#pragma unroll
            for (int m = 0; m < 4; ++m) { const size_t ro = (size_t)(row0 + ai * 128 + m * 16) * DM;
#pragma unroll
                for (int bj = 0; bj < 2; ++bj)
#pragma unroll
                    for (int n = 0; n < 2; ++n) { const int c = col0 + bj * 128 + n * 16; const f32x4 xv = *(const f32x4*)(xi + ro + c);
                        *(f32x4*)(xo + ro + c) = xv + gv[bj][n] * acc[ai][bj][m][n]; } }
    }
};

__device__ void transpose_tile(const float* __restrict__ src, int K, int N, bf16_t* __restrict__ dst, int tk, int tn, float* tile) {
    const int tid = otid(), k0 = tk * 64, n0 = tn * 64, cl = tid & 63, r0 = tid >> 6;
#pragma unroll
    for (int i = 0; i < 8; ++i) { const int r = r0 + 8 * i, n = n0 + cl; tile[r * 65 + cl] = (n < N) ? src[(size_t)(k0 + r) * N + n] : 0.f; }
    __syncthreads();
#pragma unroll
    for (int i = 0; i < 8; ++i) { const int rn = r0 + 8 * i; dst[(size_t)(n0 + rn) * K + k0 + cl] = f2bf(tile[cl * 65 + rn]); }
    __syncthreads();
}
__device__ void phase_prep(const Params& p, unsigned char* lds) {
    float* tile = (float*)lds;
    const int tid = otid();
    constexpr int T_IN = 16 * 60, T_OUT = 16 * 16, T_1 = 16 * 64, T_2 = 64 * 16, T_L = T_IN + T_OUT + T_1 + T_2;
    for (int t = blockIdx.x; t < 2 * T_L; t += gridDim.x) {
        const int l = t / T_L; int r = t % T_L;
        if (r < T_IN) transpose_tile(p.w_in + (size_t)l * DM * INW, DM, INW, (bf16_t*)(p.ws + WS_WIN) + (size_t)l * INWP * DM, r / 60, r % 60, tile);
        else if ((r -= T_IN) < T_OUT) transpose_tile(p.w_out + (size_t)l * DM * DM, DM, DM, (bf16_t*)(p.ws + WS_WOUT) + (size_t)l * DM * DM, r / 16, r % 16, tile);
        else if ((r -= T_OUT) < T_1) transpose_tile(p.w_mlp1 + (size_t)l * DM * DFF, DM, DFF, (bf16_t*)(p.ws + WS_W1) + (size_t)l * DFF * DM, r / 64, r % 64, tile);
        else { r -= T_1; transpose_tile(p.w_mlp2 + (size_t)l * DFF * DM, DFF, DM, (bf16_t*)(p.ws + WS_W2) + (size_t)l * DM * DFF, r / 16, r % 16, tile); }
    }
    float* red = (float*)lds;
    const int w = tid >> 6, lane = tid & 63;
    for (int it = blockIdx.x; it < 2 * 96; it += gridDim.x) {
        const int l = it / 96, j0 = (it % 96) * 64;
        float a[9];
#pragma unroll
        for (int r = 0; r < 9; ++r) a[r] = 0.f;
        const float* wp = p.ada_w + (size_t)l * DM * 6 * DM + j0 + lane;
        for (int k = w * 128; k < w * 128 + 128; ++k) {
            const float wv = wp[(size_t)k * 6 * DM];
#pragma unroll
            for (int r = 0; r < 9; ++r) { const float cv = (r < 8) ? p.c[r * DM + k] : p.c_ctx[k]; a[r] += silu_f(cv) * wv; }
        }
        __syncthreads();
#pragma unroll
        for (int r = 0; r < 9; ++r) red[(w * 9 + r) * 64 + lane] = a[r];
        __syncthreads();
        for (int idx = tid; idx < 9 * 64; idx += 512) { const int r = idx >> 6, ln = idx & 63; float s = 0.f;
#pragma unroll
            for (int ww = 0; ww < 8; ++ww) s += red[(ww * 9 + r) * 64 + ln];
            ((float*)(p.ws + WS_MOD))[((size_t)l * 9 + r) * 6 * DM + j0 + ln] = s + p.ada_b[(size_t)l * 6 * DM + j0 + ln]; }
    }
    if (blockIdx.x == gridDim.x - 1) {
        float* tab = (float*)(p.ws + WS_TAB);
        for (int idx = tid; idx < 2048; idx += 512) { const int pos = idx >> 5, i = idx & 31; const float inv = powf(10000.0f, -(float)i / 32.0f); const float ang = (float)pos * inv;
            tab[idx] = cosf(ang); tab[2048 + idx] = sinf(ang); }
    }
    __syncthreads();
}

__device__ __forceinline__ const float* xrow(const float* lat, const float* ctx, int m) { return m < NLAT ? lat + (size_t)m * DM : ctx + (size_t)(m - NLAT) * DM; }
__device__ void phase_norm(const Params& p, const float* xl, const float* xc, const float* g, const float* mod_l, int sh_off, int nrows) {
    const int tid_ = otid(); const int lane = tid_ & 63, gw = blockIdx.x * 8 + (tid_ >> 6), nw = gridDim.x * 8;
    bf16_t* H = (bf16_t*)(p.ws + WS_H);
    for (int m = gw; m < nrows; m += nw) {
        const float* xr = xrow(xl, xc, m);
        const int b = m < NLAT ? (m >> 12) : 8;
        const float* sh = mod_l + (size_t)b * 6 * DM + sh_off; const float* sc = sh + DM;
        f32x4 v[4]; float ss = 0.f;
#pragma unroll
        for (int i = 0; i < 4; ++i) { v[i] = *(const f32x4*)(xr + 4 * lane + 256 * i); ss += v[i][0] * v[i][0] + v[i][1] * v[i][1] + v[i][2] * v[i][2] + v[i][3] * v[i][3]; }
#pragma unroll
        for (int o = 32; o >= 1; o >>= 1) ss += __shfl_xor(ss, o);
        const float rinv = rsqrtf(ss * (1.0f / DM) + 1e-6f);
#pragma unroll
        for (int i = 0; i < 4; ++i) { const int c = 4 * lane + 256 * i; const f32x4 gg = *(const f32x4*)(g + c), s1 = *(const f32x4*)(sc + c), s0 = *(const f32x4*)(sh + c);
            f32x4 y;
#pragma unroll
            for (int j = 0; j < 4; ++j) y[j] = (v[i][j] * rinv * gg[j]) * (1.f + s1[j]) + s0[j];
            u32x2 w2; w2.x = cvt_pk_bf16(y[0], y[1]); w2.y = cvt_pk_bf16(y[2], y[3]); *(u32x2*)(H + (size_t)m * DM + c) = w2; }
    }
}
__device__ void phase_final(const Params& p) {
    const int tid_ = otid(); const int lane = tid_ & 63, gw = blockIdx.x * 8 + (tid_ >> 6), nw = gridDim.x * 8;
    for (int m = gw; m < NLAT; m += nw) {
        float* xr = p.out + (size_t)m * DM;
        f32x4 v[4]; float ss = 0.f;
#pragma unroll
        for (int i = 0; i < 4; ++i) { v[i] = *(const f32x4*)(xr + 4 * lane + 256 * i); ss += v[i][0] * v[i][0] + v[i][1] * v[i][1] + v[i][2] * v[i][2] + v[i][3] * v[i][3]; }
#pragma unroll
        for (int o = 32; o >= 1; o >>= 1) ss += __shfl_xor(ss, o);
        const float rinv = rsqrtf(ss * (1.0f / DM) + 1e-6f);
#pragma unroll
        for (int i = 0; i < 4; ++i) { const int c = 4 * lane + 256 * i; const f32x4 gg = *(const f32x4*)(p.final_g + c);
            f32x4 y;
#pragma unroll
            for (int j = 0; j < 4; ++j) y[j] = v[i][j] * rinv * gg[j];
            *(f32x4*)(xr + c) = y; }
    }
}

__device__ void phase_merge(const Params& p, int l, int nrows) {
    const int tid_ = otid(); const int lane = tid_ & 63, gw = blockIdx.x * 8 + (tid_ >> 6), nw = gridDim.x * 8;
    bf16_t* H = (bf16_t*)(p.ws + WS_H); const bf16_t* OB = (const bf16_t*)(p.ws + WS_OB); const bf16_t* P = (const bf16_t*)(p.ws + WS_P);
    const bool isgla = lane >= 32;
    const int gcol = isgla ? (2560 + 16 * lane) : (1536 + 16 * lane);
    const float* gn = p.gla_norm_g + l * 128 + ((16 * lane) & 127);
    for (int m = gw; m < nrows; m += nw) {
        const bf16x8 f0 = *(const bf16x8*)(H + (size_t)m * DM + 16 * lane), f1 = *(const bf16x8*)(H + (size_t)m * DM + 16 * lane + 8);
#ifdef NO_SCAN
        const bf16x8 b0 = (bf16x8){0,0,0,0,0,0,0,0}, b1 = b0; (void)OB;
#else
        const bf16x8 b0 = *(const bf16x8*)(OB + (size_t)m * DM + 16 * lane), b1 = *(const bf16x8*)(OB + (size_t)m * DM + 16 * lane + 8);
#endif
        const bf16x8 g0 = *(const bf16x8*)(P + (size_t)m * INW + gcol), g1 = *(const bf16x8*)(P + (size_t)m * INW + gcol + 8);
        float r[16]; float s1 = 0.f, s2 = 0.f;
#pragma unroll
        for (int j = 0; j < 8; ++j) { r[j] = bf2f(f0[j]) + bf2f(b0[j]); r[8 + j] = bf2f(f1[j]) + bf2f(b1[j]); }
#ifdef SANITIZE
#pragma unroll
        for (int j = 0; j < 16; ++j) { if (!(fabsf(r[j]) < 1e30f)) r[j] = 0.f; }
#endif
#ifdef SKIP_GLA
        if (isgla) {
#pragma unroll
            for (int j = 0; j < 16; ++j) r[j] = 0.f; }
#endif
#ifdef SKIP_RET
        if (!isgla) {
#pragma unroll
            for (int j = 0; j < 16; ++j) r[j] = 0.f; }
#endif
#pragma unroll
        for (int j = 0; j < 16; ++j) { s1 += r[j]; s2 += r[j] * r[j]; }
#pragma unroll
        for (int o = 1; o <= 4; o <<= 1) { s1 += __shfl_xor(s1, o); s2 += __shfl_xor(s2, o); }
        float y[16];
        if (!isgla) {
            const float mu = s1 * (1.f / 128.f); float sv = 0.f;
#pragma unroll
            for (int j = 0; j < 16; ++j) { const float d = r[j] - mu; sv += d * d; }
#pragma unroll
            for (int o = 1; o <= 4; o <<= 1) sv += __shfl_xor(sv, o);
            const float rs = rsqrtf(sv * (1.f / 128.f) + 1e-6f);
#pragma unroll
            for (int j = 0; j < 16; ++j) y[j] = (r[j] - mu) * rs;
        } else {
            float sv = 0.f;
#pragma unroll
            for (int o = 1; o <= 4; o <<= 1) sv += __shfl_xor(sv, o);
            const float rs = rsqrtf(s2 * (1.f / 128.f) + 1e-6f);
#pragma unroll
            for (int j = 0; j < 16; ++j) y[j] = r[j] * rs * gn[j] + 0.f * sv;
        }
        u32x4 o0, o1;
#pragma unroll
        for (int j = 0; j < 8; ++j) { y[j] *= silu_f(bf2f(g0[j])); y[8 + j] *= silu_f(bf2f(g1[j])); }
        o0.x = cvt_pk_bf16(y[0], y[1]); o0.y = cvt_pk_bf16(y[2], y[3]); o0.z = cvt_pk_bf16(y[4], y[5]); o0.w = cvt_pk_bf16(y[6], y[7]);
        o1.x = cvt_pk_bf16(y[8], y[9]); o1.y = cvt_pk_bf16(y[10], y[11]); o1.z = cvt_pk_bf16(y[12], y[13]); o1.w = cvt_pk_bf16(y[14], y[15]);
        *(u32x4*)(H + (size_t)m * DM + 16 * lane) = o0; *(u32x4*)(H + (size_t)m * DM + 16 * lane + 8) = o1;
    }
}

template <int DK, bool GLA>
__device__ __forceinline__ void scan_item(const Params& p, int l, unsigned char* lds, int b, int h, int dir, int dvs) {
    constexpr int QS = DK + 8, TS = 72, NT = DK / 32, NKS = DK / 32;
    bf16_t* QD = (bf16_t*)lds;
    bf16_t* KI = QD + 64 * QS;
    bf16_t* ST = KI + 64 * QS;
    bf16_t* KET = ST + 64 * QS;
    bf16_t* VT = KET + DK * TS;
    bf16_t* SC = VT + 64 * TS;
    float* DVEC = (float*)(SC + 64 * TS);
    float* CL = DVEC + DK;
    float* CUM = CL + DK;
    float* UP = CUM + 64 * 68;
    const int tid = otid(), lane = tid & 63, w = tid >> 6, fr = lane & 15, fq = lane >> 4;
    const bf16_t* P = (const bf16_t*)(p.ws + WS_P);
    bf16_t* O = (bf16_t*)(p.ws + (dir ? WS_OB : WS_H));
    const float* TABC = (const float*)(p.ws + WS_TAB); const float* TABS = TABC + 2048;
    const int ocol = (GLA ? 512 : 0) + 128 * h + 64 * dvs;
    const int qcol = GLA ? 2048 + 64 * h : 128 * h, kcol = GLA ? 2304 + 64 * h : 512 + 128 * h, vcol = (GLA ? 2560 : 1024) + 128 * h + 64 * dvs;
    float g = 0.f;
    if (!GLA) g = log1pf(-__expf(p.ret_decay[l * 8 + dir * 4 + h]));
    const int dkt = (DK == 128) ? w : (w >> 1);
    const int dvt0 = (DK == 128) ? 0 : 2 * (w & 1);
    f32x4 S[NT];
#pragma unroll
    for (int i = 0; i < NT; ++i) S[i] = (f32x4){0.f, 0.f, 0.f, 0.f};
    __syncthreads();
    for (int i = tid; i < 64 * QS / 2; i += 512) ((unsigned*)ST)[i] = 0u;
    if (GLA) {
        for (int i = tid; i < 16 * 64; i += 512) UP[i] = p.gate_up[((size_t)(l * 2 + dir) * 16 + (i >> 6)) * 256 + 64 * h + (i & 63)];
        if (tid < 64) UP[1024 + tid] = p.gate_b[(l * 2 + dir) * 256 + 64 * h + tid];
    } else {
        if (tid < DK) DVEC[tid] = __expf(64.f * g);
    }
    __syncthreads();
    for (int step = 0; step < 68; ++step) {
        const bool isctx = step < 4;
        const int chunk = dir == 0 ? (isctx ? step : step - 4) : (isctx ? 3 - step : 67 - step);
        const int m0 = isctx ? (NLAT + b * CTXL + chunk * 64) : (b * SEQ + chunk * 64);
        if (GLA) {
            const bf16_t* dp = P + (size_t)(m0 + lane) * INW + 3584 + 16 * dir;
            const bf16x8 d0 = *(const bf16x8*)dp, d1 = *(const bf16x8*)(dp + 8);
            float df[16];
#pragma unroll
            for (int r = 0; r < 8; ++r) { df[r] = bf2f(d0[r]); df[8 + r] = bf2f(d1[r]); }
#pragma unroll
            for (int c = 0; c < 8; ++c) {
                const int ch = 8 * w + c;
                float z = UP[1024 + ch];
#pragma unroll
                for (int r = 0; r < 16; ++r) z += df[r] * UP[r * 64 + ch];
                float v = (fminf(z, 0.f) - log1pf(__expf(-fabsf(z)))) * (1.0f / 16.0f);
                if (dir == 0) {
#pragma unroll
                    for (int o = 1; o < 64; o <<= 1) { const float t = __shfl_up(v, o); if (lane >= o) v += t; }
                } else {
#pragma unroll
                    for (int o = 1; o < 64; o <<= 1) { const float t = __shfl_down(v, o); if (lane + o < 64) v += t; }
                }
                CUM[lane * 68 + ch] = v;
                const float tot = __shfl(v, dir == 0 ? 63 : 0);
                if (lane == 0) { CL[ch] = tot; DVEC[ch] = __expf(tot); }
            }
            __syncthreads();
        }
        {
            const int s = tid >> 3;
            const bf16_t* rowp = P + (size_t)(m0 + s) * INW;
            if (!GLA) {
                const int pr = tid & 7, c8a = (pr & 3) + 8 * (pr >> 2);
                const bf16x8 q1 = *(const bf16x8*)(rowp + qcol + 8 * c8a), q2 = *(const bf16x8*)(rowp + qcol + 8 * (c8a + 4));
                const bf16x8 k1 = *(const bf16x8*)(rowp + kcol + 8 * c8a), k2 = *(const bf16x8*)(rowp + kcol + 8 * (c8a + 4));
                const float cum = dir == 0 ? g * (float)(s + 1) : g * (float)(64 - s), cl = 64.f * g;
                const float eq = __expf(cum) * 0.08838834764831845f, eki = __expf(-cum), eke = __expf(cl - cum);
                float cs[8], sn[8];
                if (!isctx) {
                    const int pos = (pr >> 2) ? s : chunk;
                    const f32x4 c0 = *(const f32x4*)(TABC + pos * 32 + 8 * (pr & 3)), c1 = *(const f32x4*)(TABC + pos * 32 + 8 * (pr & 3) + 4);
                    const f32x4 s0 = *(const f32x4*)(TABS + pos * 32 + 8 * (pr & 3)), s1 = *(const f32x4*)(TABS + pos * 32 + 8 * (pr & 3) + 4);
#pragma unroll
                    for (int j = 0; j < 4; ++j) { cs[j] = c0[j]; cs[4 + j] = c1[j]; sn[j] = s0[j]; sn[4 + j] = s1[j]; }
                } else {
#pragma unroll
                    for (int j = 0; j < 8; ++j) { cs[j] = 1.f; sn[j] = 0.f; }
                }
                float qa[8], qb[8], ka[8], kb[8];
#pragma unroll
                for (int j = 0; j < 8; ++j) {
                    const float a1 = bf2f(q1[j]), a2 = bf2f(q2[j]), b1 = bf2f(k1[j]), b2 = bf2f(k2[j]);
                    qa[j] = a1 * cs[j] - a2 * sn[j]; qb[j] = a1 * sn[j] + a2 * cs[j];
                    ka[j] = b1 * cs[j] - b2 * sn[j]; kb[j] = b1 * sn[j] + b2 * cs[j];
                }
                u32x4 o;
                o.x = cvt_pk_bf16(qa[0] * eq, qa[1] * eq); o.y = cvt_pk_bf16(qa[2] * eq, qa[3] * eq); o.z = cvt_pk_bf16(qa[4] * eq, qa[5] * eq); o.w = cvt_pk_bf16(qa[6] * eq, qa[7] * eq);
                *(u32x4*)(QD + s * QS + 8 * c8a) = o;
                o.x = cvt_pk_bf16(qb[0] * eq, qb[1] * eq); o.y = cvt_pk_bf16(qb[2] * eq, qb[3] * eq); o.z = cvt_pk_bf16(qb[4] * eq, qb[5] * eq); o.w = cvt_pk_bf16(qb[6] * eq, qb[7] * eq);
                *(u32x4*)(QD + s * QS + 8 * (c8a + 4)) = o;
                o.x = cvt_pk_bf16(ka[0] * eki, ka[1] * eki); o.y = cvt_pk_bf16(ka[2] * eki, ka[3] * eki); o.z = cvt_pk_bf16(ka[4] * eki, ka[5] * eki); o.w = cvt_pk_bf16(ka[6] * eki, ka[7] * eki);
                *(u32x4*)(KI + s * QS + 8 * c8a) = o;
                o.x = cvt_pk_bf16(kb[0] * eki, kb[1] * eki); o.y = cvt_pk_bf16(kb[2] * eki, kb[3] * eki); o.z = cvt_pk_bf16(kb[4] * eki, kb[5] * eki); o.w = cvt_pk_bf16(kb[6] * eki, kb[7] * eki);
                *(u32x4*)(KI + s * QS + 8 * (c8a + 4)) = o;
#pragma unroll
                for (int j = 0; j < 8; ++j) { KET[(8 * c8a + j) * TS + s] = f2bf(ka[j] * eke); KET[(8 * (c8a + 4) + j) * TS + s] = f2bf(kb[j] * eke); }
            } else {
                const int c8 = tid & 7;
                const bf16x8 q1 = *(const bf16x8*)(rowp + qcol + 8 * c8), k1 = *(const bf16x8*)(rowp + kcol + 8 * c8);
                const f32x4 cu0 = *(const f32x4*)(CUM + s * 68 + 8 * c8), cu1 = *(const f32x4*)(CUM + s * 68 + 8 * c8 + 4);
                const f32x4 cl0 = *(const f32x4*)(CL + 8 * c8), cl1 = *(const f32x4*)(CL + 8 * c8 + 4);
                float qd[8], ki[8];
#pragma unroll
                for (int j = 0; j < 8; ++j) {
                    const float cu = j < 4 ? cu0[j & 3] : cu1[j & 3], cl = j < 4 ? cl0[j & 3] : cl1[j & 3];
                    const float qv = bf2f(q1[j]), kv = bf2f(k1[j]);
                    qd[j] = qv * 0.125f * __expf(cu); ki[j] = kv * __expf(-cu);
                    KET[(8 * c8 + j) * TS + s] = f2bf(kv * __expf(cl - cu));
                }
                u32x4 o;
                o.x = cvt_pk_bf16(qd[0], qd[1]); o.y = cvt_pk_bf16(qd[2], qd[3]); o.z = cvt_pk_bf16(qd[4], qd[5]); o.w = cvt_pk_bf16(qd[6], qd[7]);
                *(u32x4*)(QD + s * QS + 8 * c8) = o;
                o.x = cvt_pk_bf16(ki[0], ki[1]); o.y = cvt_pk_bf16(ki[2], ki[3]); o.z = cvt_pk_bf16(ki[4], ki[5]); o.w = cvt_pk_bf16(ki[6], ki[7]);
                *(u32x4*)(KI + s * QS + 8 * c8) = o;
            }
            {
                const int c8 = tid & 7;
                const bf16x8 v1 = *(const bf16x8*)(rowp + vcol + 8 * c8);
#pragma unroll
                for (int j = 0; j < 8; ++j) VT[(8 * c8 + j) * TS + s] = (bf16_t)v1[j];
            }
        }
        __syncthreads();
        {
            const int tt = w >> 1;
#pragma unroll
            for (int si = 0; si < 2; ++si) {
                const int st = 2 * (w & 1) + si;
                f32x4 acc = (f32x4){0.f, 0.f, 0.f, 0.f};
#pragma unroll
                for (int ks = 0; ks < NKS; ++ks) {
                    const bf16x8 a = *(const bf16x8*)(KI + (16 * st + fr) * QS + 32 * ks + 8 * fq);
                    const bf16x8 bb = *(const bf16x8*)(QD + (16 * tt + fr) * QS + 32 * ks + 8 * fq);
                    acc = __builtin_amdgcn_mfma_f32_16x16x32_bf16(a, bb, acc, 0, 0, 0);
                }
                const int t = 16 * tt + fr, s0 = 16 * st + 4 * fq;
                float v[4];
#pragma unroll
                for (int r = 0; r < 4; ++r) { const int s = s0 + r; const bool keep = dir == 0 ? (s <= t) : (s > t); v[r] = keep ? acc[r] : 0.f; }
                u32x2 w2; w2.x = cvt_pk_bf16(v[0], v[1]); w2.y = cvt_pk_bf16(v[2], v[3]);
                *(u32x2*)(SC + t * TS + s0) = w2;
            }
        }
        __syncthreads();
        {
            const int tt = w >> 1;
#pragma unroll
            for (int di = 0; di < 2; ++di) {
                const int dvt = 2 * (w & 1) + di;
                f32x4 acc = (f32x4){0.f, 0.f, 0.f, 0.f};
#pragma unroll
                for (int ks = 0; ks < 2; ++ks) {
                    const bf16x8 a = *(const bf16x8*)(VT + (16 * dvt + fr) * TS + 32 * ks + 8 * fq);
                    const bf16x8 bb = *(const bf16x8*)(SC + (16 * tt + fr) * TS + 32 * ks + 8 * fq);
                    acc = __builtin_amdgcn_mfma_f32_16x16x32_bf16(a, bb, acc, 0, 0, 0);
                }
#pragma unroll
                for (int ks = 0; ks < NKS; ++ks) {
                    const bf16x8 a = *(const bf16x8*)(ST + (16 * dvt + fr) * QS + 32 * ks + 8 * fq);
                    const bf16x8 bb = *(const bf16x8*)(QD + (16 * tt + fr) * QS + 32 * ks + 8 * fq);
                    acc = __builtin_amdgcn_mfma_f32_16x16x32_bf16(a, bb, acc, 0, 0, 0);
                }
                u32x2 w2; w2.x = cvt_pk_bf16(acc[0], acc[1]); w2.y = cvt_pk_bf16(acc[2], acc[3]);
                *(u32x2*)(O + (size_t)(m0 + 16 * tt + fr) * DM + ocol + 16 * dvt + 4 * fq) = w2;
            }
            const f32x4 dv4 = *(const f32x4*)(DVEC + 16 * dkt + 4 * fq);
#pragma unroll
            for (int i = 0; i < NT; ++i) {
                const int dvt = dvt0 + i;
                S[i] = S[i] * dv4;
#pragma unroll
                for (int ks = 0; ks < 2; ++ks) {
                    const bf16x8 a = *(const bf16x8*)(KET + (16 * dkt + fr) * TS + 32 * ks + 8 * fq);
                    const bf16x8 bb = *(const bf16x8*)(VT + (16 * dvt + fr) * TS + 32 * ks + 8 * fq);
                    S[i] = __builtin_amdgcn_mfma_f32_16x16x32_bf16(a, bb, S[i], 0, 0, 0);
                }
            }
        }
        __syncthreads();
#pragma unroll
        for (int i = 0; i < NT; ++i) {
            const int dvt = dvt0 + i;
            u32x2 w2; w2.x = cvt_pk_bf16(S[i][0], S[i][1]); w2.y = cvt_pk_bf16(S[i][2], S[i][3]);
            *(u32x2*)(ST + (16 * dvt + fr) * QS + 16 * dkt + 4 * fq) = w2;
        }
    }
    __syncthreads();
}
__device__ void phase_scan(const Params& p, int l, unsigned char* lds) {
    for (int it = blockIdx.x; it < 256; it += gridDim.x) {
        const int isgla = it & 1, r = it >> 1;
        const int dvs = r & 1, dir = (r >> 1) & 1, h = (r >> 2) & 3, b = r >> 4;
#ifdef SKIP_GLA
        if (isgla) continue;
#endif
#ifdef SKIP_RET
        if (!isgla) continue;
#endif
        if (isgla) scan_item<64, true>(p, l, lds, b, h, dir, dvs);
        else scan_item<128, false>(p, l, lds, b, h, dir, dvs);
    }
}

__global__ void __launch_bounds__(512, 2) fwd_megakernel(Params p) {
    extern __shared__ __attribute__((aligned(16))) unsigned char shm[];
    cg::grid_group grid = cg::this_grid();
    const float* MOD = (const float*)(p.ws + WS_MOD);
    for (int ph = p.ph_lo; ph < p.ph_hi; ++ph) {
        if (ph == 0) phase_prep(p, shm);
        else if (ph == NPHASE - 1) phase_final(p);
        else {
            const int l = (ph - 1) >> 3, sub = (ph - 1) & 7;
            const float* mod_l = MOD + (size_t)l * 9 * 6 * DM;
            const float* xin_lat = l == 0 ? p.x : p.out; const float* xin_ctx = l == 0 ? p.ctx : (const float*)(p.ws + WS_XCTX);
            float* xo_lat = p.out; float* xo_ctx = (float*)(p.ws + WS_XCTX);
            const int mrows = l == 0 ? MTOT : NLAT;
            bf16_t* H = (bf16_t*)(p.ws + WS_H); bf16_t* Pm = (bf16_t*)(p.ws + WS_P);
            pg8::StaticOrder S;
            if (sub == 0) phase_norm(p, xin_lat, xin_ctx, p.norm1_g + l * DM, mod_l, 0, MTOT);
#ifndef NO_G1
            else if (sub == 1) { pg8::Gemm g{H, (const bf16_t*)(p.ws + WS_WIN) + (size_t)l * INWP * DM, MTOT, INWP, DM}; S.init(g.M, g.N, gridDim.x, blockIdx.x);
                EpiP E{Pm}; pg8::gemm_phase(( LAS unsigned char*)shm, g, S, E); }
#endif
#ifndef NO_SCAN
            else if (sub == 2) phase_scan(p, l, shm);
#endif
            else if (sub == 3) phase_merge(p, l, mrows);
#ifndef NO_G2
            else if (sub == 4) { pg8::Gemm g{H, (const bf16_t*)(p.ws + WS_WOUT) + (size_t)l * DM * DM, mrows, DM, DM}; S.init(g.M, g.N, gridDim.x, blockIdx.x);
                EpiRes E{xin_lat, xin_ctx, xo_lat, xo_ctx, mod_l + 2 * DM}; pg8::gemm_phase((LAS unsigned char*)shm, g, S, E); }
#endif
            else if (sub == 5) phase_norm(p, xo_lat, xo_ctx, p.norm2_g + l * DM, mod_l, 3 * DM, mrows);
#ifndef NO_G3
            else if (sub == 6) { pg8::Gemm g{H, (const bf16_t*)(p.ws + WS_W1) + (size_t)l * DFF * DM, mrows, DFF, DM}; S.init(g.M, g.N, gridDim.x, blockIdx.x);
                EpiRelu2 E{Pm}; pg8::gemm_phase((LAS unsigned char*)shm, g, S, E); }
#endif
#ifndef NO_G4
            else if (sub == 7) { pg8::Gemm g{Pm, (const bf16_t*)(p.ws + WS_W2) + (size_t)l * DM * DFF, mrows, DM, DFF}; S.init(g.M, g.N, gridDim.x, blockIdx.x);
                EpiRes E{xo_lat, xo_ctx, xo_lat, xo_ctx, mod_l + 5 * DM}; pg8::gemm_phase((LAS unsigned char*)shm, g, S, E); }
#endif
        }
        if (ph + 1 < p.ph_hi) grid.sync();
    }
}

extern "C" void kernel_launch(void* const* d_in, const int* in_sizes, int n_in, void* d_out, int out_size, void* d_ws, size_t ws_size, hipStream_t stream) {
    static int grid_blocks = 0;
    if (!grid_blocks) {
        int dev = 0, cus = 0, per_cu = 0;
        hipGetDevice(&dev);
        hipDeviceGetAttribute(&cus, hipDeviceAttributeMultiprocessorCount, dev);
        if (hipFuncSetAttribute((const void*)fwd_megakernel, hipFuncAttributeMaxDynamicSharedMemorySize, LDS_BYTES) != hipSuccess) fprintf(stderr, "hipFuncSetAttribute failed\n");
        if (hipOccupancyMaxActiveBlocksPerMultiprocessor(&per_cu, (const void*)fwd_megakernel, 512, LDS_BYTES) != hipSuccess || per_cu < 1) { fprintf(stderr, "occupancy query: %d\n", per_cu); per_cu = 1; }
        (void)hipGetLastError();
        grid_blocks = cus * per_cu;
        if (ws_size < WS_END) fprintf(stderr, "workspace too small: %zu < %zu\n", ws_size, (size_t)WS_END);
    }
    Params p{};
    p.x = (const float*)d_in[0]; p.c = (const float*)d_in[1]; p.ctx = (const float*)d_in[2]; p.c_ctx = (const float*)d_in[3]; p.ada_w = (const float*)d_in[4];
    p.ada_b = (const float*)d_in[5]; p.norm1_g = (const float*)d_in[6]; p.w_in = (const float*)d_in[7]; p.ret_decay = (const float*)d_in[8];
    p.gate_up = (const float*)d_in[9]; p.gate_b = (const float*)d_in[10]; p.gla_norm_g = (const float*)d_in[11]; p.w_out = (const float*)d_in[12];
    p.norm2_g = (const float*)d_in[13]; p.w_mlp1 = (const float*)d_in[14]; p.w_mlp2 = (const float*)d_in[15]; p.final_g = (const float*)d_in[16];
    p.out = (float*)d_out; p.ws = (unsigned char*)d_ws;
#if MULTI
    for (int ph = 0; ph < NPHASE; ++ph) {
        p.ph_lo = ph; p.ph_hi = ph + 1;
        hipLaunchKernelGGL(fwd_megakernel, dim3(grid_blocks), dim3(512), LDS_BYTES, stream, p);
    }
#else
    p.ph_lo = 0; p.ph_hi = NPHASE;
    void* args[] = {&p};
    hipError_t e = hipLaunchCooperativeKernel((const void*)fwd_megakernel, dim3(grid_blocks), dim3(512), args, LDS_BYTES, stream);
    if (e != hipSuccess) fprintf(stderr, "cooperative launch failed: %s (grid %d)\n", hipGetErrorString(e), grid_blocks);
#endif
}
```

```cpp
#include <hip/hip_runtime.h>
#include <hip/hip_cooperative_groups.h>
#include <cstdio>
namespace cg = cooperative_groups;

#ifndef MULTI
#define MULTI 0
#endif

#define LAS __attribute__((address_space(3)))
typedef unsigned short bf16_t;
typedef short bf16x8 __attribute__((ext_vector_type(8)));
typedef float f32x4 __attribute__((ext_vector_type(4)));
typedef unsigned u32x2 __attribute__((ext_vector_type(2)));
typedef unsigned u32x4 __attribute__((ext_vector_type(4)));

constexpr int DM = 1024, NB = 8, SEQ = 4096, CTXL = 256, NLAT = NB * SEQ, NCTX = NB * CTXL, MTOT = NLAT + NCTX;
constexpr int INW = 3616, INWP = 3840, DFF = 4096;
constexpr int NPHASE = 18;
constexpr int LDS_BYTES = 131072;

constexpr size_t WS_WIN = 0;
constexpr size_t WS_WOUT = WS_WIN + (size_t)2 * INWP * DM * 2;
constexpr size_t WS_W1 = WS_WOUT + (size_t)2 * DM * DM * 2;
constexpr size_t WS_W2 = WS_W1 + (size_t)2 * DFF * DM * 2;
constexpr size_t WS_MOD = WS_W2 + (size_t)2 * DM * DFF * 2;
constexpr size_t WS_TAB = WS_MOD + (size_t)2 * 9 * 6 * DM * 4;
constexpr size_t WS_XCTX = WS_TAB + (size_t)2 * 2048 * 4;
constexpr size_t WS_H = WS_XCTX + (size_t)NCTX * DM * 4;
constexpr size_t WS_P = WS_H + (size_t)MTOT * DM * 2;
constexpr size_t WS_OB = WS_P + (size_t)MTOT * INW * 2;
constexpr size_t WS_END = WS_OB + (size_t)MTOT * DM * 2;
static_assert((size_t)MTOT * DFF * 2 <= WS_END - WS_P, "hmlp alias");
static_assert(WS_END <= (size_t)536870912, "ws");

struct Params {
    const float* x; const float* c; const float* ctx; const float* c_ctx; const float* ada_w; const float* ada_b; const float* norm1_g;
    const float* w_in; const float* ret_decay; const float* gate_up; const float* gate_b; const float* gla_norm_g; const float* w_out;
    const float* norm2_g; const float* w_mlp1; const float* w_mlp2; const float* final_g;
    float* out; unsigned char* ws; int ph_lo, ph_hi;
};

typedef float f32x2_t __attribute__((ext_vector_type(2)));
typedef __bf16 bf16x2_t __attribute__((ext_vector_type(2)));
__device__ __forceinline__ unsigned cvt_pk_bf16(float lo, float hi) { f32x2_t v = {lo, hi}; bf16x2_t b = __builtin_convertvector(v, bf16x2_t); return __builtin_bit_cast(unsigned, b); }
__device__ __forceinline__ bf16_t f2bf(float f) { return (bf16_t)(cvt_pk_bf16(f, 0.f) & 0xffffu); }
__device__ __forceinline__ float bf2f(short b) { return __uint_as_float(((unsigned)(unsigned short)b) << 16); }
__device__ __forceinline__ int otid() { int t = threadIdx.x; asm volatile("" : "+v"(t)); return t; }
__device__ __forceinline__ float silu_f(float v) { return v / (1.f + __expf(-v)); }

namespace pg8 {
constexpr int BM = 256, BK = 64, HALF = 128, HTB = HALF * BK * 2, STAGE_BYTES = 8 * HTB, NXCD = 8, WGM = 8;
__host__ __device__ __forceinline__ int lds_byte(int r, int c) { const int st = (r >> 4) * 2 + (c >> 5), rr = r & 15, cc = c & 31, ob = rr * 64 + cc * 2; return st * 1024 + (ob ^ (((ob >> 9) & 1) << 5)); }
__host__ __device__ __forceinline__ void stage_rc(int b, int& R, int& C) { const int st = b / 1024, sb = b % 1024, swz = sb ^ (((sb >> 9) & 1) << 5); R = (st >> 1) * 16 + swz / 64; C = (st & 1) * 32 + (swz % 64) / 2; }
__host__ __device__ __forceinline__ int perm32(int rho) { const int n = rho >> 4, i = rho & 15; return 8 * (i >> 2) + 4 * n + (i & 3); }
struct Unit { int pm, pn; };
struct Gemm { const bf16_t* A; const bf16_t* Bt; int M, N, K; };
struct StaticOrder {
    int nM, nN, nwg, G, c;
    __host__ __device__ void init(int M, int N, int G_, int c_) { nM = M / BM; nN = N / BM; nwg = nM * nN; G = G_; c = c_; }
    __host__ __device__ bool next(int i, Unit& u) const {
        const long L = (long)i * G + c; if (L >= nwg) return false;
        int wgid = (int)L; { const int q = nwg / NXCD, r = nwg % NXCD, xcd = wgid % NXCD, off = wgid / NXCD; wgid = (xcd < r ? xcd * (q + 1) : r * (q + 1) + (xcd - r) * q) + off; }
        const int nig = WGM * nN, gid = wgid / nig, fm = gid * WGM, gsz = (nM - fm) < WGM ? (nM - fm) : WGM;
        u.pm = fm + ((wgid % nig) % gsz); u.pn = (wgid % nig) / gsz; return true;
    }
    __device__ __forceinline__ void a_ready(const Unit&) const {}
    __device__ __forceinline__ void done(const Unit&) const {}
};

template <class Epi, class Sched>
__device__ __forceinline__ void gemm_phase(LAS unsigned char* lds, const Gemm g, const Sched& S, const Epi& E) {
    const int tid = otid(), wid = __builtin_amdgcn_readfirstlane(tid >> 6), lane = tid & 63, wr = wid >> 2, wc = wid & 3, fr = lane & 15, fq = lane >> 4;
    const int K = g.K, nt = K / BK;
    unsigned voffA[2], voffB[2];
#pragma unroll
    for (int i = 0; i < 2; ++i) { int R, C; stage_rc(tid * 16 + i * 8192, R, C); const int Rb = Epi::PERM ? ((R & ~31) + perm32(R & 31)) : R;
        voffA[i] = (unsigned)(R * K + C) * 2u; voffB[i] = (unsigned)(Rb * K + C) * 2u; }
    const size_t kstep = (size_t)(BK * 2);
    const size_t hstep = (size_t)HALF * K * 2;
    const size_t tstep = 2 * hstep;
    const unsigned ldsw = (unsigned)wid * 1024u;
    const int aoff = lds_byte(wr * 64 + fr, fq * 8), boff = lds_byte(wc * 32 + fr, fq * 8);
#define PG8_SA(b, h) (((b) * 2 + (h)) * HTB)
#define PG8_SB(b, h) ((4 + (b) * 2 + (h)) * HTB)
#define PG8_STAGE(bufoff, gbase, voff) do { _Pragma("unroll") for (int _i = 0; _i < 2; ++_i) \
        __builtin_amdgcn_global_load_lds((const unsigned*)((const char*)(gbase) + (voff)[_i]), (LAS unsigned*)(lds + (bufoff) + ldsw + _i * 8192), 16, 0, 0); } while (0)
#define PG8_LDA(dst, b, h) do { _Pragma("unroll") for (int m = 0; m < 4; ++m) _Pragma("unroll") for (int k = 0; k < 2; ++k) dst[m][k] = *(const LAS bf16x8*)(lds + PG8_SA(b, h) + aoff + m * 2048 + k * 1024); } while (0)
#define PG8_LDB(dst, b, h) do { _Pragma("unroll") for (int n = 0; n < 2; ++n) _Pragma("unroll") for (int k = 0; k < 2; ++k) dst[n][k] = *(const LAS bf16x8*)(lds + PG8_SB(b, h) + boff + n * 2048 + k * 1024); } while (0)
#define PG8_MMA(ai, bj, At, Bt) do { __builtin_amdgcn_s_setprio(1); _Pragma("unroll") for (int m = 0; m < 4; ++m) _Pragma("unroll") for (int n = 0; n < 2; ++n) _Pragma("unroll") for (int k = 0; k < 2; ++k) \
        acc[ai][bj][m][n] = __builtin_amdgcn_mfma_f32_16x16x32_bf16(Bt[n][k], At[m][k], acc[ai][bj][m][n], 0, 0, 0); __builtin_amdgcn_s_setprio(0); } while (0)
#define PG8_WAIT_V(n) asm volatile("s_waitcnt vmcnt(" #n ")" ::: "memory")
#define PG8_WAIT_L(n) asm volatile("s_waitcnt lgkmcnt(" #n ")" ::: "memory")
#define PG8_BAR __builtin_amdgcn_s_barrier()
#define PG8_SCHED __builtin_amdgcn_sched_barrier(0)
    Unit cur, nxt; int ui = 0;
    if (!S.next(0, cur)) return;
    f32x4 acc[2][2][4][2];
#pragma unroll
    for (int a = 0; a < 2; ++a)
#pragma unroll
        for (int b = 0; b < 2; ++b)
#pragma unroll
            for (int m = 0; m < 4; ++m)
#pragma unroll
                for (int n = 0; n < 2; ++n) acc[a][b][m][n] = (f32x4){0.f, 0.f, 0.f, 0.f};
    bf16x8 At[4][2], B0[2][2], B1[2][2];
    const char* cA = (const char*)g.A + (size_t)cur.pm * tstep; const char* cB = (const char*)g.Bt + (size_t)cur.pn * tstep;
    S.a_ready(cur);
    PG8_STAGE(PG8_SB(0, 0), cB, voffB); PG8_STAGE(PG8_SA(0, 0), cA, voffA); PG8_STAGE(PG8_SB(0, 1), cB + hstep, voffB); PG8_STAGE(PG8_SA(0, 1), cA + hstep, voffA);
    if (wr == 1) PG8_BAR;
    PG8_WAIT_V(4); PG8_BAR;
    PG8_STAGE(PG8_SB(1, 0), cB + kstep, voffB); PG8_STAGE(PG8_SA(1, 0), cA + kstep, voffA); PG8_STAGE(PG8_SB(1, 1), cB + hstep + kstep, voffB);
    PG8_WAIT_V(6); PG8_BAR;
    for (;;) {
        const bool has_next = S.next(ui + 1, nxt);
        const char* nA = has_next ? (const char*)g.A + (size_t)nxt.pm * tstep : cA; const char* nB = has_next ? (const char*)g.Bt + (size_t)nxt.pn * tstep : cB;
        for (int t = 0; t < nt; t += 2) {
            const bool last = (t == nt - 2);
            const char* a1 = cA + (size_t)(t + 1) * kstep;
            const char* a2 = last ? nA : cA + (size_t)(t + 2) * kstep; const char* b2 = last ? nB : cB + (size_t)(t + 2) * kstep;
            const char* a3 = a2 + kstep; const char* b3 = b2 + kstep;
            if (last && has_next) S.a_ready(nxt);
            PG8_LDB(B0, 0, 0); PG8_SCHED; PG8_LDA(At, 0, 0); PG8_STAGE(PG8_SA(1, 1), a1 + hstep, voffA);
            PG8_WAIT_L(8); PG8_BAR; PG8_WAIT_L(0); PG8_MMA(0, 0, At, B0); PG8_BAR; PG8_SCHED;
            PG8_LDB(B1, 0, 1); PG8_STAGE(PG8_SB(0, 0), b2, voffB);
            PG8_BAR; PG8_WAIT_L(0); PG8_MMA(0, 1, At, B1); PG8_BAR;
            PG8_LDA(At, 0, 1); PG8_STAGE(PG8_SA(0, 0), a2, voffA);
            PG8_BAR; PG8_WAIT_L(0); PG8_MMA(1, 0, At, B0); PG8_BAR; PG8_SCHED;
            PG8_STAGE(PG8_SB(0, 1), b2 + hstep, voffB);
            PG8_WAIT_V(6); PG8_BAR; PG8_MMA(1, 1, At, B1); PG8_BAR;
            PG8_LDB(B0, 1, 0); PG8_SCHED; PG8_LDA(At, 1, 0); PG8_STAGE(PG8_SA(0, 1), a2 + hstep, voffA);
            PG8_WAIT_L(8); PG8_BAR; PG8_WAIT_L(0); PG8_MMA(0, 0, At, B0); PG8_BAR; PG8_SCHED;
            PG8_LDB(B1, 1, 1); PG8_STAGE(PG8_SB(1, 0), b3, voffB);
            PG8_BAR; PG8_WAIT_L(0); PG8_MMA(0, 1, At, B1); PG8_BAR;
            PG8_LDA(At, 1, 1); PG8_STAGE(PG8_SA(1, 0), a3, voffA);
            PG8_BAR; PG8_WAIT_L(0); PG8_MMA(1, 0, At, B0); PG8_BAR; PG8_SCHED;
            PG8_STAGE(PG8_SB(1, 1), b3 + hstep, voffB);
            PG8_WAIT_V(6); PG8_BAR; PG8_MMA(1, 1, At, B1); PG8_BAR;
        }
        E(acc, cur, wr, wc, fr, fq);
        if (!has_next) break;
#pragma unroll
        for (int a = 0; a < 2; ++a)
#pragma unroll
            for (int b = 0; b < 2; ++b)
#pragma unroll
                for (int m = 0; m < 4; ++m)
#pragma unroll
                    for (int n = 0; n < 2; ++n) acc[a][b][m][n] = (f32x4){0.f, 0.f, 0.f, 0.f};
        cur = nxt; cA = nA; cB = nB; ++ui;
    }
    PG8_WAIT_V(0);
    if (wr == 0) PG8_BAR;
    PG8_BAR;
#undef PG8_SA
#undef PG8_SB
#undef PG8_STAGE
#undef PG8_LDA
#undef PG8_LDB
#undef PG8_MMA
#undef PG8_WAIT_V
#undef PG8_WAIT_L
#undef PG8_BAR
#undef PG8_SCHED
}
}

struct EpiP {
    static constexpr bool PERM = false;
    bf16_t* P;
    __device__ __forceinline__ void operator()(const f32x4 (&acc)[2][2][4][2], const pg8::Unit& u, int wr, int wc, int fr, int fq) const {
        const int row0 = u.pm * 256 + wr * 64 + fr, col0 = u.pn * 256 + wc * 32 + 4 * fq;
#pragma unroll
        for (int ai = 0; ai < 2; ++ai)
#pragma unroll
            for (int m = 0; m < 4; ++m) { bf16_t* rowp = P + (size_t)(row0 + ai * 128 + m * 16) * INW;
#pragma unroll
                for (int bj = 0; bj < 2; ++bj)
#pragma unroll
                    for (int n = 0; n < 2; ++n) { const int c = col0 + bj * 128 + n * 16; const f32x4 v = acc[ai][bj][m][n];
                        if (c < INW) { u32x2 w2; w2.x = cvt_pk_bf16(v[0], v[1]); w2.y = cvt_pk_bf16(v[2], v[3]); *(u32x2*)(rowp + c) = w2; } } }
    }
};
struct EpiRelu2 {
    static constexpr bool PERM = false;
    bf16_t* O;
    __device__ __forceinline__ void operator()(const f32x4 (&acc)[2][2][4][2], const pg8::Unit& u, int wr, int wc, int fr, int fq) const {
        const int row0 = u.pm * 256 + wr * 64 + fr, col0 = u.pn * 256 + wc * 32 + 4 * fq;
#pragma unroll
        for (int ai = 0; ai < 2; ++ai)
#pragma unroll
            for (int m = 0; m < 4; ++m) { bf16_t* rowp = O + (size_t)(row0 + ai * 128 + m * 16) * DFF;
#pragma unroll
                for (int bj = 0; bj < 2; ++bj)
#pragma unroll
                    for (int n = 0; n < 2; ++n) { const int c = col0 + bj * 128 + n * 16; f32x4 v = acc[ai][bj][m][n];
#pragma unroll
                        for (int j = 0; j < 4; ++j) { const float r = fmaxf(v[j], 0.f); v[j] = r * r; }
                        u32x2 w2; w2.x = cvt_pk_bf16(v[0], v[1]); w2.y = cvt_pk_bf16(v[2], v[3]); *(u32x2*)(rowp + c) = w2; } }
    }
};
struct EpiRes {
    static constexpr bool PERM = false;
    const float* xin_lat; const float* xin_ctx; float* xout_lat; float* xout_ctx; const float* gate;
    __device__ __forceinline__ void operator()(const f32x4 (&acc)[2][2][4][2], const pg8::Unit& u, int wr, int wc, int fr, int fq) const {
        const int row0 = u.pm * 256 + wr * 64 + fr, col0 = u.pn * 256 + wc * 32 + 4 * fq;
        const int rb = u.pm * 256;
        const bool isctx = rb >= NLAT;
        const int bidx = isctx ? 8 : (rb >> 12);
        const float* xi = isctx ? xin_ctx - (size_t)NLAT * DM : xin_lat;
        float* xo = isctx ? xout_ctx - (size_t)NLAT * DM : xout_lat;
        const float* gp = gate + (size_t)bidx * 6 * DM;
        f32x4 gv[2][2];
#pragma unroll
        for (int bj = 0; bj < 2; ++bj)
#pragma unroll
            for (int n = 0; n < 2; ++n) gv[bj][n] = *(const f32x4*)(gp + col0 + bj * 128 + n * 16);
#pragma unroll
        for (int ai = 0; ai < 2; ++ai)
#pragma unroll
            for (int m = 0; m < 4; ++m) { const size_t ro = (size_t)(row0 + ai * 128 + m * 16) * DM;
#pragma unroll
                for (int bj = 0; bj < 2; ++bj)
#pragma unroll
                    for (int n = 0; n < 2; ++n) { const int c = col0 + bj * 128 + n * 16; const f32x4 xv = *(const f32x4*)(xi + ro + c);
                        *(f32x4*)(xo + ro + c) = xv + gv[bj][n] * acc[ai][bj][m][n]; } }
    }
};

__device__ void transpose_tile(const float* __restrict__ src, int K, int N, bf16_t* __restrict__ dst, int tk, int tn, float* tile) {
    const int tid = otid(), k0 = tk * 64, n0 = tn * 64, cl = tid & 63, r0 = tid >> 6;
#pragma unroll
    for (int i = 0; i < 8; ++i) { const int r = r0 + 8 * i, n = n0 + cl; tile[r * 65 + cl] = (n < N) ? src[(size_t)(k0 + r) * N + n] : 0.f; }
    __syncthreads();
#pragma unroll
    for (int i = 0; i < 8; ++i) { const int rn = r0 + 8 * i; dst[(size_t)(n0 + rn) * K + k0 + cl] = f2bf(tile[cl * 65 + rn]); }
    __syncthreads();
}
__device__ void phase_prep(const Params& p, unsigned char* lds) {
    float* tile = (float*)lds;
    const int tid = otid();
    constexpr int T_IN = 16 * 60, T_OUT = 16 * 16, T_1 = 16 * 64, T_2 = 64 * 16, T_L = T_IN + T_OUT + T_1 + T_2;
    for (int t = blockIdx.x; t < 2 * T_L; t += gridDim.x) {
        const int l = t / T_L; int r = t % T_L;
        if (r < T_IN) transpose_tile(p.w_in + (size_t)l * DM * INW, DM, INW, (bf16_t*)(p.ws + WS_WIN) + (size_t)l * INWP * DM, r / 60, r % 60, tile);
        else if ((r -= T_IN) < T_OUT) transpose_tile(p.w_out + (size_t)l * DM * DM, DM, DM, (bf16_t*)(p.ws + WS_WOUT) + (size_t)l * DM * DM, r / 16, r % 16, tile);
        else if ((r -= T_OUT) < T_1) transpose_tile(p.w_mlp1 + (size_t)l * DM * DFF, DM, DFF, (bf16_t*)(p.ws + WS_W1) + (size_t)l * DFF * DM, r / 64, r % 64, tile);
        else { r -= T_1; transpose_tile(p.w_mlp2 + (size_t)l * DFF * DM, DFF, DM, (bf16_t*)(p.ws + WS_W2) + (size_t)l * DM * DFF, r / 16, r % 16, tile); }
    }
    float* red = (float*)lds;
    const int w = tid >> 6, lane = tid & 63;
    for (int it = blockIdx.x; it < 2 * 96; it += gridDim.x) {
        const int l = it / 96, j0 = (it % 96) * 64;
        float a[9];
#pragma unroll
        for (int r = 0; r < 9; ++r) a[r] = 0.f;
        const float* wp = p.ada_w + (size_t)l * DM * 6 * DM + j0 + lane;
        for (int k = w * 128; k < w * 128 + 128; ++k) {
            const float wv = wp[(size_t)k * 6 * DM];
#pragma unroll
            for (int r = 0; r < 9; ++r) { const float cv = (r < 8) ? p.c[r * DM + k] : p.c_ctx[k]; a[r] += silu_f(cv) * wv; }
        }
        __syncthreads();
#pragma unroll
        for (int r = 0; r < 9; ++r) red[(w * 9 + r) * 64 + lane] = a[r];
        __syncthreads();
        for (int idx = tid; idx < 9 * 64; idx += 512) { const int r = idx >> 6, ln = idx & 63; float s = 0.f;
#pragma unroll
            for (int ww = 0; ww < 8; ++ww) s += red[(ww * 9 + r) * 64 + ln];
            ((float*)(p.ws + WS_MOD))[((size_t)l * 9 + r) * 6 * DM + j0 + ln] = s + p.ada_b[(size_t)l * 6 * DM + j0 + ln]; }
    }
    if (blockIdx.x == gridDim.x - 1) {
        float* tab = (float*)(p.ws + WS_TAB);
        for (int idx = tid; idx < 2048; idx += 512) { const int pos = idx >> 5, i = idx & 31; const float inv = powf(10000.0f, -(float)i / 32.0f); const float ang = (float)pos * inv;
            tab[idx] = cosf(ang); tab[2048 + idx] = sinf(ang); }
    }
    __syncthreads();
}

__device__ __forceinline__ const float* xrow(const float* lat, const float* ctx, int m) { return m < NLAT ? lat + (size_t)m * DM : ctx + (size_t)(m - NLAT) * DM; }
__device__ void phase_norm(const Params& p, const float* xl, const float* xc, const float* g, const float* mod_l, int sh_off, int nrows) {
    const int tid_ = otid(); const int lane = tid_ & 63, gw = blockIdx.x * 8 + (tid_ >> 6), nw = gridDim.x * 8;
    bf16_t* H = (bf16_t*)(p.ws + WS_H);
    for (int m = gw; m < nrows; m += nw) {
        const float* xr = xrow(xl, xc, m);
        const int b = m < NLAT ? (m >> 12) : 8;
        const float* sh = mod_l + (size_t)b * 6 * DM + sh_off; const float* sc = sh + DM;
        f32x4 v[4]; float ss = 0.f;
#pragma unroll
        for (int i = 0; i < 4; ++i) { v[i] = *(const f32x4*)(xr + 4 * lane + 256 * i); ss += v[i][0] * v[i][0] + v[i][1] * v[i][1] + v[i][2] * v[i][2] + v[i][3] * v[i][3]; }
#pragma unroll
        for (int o = 32; o >= 1; o >>= 1) ss += __shfl_xor(ss, o);
        const float rinv = rsqrtf(ss * (1.0f / DM) + 1e-6f);
#pragma unroll
        for (int i = 0; i < 4; ++i) { const int c = 4 * lane + 256 * i; const f32x4 gg = *(const f32x4*)(g + c), s1 = *(const f32x4*)(sc + c), s0 = *(const f32x4*)(sh + c);
            f32x4 y;
#pragma unroll
            for (int j = 0; j < 4; ++j) y[j] = (v[i][j] * rinv * gg[j]) * (1.f + s1[j]) + s0[j];
            u32x2 w2; w2.x = cvt_pk_bf16(y[0], y[1]); w2.y = cvt_pk_bf16(y[2], y[3]); *(u32x2*)(H + (size_t)m * DM + c) = w2; }
    }
}
__device__ void phase_final(const Params& p) {
    const int tid_ = otid(); const int lane = tid_ & 63, gw = blockIdx.x * 8 + (tid_ >> 6), nw = gridDim.x * 8;
    for (int m = gw; m < NLAT; m += nw) {
        float* xr = p.out + (size_t)m * DM;
        f32x4 v[4]; float ss = 0.f;
#pragma unroll
        for (int i = 0; i < 4; ++i) { v[i] = *(const f32x4*)(xr + 4 * lane + 256 * i); ss += v[i][0] * v[i][0] + v[i][1] * v[i][1] + v[i][2] * v[i][2] + v[i][3] * v[i][3]; }
#pragma unroll
        for (int o = 32; o >= 1; o >>= 1) ss += __shfl_xor(ss, o);
        const float rinv = rsqrtf(ss * (1.0f / DM) + 1e-6f);
#pragma unroll
        for (int i = 0; i < 4; ++i) { const int c = 4 * lane + 256 * i; const f32x4 gg = *(const f32x4*)(p.final_g + c);
            f32x4 y;
#pragma unroll
            for (int j = 0; j < 4; ++j) y[j] = v[i][j] * rinv * gg[j];
            *(f32x4*)(xr + c) = y; }
    }
}

__device__ void phase_merge(const Params& p, int l, int nrows) {
    const int tid_ = otid(); const int lane = tid_ & 63, gw = blockIdx.x * 8 + (tid_ >> 6), nw = gridDim.x * 8;
    bf16_t* H = (bf16_t*)(p.ws + WS_H); const bf16_t* OB = (const bf16_t*)(p.ws + WS_OB); const bf16_t* P = (const bf16_t*)(p.ws + WS_P);
    const bool isgla = lane >= 32;
    const int gcol = isgla ? (2560 + 16 * lane) : (1536 + 16 * lane);
    const float* gn = p.gla_norm_g + l * 128 + ((16 * lane) & 127);
    for (int m = gw; m < nrows; m += nw) {
        const bf16x8 f0 = *(const bf16x8*)(H + (size_t)m * DM + 16 * lane), f1 = *(const bf16x8*)(H + (size_t)m * DM + 16 * lane + 8);
#ifdef NO_SCAN
        const bf16x8 b0 = (bf16x8){0,0,0,0,0,0,0,0}, b1 = b0; (void)OB;
#else
        const bf16x8 b0 = *(const bf16x8*)(OB + (size_t)m * DM + 16 * lane), b1 = *(const bf16x8*)(OB + (size_t)m * DM + 16 * lane + 8);
#endif
        const bf16x8 g0 = *(const bf16x8*)(P + (size_t)m * INW + gcol), g1 = *(const bf16x8*)(P + (size_t)m * INW + gcol + 8);
        float r[16]; float s1 = 0.f, s2 = 0.f;
#pragma unroll
        for (int j = 0; j < 8; ++j) { r[j] = bf2f(f0[j]) + bf2f(b0[j]); r[8 + j] = bf2f(f1[j]) + bf2f(b1[j]); }
#ifdef SANITIZE
#pragma unroll
        for (int j = 0; j < 16; ++j) { if (!(fabsf(r[j]) < 1e30f)) r[j] = 0.f; }
#endif
#ifdef SKIP_GLA
        if (isgla) {
#pragma unroll
            for (int j = 0; j < 16; ++j) r[j] = 0.f; }
#endif
#ifdef SKIP_RET
        if (!isgla) {
#pragma unroll
            for (int j = 0; j < 16; ++j) r[j] = 0.f; }
#endif
#pragma unroll
        for (int j = 0; j < 16; ++j) { s1 += r[j]; s2 += r[j] * r[j]; }
#pragma unroll
        for (int o = 1; o <= 4; o <<= 1) { s1 += __shfl_xor(s1, o); s2 += __shfl_xor(s2, o); }
        float y[16];
        if (!isgla) {
            const float mu = s1 * (1.f / 128.f); float sv = 0.f;
#pragma unroll
            for (int j = 0; j < 16; ++j) { const float d = r[j] - mu; sv += d * d; }
#pragma unroll
            for (int o = 1; o <= 4; o <<= 1) sv += __shfl_xor(sv, o);
            const float rs = rsqrtf(sv * (1.f / 128.f) + 1e-6f);
#pragma unroll
            for (int j = 0; j < 16; ++j) y[j] = (r[j] - mu) * rs;
        } else {
            float sv = 0.f;
#pragma unroll
            for (int o = 1; o <= 4; o <<= 1) sv += __shfl_xor(sv, o);
            const float rs = rsqrtf(s2 * (1.f / 128.f) + 1e-6f);
#pragma unroll
            for (int j = 0; j < 16; ++j) y[j] = r[j] * rs * gn[j] + 0.f * sv;
        }
        u32x4 o0, o1;
#pragma unroll
        for (int j = 0; j < 8; ++j) { y[j] *= silu_f(bf2f(g0[j])); y[8 + j] *= silu_f(bf2f(g1[j])); }
        o0.x = cvt_pk_bf16(y[0], y[1]); o0.y = cvt_pk_bf16(y[2], y[3]); o0.z = cvt_pk_bf16(y[4], y[5]); o0.w = cvt_pk_bf16(y[6], y[7]);
        o1.x = cvt_pk_bf16(y[8], y[9]); o1.y = cvt_pk_bf16(y[10], y[11]); o1.z = cvt_pk_bf16(y[12], y[13]); o1.w = cvt_pk_bf16(y[14], y[15]);
        *(u32x4*)(H + (size_t)m * DM + 16 * lane) = o0; *(u32x4*)(H + (size_t)m * DM + 16 * lane + 8) = o1;
    }
}

template <int DK, bool GLA>
__device__ __forceinline__ void scan_item(const Params& p, int l, unsigned char* lds, int b, int h, int dir, int dvs) {
    constexpr int QS = DK + 8, TS = 72, NT = DK / 32, NKS = DK / 32;
    bf16_t* QD = (bf16_t*)lds;
    bf16_t* KI = QD + 64 * QS;
    bf16_t* ST = KI + 64 * QS;
    bf16_t* KET = ST + 64 * QS;
    bf16_t* VT = KET + DK * TS;
    bf16_t* SC = VT + 64 * TS;
    float* DVEC = (float*)(SC + 64 * TS);
    float* CL = DVEC + DK;
    float* CUM = CL + DK;
    float* UP = CUM + 64 * 68;
    const int tid = otid(), lane = tid & 63, w = tid >> 6, fr = lane & 15, fq = lane >> 4;
    const bf16_t* P = (const bf16_t*)(p.ws + WS_P);
    bf16_t* O = (bf16_t*)(p.ws + (dir ? WS_OB : WS_H));
    const float* TABC = (const float*)(p.ws + WS_TAB); const float* TABS = TABC + 2048;
    const int ocol = (GLA ? 512 : 0) + 128 * h + 64 * dvs;
    const int qcol = GLA ? 2048 + 64 * h : 128 * h, kcol = GLA ? 2304 + 64 * h : 512 + 128 * h, vcol = (GLA ? 2560 : 1024) + 128 * h + 64 * dvs;
    float g = 0.f;
    if (!GLA) g = log1pf(-__expf(p.ret_decay[l * 8 + dir * 4 + h]));
    const int dkt = (DK == 128) ? w : (w >> 1);
    const int dvt0 = (DK == 128) ? 0 : 2 * (w & 1);
    f32x4 S[NT];
#pragma unroll
    for (int i = 0; i < NT; ++i) S[i] = (f32x4){0.f, 0.f, 0.f, 0.f};
    __syncthreads();
    for (int i = tid; i < 64 * QS / 2; i += 512) ((unsigned*)ST)[i] = 0u;
    if (GLA) {
        for (int i = tid; i < 16 * 64; i += 512) UP[i] = p.gate_up[((size_t)(l * 2 + dir) * 16 + (i >> 6)) * 256 + 64 * h + (i & 63)];
        if (tid < 64) UP[1024 + tid] = p.gate_b[(l * 2 + dir) * 256 + 64 * h + tid];
    } else {
        if (tid < DK) DVEC[tid] = __expf(64.f * g);
    }
    __syncthreads();
    for (int step = 0; step < 68; ++step) {
        const bool isctx = step < 4;
        const int chunk = dir == 0 ? (isctx ? step : step - 4) : (isctx ? 3 - step : 67 - step);
        const int m0 = isctx ? (NLAT + b * CTXL + chunk * 64) : (b * SEQ + chunk * 64);
        if (GLA) {
            const bf16_t* dp = P + (size_t)(m0 + lane) * INW + 3584 + 16 * dir;
            const bf16x8 d0 = *(const bf16x8*)dp, d1 = *(const bf16x8*)(dp + 8);
            float df[16];
#pragma unroll
            for (int r = 0; r < 8; ++r) { df[r] = bf2f(d0[r]); df[8 + r] = bf2f(d1[r]); }
#pragma unroll
            for (int c = 0; c < 8; ++c) {
                const int ch = 8 * w + c;
                float z = UP[1024 + ch];
#pragma unroll
                for (int r = 0; r < 16; ++r) z += df[r] * UP[r * 64 + ch];
                float v = (fminf(z, 0.f) - log1pf(__expf(-fabsf(z)))) * (1.0f / 16.0f);
                if (dir == 0) {
#pragma unroll
                    for (int o = 1; o < 64; o <<= 1) { const float t = __shfl_up(v, o); if (lane >= o) v += t; }
                } else {
#pragma unroll
                    for (int o = 1; o < 64; o <<= 1) { const float t = __shfl_down(v, o); if (lane + o < 64) v += t; }
                }
                CUM[lane * 68 + ch] = v;
                const float tot = __shfl(v, dir == 0 ? 63 : 0);
                if (lane == 0) { CL[ch] = tot; DVEC[ch] = __expf(tot); }
            }
            __syncthreads();
        }
        {
            const int s = tid >> 3;
            const bf16_t* rowp = P + (size_t)(m0 + s) * INW;
            if (!GLA) {
                const int pr = tid & 7, c8a = (pr & 3) + 8 * (pr >> 2);
                const bf16x8 q1 = *(const bf16x8*)(rowp + qcol + 8 * c8a), q2 = *(const bf16x8*)(rowp + qcol + 8 * (c8a + 4));
                const bf16x8 k1 = *(const bf16x8*)(rowp + kcol + 8 * c8a), k2 = *(const bf16x8*)(rowp + kcol + 8 * (c8a + 4));
                const float cum = dir == 0 ? g * (float)(s + 1) : g * (float)(64 - s), cl = 64.f * g;
                const float eq = __expf(cum) * 0.08838834764831845f, eki = __expf(-cum), eke = __expf(cl - cum);
                float cs[8], sn[8];
                if (!isctx) {
                    const int pos = (pr >> 2) ? s : chunk;
                    const f32x4 c0 = *(const f32x4*)(TABC + pos * 32 + 8 * (pr & 3)), c1 = *(const f32x4*)(TABC + pos * 32 + 8 * (pr & 3) + 4);
                    const f32x4 s0 = *(const f32x4*)(TABS + pos * 32 + 8 * (pr & 3)), s1 = *(const f32x4*)(TABS + pos * 32 + 8 * (pr & 3) + 4);
#pragma unroll
                    for (int j = 0; j < 4; ++j) { cs[j] = c0[j]; cs[4 + j] = c1[j]; sn[j] = s0[j]; sn[4 + j] = s1[j]; }
                } else {
#pragma unroll
                    for (int j = 0; j < 8; ++j) { cs[j] = 1.f; sn[j] = 0.f; }
                }
                float qa[8], qb[8], ka[8], kb[8];
#pragma unroll
                for (int j = 0; j < 8; ++j) {
                    const float a1 = bf2f(q1[j]), a2 = bf2f(q2[j]), b1 = bf2f(k1[j]), b2 = bf2f(k2[j]);
                    qa[j] = a1 * cs[j] - a2 * sn[j]; qb[j] = a1 * sn[j] + a2 * cs[j];
                    ka[j] = b1 * cs[j] - b2 * sn[j]; kb[j] = b1 * sn[j] + b2 * cs[j];
                }
                u32x4 o;
                o.x = cvt_pk_bf16(qa[0] * eq, qa[1] * eq); o.y = cvt_pk_bf16(qa[2] * eq, qa[3] * eq); o.z = cvt_pk_bf16(qa[4] * eq, qa[5] * eq); o.w = cvt_pk_bf16(qa[6] * eq, qa[7] * eq);
                *(u32x4*)(QD + s * QS + 8 * c8a) = o;
                o.x = cvt_pk_bf16(qb[0] * eq, qb[1] * eq); o.y = cvt_pk_bf16(qb[2] * eq, qb[3] * eq); o.z = cvt_pk_bf16(qb[4] * eq, qb[5] * eq); o.w = cvt_pk_bf16(qb[6] * eq, qb[7] * eq);
                *(u32x4*)(QD + s * QS + 8 * (c8a + 4)) = o;
                o.x = cvt_pk_bf16(ka[0] * eki, ka[1] * eki); o.y = cvt_pk_bf16(ka[2] * eki, ka[3] * eki); o.z = cvt_pk_bf16(ka[4] * eki, ka[5] * eki); o.w = cvt_pk_bf16(ka[6] * eki, ka[7] * eki);
                *(u32x4*)(KI + s * QS + 8 * c8a) = o;
                o.x = cvt_pk_bf16(kb[0] * eki, kb[1] * eki); o.y = cvt_pk_bf16(kb[2] * eki, kb[3] * eki); o.z = cvt_pk_bf16(kb[4] * eki, kb[5] * eki); o.w = cvt_pk_bf16(kb[6] * eki, kb[7] * eki);
                *(u32x4*)(KI + s * QS + 8 * (c8a + 4)) = o;
#pragma unroll
                for (int j = 0; j < 8; ++j) { KET[(8 * c8a + j) * TS + s] = f2bf(ka[j] * eke); KET[(8 * (c8a + 4) + j) * TS + s] = f2bf(kb[j] * eke); }
            } else {
                const int c8 = tid & 7;
                const bf16x8 q1 = *(const bf16x8*)(rowp + qcol + 8 * c8), k1 = *(const bf16x8*)(rowp + kcol + 8 * c8);
                const f32x4 cu0 = *(const f32x4*)(CUM + s * 68 + 8 * c8), cu1 = *(const f32x4*)(CUM + s * 68 + 8 * c8 + 4);
                const f32x4 cl0 = *(const f32x4*)(CL + 8 * c8), cl1 = *(const f32x4*)(CL + 8 * c8 + 4);
                float qd[8], ki[8];
#pragma unroll
                for (int j = 0; j < 8; ++j) {
                    const float cu = j < 4 ? cu0[j & 3] : cu1[j & 3], cl = j < 4 ? cl0[j & 3] : cl1[j & 3];
                    const float qv = bf2f(q1[j]), kv = bf2f(k1[j]);
                    qd[j] = qv * 0.125f * __expf(cu); ki[j] = kv * __expf(-cu);
                    KET[(8 * c8 + j) * TS + s] = f2bf(kv * __expf(cl - cu));
                }
                u32x4 o;
                o.x = cvt_pk_bf16(qd[0], qd[1]); o.y = cvt_pk_bf16(qd[2], qd[3]); o.z = cvt_pk_bf16(qd[4], qd[5]); o.w = cvt_pk_bf16(qd[6], qd[7]);
                *(u32x4*)(QD + s * QS + 8 * c8) = o;
                o.x = cvt_pk_bf16(ki[0], ki[1]); o.y = cvt_pk_bf16(ki[2], ki[3]); o.z = cvt_pk_bf16(ki[4], ki[5]); o.w = cvt_pk_bf16(ki[6], ki[7]);
                *(u32x4*)(KI + s * QS + 8 * c8) = o;
            }
            {
                const int c8 = tid & 7;
                const bf16x8 v1 = *(const bf16x8*)(rowp + vcol + 8 * c8);
#pragma unroll
                for (int j = 0; j < 8; ++j) VT[(8 * c8 + j) * TS + s] = (bf16_t)v1[j];
            }
        }
        __syncthreads();
        {
            const int tt = w >> 1;
#pragma unroll
            for (int si = 0; si < 2; ++si) {
                const int st = 2 * (w & 1) + si;
                f32x4 acc = (f32x4){0.f, 0.f, 0.f, 0.f};
#pragma unroll
                for (int ks = 0; ks < NKS; ++ks) {
                    const bf16x8 a = *(const bf16x8*)(KI + (16 * st + fr) * QS + 32 * ks + 8 * fq);
                    const bf16x8 bb = *(const bf16x8*)(QD + (16 * tt + fr) * QS + 32 * ks + 8 * fq);
                    acc = __builtin_amdgcn_mfma_f32_16x16x32_bf16(a, bb, acc, 0, 0, 0);
                }
                const int t = 16 * tt + fr, s0 = 16 * st + 4 * fq;
                float v[4];
#pragma unroll
                for (int r = 0; r < 4; ++r) { const int s = s0 + r; const bool keep = dir == 0 ? (s <= t) : (s > t); v[r] = keep ? acc[r] : 0.f; }
                u32x2 w2; w2.x = cvt_pk_bf16(v[0], v[1]); w2.y = cvt_pk_bf16(v[2], v[3]);
                *(u32x2*)(SC + t * TS + s0) = w2;
            }
        }
        __syncthreads();
        {
            const int tt = w >> 1;
#pragma unroll
            for (int di = 0; di < 2; ++di) {
                const int dvt = 2 * (w & 1) + di;
                f32x4 acc = (f32x4){0.f, 0.f, 0.f, 0.f};
#pragma unroll
                for (int ks = 0; ks < 2; ++ks) {
                    const bf16x8 a = *(const bf16x8*)(VT + (16 * dvt + fr) * TS + 32 * ks + 8 * fq);
                    const bf16x8 bb = *(const bf16x8*)(SC + (16 * tt + fr) * TS + 32 * ks + 8 * fq);
                    acc = __builtin_amdgcn_mfma_f32_16x16x32_bf16(a, bb, acc, 0, 0, 0);
                }
#pragma unroll
                for (int ks = 0; ks < NKS; ++ks) {
                    const bf16x8 a = *(const bf16x8*)(ST + (16 * dvt + fr) * QS + 32 * ks + 8 * fq);
                    const bf16x8 bb = *(const bf16x8*)(QD + (16 * tt + fr) * QS + 32 * ks + 8 * fq);
                    acc = __builtin_amdgcn_mfma_f32_16x16x32_bf16(a, bb, acc, 0, 0, 0);
                }
                u32x2 w2; w2.x = cvt_pk_bf16(acc[0], acc[1]); w2.y = cvt_pk_bf16(acc[2], acc[3]);
                *(u32x2*)(O + (size_t)(m0 + 16 * tt + fr) * DM + ocol + 16 * dvt + 4 * fq) = w2;
            }
            const f32x4 dv4 = *(const f32x4*)(DVEC + 16 * dkt + 4 * fq);
#pragma unroll
            for (int i = 0; i < NT; ++i) {
                const int dvt = dvt0 + i;
                S[i] = S[i] * dv4;
#pragma unroll
                for (int ks = 0; ks < 2; ++ks) {
                    const bf16x8 a = *(const bf16x8*)(KET + (16 * dkt + fr) * TS + 32 * ks + 8 * fq);
                    const bf16x8 bb = *(const bf16x8*)(VT + (16 * dvt + fr) * TS + 32 * ks + 8 * fq);
                    S[i] = __builtin_amdgcn_mfma_f32_16x16x32_bf16(a, bb, S[i], 0, 0, 0);
                }
            }
        }
        __syncthreads();
#pragma unroll
        for (int i = 0; i < NT; ++i) {
            const int dvt = dvt0 + i;
            u32x2 w2; w2.x = cvt_pk_bf16(S[i][0], S[i][1]); w2.y = cvt_pk_bf16(S[i][2], S[i][3]);
            *(u32x2*)(ST + (16 * dvt + fr) * QS + 16 * dkt + 4 * fq) = w2;
        }
    }
    __syncthreads();
}
__device__ void phase_scan(const Params& p, int l, unsigned char* lds) {
    for (int it = blockIdx.x; it < 256; it += gridDim.x) {
        const int isgla = it & 1, r = it >> 1;
        const int dvs = r & 1, dir = (r >> 1) & 1, h = (r >> 2) & 3, b = r >> 4;
#ifdef SKIP_GLA
        if (isgla) continue;
#endif
#ifdef SKIP_RET
        if (!isgla) continue;
#endif
        if (isgla) scan_item<64, true>(p, l, lds, b, h, dir, dvs);
        else scan_item<128, false>(p, l, lds, b, h, dir, dvs);
    }
}

__global__ void __launch_bounds__(512, 2) fwd_megakernel(Params p) {
    extern __shared__ __attribute__((aligned(16))) unsigned char shm[];
    cg::grid_group grid = cg::this_grid();
    const float* MOD = (const float*)(p.ws + WS_MOD);
    for (int ph = p.ph_lo; ph < p.ph_hi; ++ph) {
        if (ph == 0) phase_prep(p, shm);
        else if (ph == NPHASE - 1) phase_final(p);
        else {
            const int l = (ph - 1) >> 3, sub = (ph - 1) & 7;
            const float* mod_l = MOD + (size_t)l * 9 * 6 * DM;
            const float* xin_lat = l == 0 ? p.x : p.out; const float* xin_ctx = l == 0 ? p.ctx : (const float*)(p.ws + WS_XCTX);
            float* xo_lat = p.out; float* xo_ctx = (float*)(p.ws + WS_XCTX);
            const int mrows = l == 0 ? MTOT : NLAT;
            bf16_t* H = (bf16_t*)(p.ws + WS_H); bf16_t* Pm = (bf16_t*)(p.ws + WS_P);
            pg8::StaticOrder S;
            if (sub == 0) phase_norm(p, xin_lat, xin_ctx, p.norm1_g + l * DM, mod_l, 0, MTOT);
#ifndef NO_G1
            else if (sub == 1) { pg8::Gemm g{H, (const bf16_t*)(p.ws + WS_WIN) + (size_t)l * INWP * DM, MTOT, INWP, DM}; S.init(g.M, g.N, gridDim.x, blockIdx.x);
                EpiP E{Pm}; pg8::gemm_phase(( LAS unsigned char*)shm, g, S, E); }
#endif
#ifndef NO_SCAN
            else if (sub == 2) phase_scan(p, l, shm);
#endif
            else if (sub == 3) phase_merge(p, l, mrows);
#ifndef NO_G2
            else if (sub == 4) { pg8::Gemm g{H, (const bf16_t*)(p.ws + WS_WOUT) + (size_t)l * DM * DM, mrows, DM, DM}; S.init(g.M, g.N, gridDim.x, blockIdx.x);
                EpiRes E{xin_lat, xin_ctx, xo_lat, xo_ctx, mod_l + 2 * DM}; pg8::gemm_phase((LAS unsigned char*)shm, g, S, E); }
#endif
            else if (sub == 5) phase_norm(p, xo_lat, xo_ctx, p.norm2_g + l * DM, mod_l, 3 * DM, mrows);
#ifndef NO_G3
            else if (sub == 6) { pg8::Gemm g{H, (const bf16_t*)(p.ws + WS_W1) + (size_t)l * DFF * DM, mrows, DFF, DM}; S.init(g.M, g.N, gridDim.x, blockIdx.x);
                EpiRelu2 E{Pm}; pg8::gemm_phase((LAS unsigned char*)shm, g, S, E); }
#endif
#ifndef NO_G4
            else if (sub == 7) { pg8::Gemm g{Pm, (const bf16_t*)(p.ws + WS_W2) + (size_t)l * DM * DFF, mrows, DM, DFF}; S.init(g.M, g.N, gridDim.x, blockIdx.x);
                EpiRes E{xo_lat, xo_ctx, xo_lat, xo_ctx, mod_l + 5 * DM}; pg8::gemm_phase((LAS unsigned char*)shm, g, S, E); }
#endif
        }
        if (ph + 1 < p.ph_hi) grid.sync();
    }
}

extern "C" void kernel_launch(void* const* d_in, const int* in_sizes, int n_in, void* d_out, int out_size, void* d_ws, size_t ws_size, hipStream_t stream) {
    static int grid_blocks = 0;
    if (!grid_blocks) {
        int dev = 0, cus = 0, per_cu = 0;
        hipGetDevice(&dev);
        hipDeviceGetAttribute(&cus, hipDeviceAttributeMultiprocessorCount, dev);
        if (hipFuncSetAttribute((const void*)fwd_megakernel, hipFuncAttributeMaxDynamicSharedMemorySize, LDS_BYTES) != hipSuccess) fprintf(stderr, "hipFuncSetAttribute failed\n");
        if (hipOccupancyMaxActiveBlocksPerMultiprocessor(&per_cu, (const void*)fwd_megakernel, 512, LDS_BYTES) != hipSuccess || per_cu < 1) { fprintf(stderr, "occupancy query: %d\n", per_cu); per_cu = 1; }
        (void)hipGetLastError();
        grid_blocks = cus * per_cu;
        if (ws_size < WS_END) fprintf(stderr, "workspace too small: %zu < %zu\n", ws_size, (size_t)WS_END);
    }
    Params p{};
    p.x = (const float*)d_in[0]; p.c = (const float*)d_in[1]; p.ctx = (const float*)d_in[2]; p.c_ctx = (const float*)d_in[3]; p.ada_w = (const float*)d_in[4];
    p.ada_b = (const float*)d_in[5]; p.norm1_g = (const float*)d_in[6]; p.w_in = (const float*)d_in[7]; p.ret_decay = (const float*)d_in[8];
    p.gate_up = (const float*)d_in[9]; p.gate_b = (const float*)d_in[10]; p.gla_norm_g = (const float*)d_in[11]; p.w_out = (const float*)d_in[12];
    p.norm2_g = (const float*)d_in[13]; p.w_mlp1 = (const float*)d_in[14]; p.w_mlp2 = (const float*)d_in[15]; p.final_g = (const float*)d_in[16];
    p.out = (float*)d_out; p.ws = (unsigned char*)d_ws;
#if MULTI
    for (int ph = 0; ph < NPHASE; ++ph) {
        p.ph_lo = ph; p.ph_hi = ph + 1;
        hipLaunchKernelGGL(fwd_megakernel, dim3(grid_blocks), dim3(512), LDS_BYTES, stream, p);
    }
#else
    p.ph_lo = 0; p.ph_hi = NPHASE;
    void* args[] = {&p};
    hipError_t e = hipLaunchCooperativeKernel((const void*)fwd_megakernel, dim3(grid_blocks), dim3(512), args, LDS_BYTES, stream);
    if (e != hipSuccess) fprintf(stderr, "cooperative launch failed: %s (grid %d)\n", hipGetErrorString(e), grid_blocks);
#endif
}
```

```cpp
#include <hip/hip_runtime.h>
#include <hip/hip_cooperative_groups.h>
#include <cstdio>
namespace cg = cooperative_groups;

#ifndef MULTI
#define MULTI 0
#endif

#define LAS __attribute__((address_space(3)))
typedef unsigned short bf16_t;
typedef short bf16x8 __attribute__((ext_vector_type(8)));
typedef float f32x4 __attribute__((ext_vector_type(4)));
typedef unsigned u32x2 __attribute__((ext_vector_type(2)));
typedef unsigned u32x4 __attribute__((ext_vector_type(4)));

constexpr int DM = 1024, NB = 8, SEQ = 4096, CTXL = 256, NLAT = NB * SEQ, NCTX = NB * CTXL, MTOT = NLAT + NCTX;
constexpr int INW = 3616, INWP = 3840, DFF = 4096;
constexpr int NPHASE = 18;
constexpr int LDS_BYTES = 131072;

constexpr size_t WS_WIN = 0;
constexpr size_t WS_WOUT = WS_WIN + (size_t)2 * INWP * DM * 2;
constexpr size_t WS_W1 = WS_WOUT + (size_t)2 * DM * DM * 2;
constexpr size_t WS_W2 = WS_W1 + (size_t)2 * DFF * DM * 2;
constexpr size_t WS_MOD = WS_W2 + (size_t)2 * DM * DFF * 2;
constexpr size_t WS_TAB = WS_MOD + (size_t)2 * 9 * 6 * DM * 4;
constexpr size_t WS_XCTX = WS_TAB + (size_t)2 * 2048 * 4;
constexpr size_t WS_H = WS_XCTX + (size_t)NCTX * DM * 4;
constexpr size_t WS_P = WS_H + (size_t)MTOT * DM * 2;
constexpr size_t WS_OB = WS_P + (size_t)MTOT * INW * 2;
constexpr size_t WS_END = WS_OB + (size_t)MTOT * DM * 2;
static_assert((size_t)MTOT * DFF * 2 <= WS_END - WS_P, "hmlp alias");
static_assert(WS_END <= (size_t)536870912, "ws");

struct Params {
    const float* x; const float* c; const float* ctx; const float* c_ctx; const float* ada_w; const float* ada_b; const float* norm1_g;
    const float* w_in; const float* ret_decay; const float* gate_up; const float* gate_b; const float* gla_norm_g; const float* w_out;
    const float* norm2_g; const float* w_mlp1; const float* w_mlp2; const float* final_g;
    float* out; unsigned char* ws; int ph_lo, ph_hi;
};

typedef float f32x2_t __attribute__((ext_vector_type(2)));
typedef __bf16 bf16x2_t __attribute__((ext_vector_type(2)));
__device__ __forceinline__ unsigned cvt_pk_bf16(float lo, float hi) { f32x2_t v = {lo, hi}; bf16x2_t b = __builtin_convertvector(v, bf16x2_t); return __builtin_bit_cast(unsigned, b); }
__device__ __forceinline__ bf16_t f2bf(float f) { return (bf16_t)(cvt_pk_bf16(f, 0.f) & 0xffffu); }
__device__ __forceinline__ float bf2f(short b) { return __uint_as_float(((unsigned)(unsigned short)b) << 16); }
__device__ __forceinline__ int otid() { int t = threadIdx.x; asm volatile("" : "+v"(t)); return t; }
__device__ __forceinline__ float silu_f(float v) { return v / (1.f + __expf(-v)); }

namespace pg8 {
constexpr int BM = 256, BK = 64, HALF = 128, HTB = HALF * BK * 2, STAGE_BYTES = 8 * HTB, NXCD = 8, WGM = 8;
__host__ __device__ __forceinline__ int lds_byte(int r, int c) { const int st = (r >> 4) * 2 + (c >> 5), rr = r & 15, cc = c & 31, ob = rr * 64 + cc * 2; return st * 1024 + (ob ^ (((ob >> 9) & 1) << 5)); }
__host__ __device__ __forceinline__ void stage_rc(int b, int& R, int& C) { const int st = b / 1024, sb = b % 1024, swz = sb ^ (((sb >> 9) & 1) << 5); R = (st >> 1) * 16 + swz / 64; C = (st & 1) * 32 + (swz % 64) / 2; }
__host__ __device__ __forceinline__ int perm32(int rho) { const int n = rho >> 4, i = rho & 15; return 8 * (i >> 2) + 4 * n + (i & 3); }
struct Unit { int pm, pn; };
struct Gemm { const bf16_t* A; const bf16_t* Bt; int M, N, K; };
struct StaticOrder {
    int nM, nN, nwg, G, c;
    __host__ __device__ void init(int M, int N, int G_, int c_) { nM = M / BM; nN = N / BM; nwg = nM * nN; G = G_; c = c_; }
    __host__ __device__ bool next(int i, Unit& u) const {
        const long L = (long)i * G + c; if (L >= nwg) return false;
        int wgid = (int)L; { const int q = nwg / NXCD, r = nwg % NXCD, xcd = wgid % NXCD, off = wgid / NXCD; wgid = (xcd < r ? xcd * (q + 1) : r * (q + 1) + (xcd - r) * q) + off; }
        const int nig = WGM * nN, gid = wgid / nig, fm = gid * WGM, gsz = (nM - fm) < WGM ? (nM - fm) : WGM;
        u.pm = fm + ((wgid % nig) % gsz); u.pn = (wgid % nig) / gsz; return true;
    }
    __device__ __forceinline__ void a_ready(const Unit&) const {}
    __device__ __forceinline__ void done(const Unit&) const {}
};

template <class Epi, class Sched>
__device__ __forceinline__ void gemm_phase(LAS unsigned char* lds, const Gemm g, const Sched& S, const Epi& E) {
    const int tid = otid(), wid = __builtin_amdgcn_readfirstlane(tid >> 6), lane = tid & 63, wr = wid >> 2, wc = wid & 3, fr = lane & 15, fq = lane >> 4;
    const int K = g.K, nt = K / BK;
    unsigned voffA[2], voffB[2];
#pragma unroll
    for (int i = 0; i < 2; ++i) { int R, C; stage_rc(tid * 16 + i * 8192, R, C); const int Rb = Epi::PERM ? ((R & ~31) + perm32(R & 31)) : R;
        voffA[i] = (unsigned)(R * K + C) * 2u; voffB[i] = (unsigned)(Rb * K + C) * 2u; }
    const size_t kstep = (size_t)(BK * 2);
    const size_t hstep = (size_t)HALF * K * 2;
    const size_t tstep = 2 * hstep;
    const unsigned ldsw = (unsigned)wid * 1024u;
    const int aoff = lds_byte(wr * 64 + fr, fq * 8), boff = lds_byte(wc * 32 + fr, fq * 8);
#define PG8_SA(b, h) (((b) * 2 + (h)) * HTB)
#define PG8_SB(b, h) ((4 + (b) * 2 + (h)) * HTB)
#define PG8_STAGE(bufoff, gbase, voff) do { _Pragma("unroll") for (int _i = 0; _i < 2; ++_i) \
        __builtin_amdgcn_global_load_lds((const unsigned*)((const char*)(gbase) + (voff)[_i]), (LAS unsigned*)(lds + (bufoff) + ldsw + _i * 8192), 16, 0, 0); } while (0)
#define PG8_LDA(dst, b, h) do { _Pragma("unroll") for (int m = 0; m < 4; ++m) _Pragma("unroll") for (int k = 0; k < 2; ++k) dst[m][k] = *(const LAS bf16x8*)(lds + PG8_SA(b, h) + aoff + m * 2048 + k * 1024); } while (0)
#define PG8_LDB(dst, b, h) do { _Pragma("unroll") for (int n = 0; n < 2; ++n) _Pragma("unroll") for (int k = 0; k < 2; ++k) dst[n][k] = *(const LAS bf16x8*)(lds + PG8_SB(b, h) + boff + n * 2048 + k * 1024); } while (0)
#define PG8_MMA(ai, bj, At, Bt) do { __builtin_amdgcn_s_setprio(1); _Pragma("unroll") for (int m = 0; m < 4; ++m) _Pragma("unroll") for (int n = 0; n < 2; ++n) _Pragma("unroll") for (int k = 0; k < 2; ++k) \
        acc[ai][bj][m][n] = __builtin_amdgcn_mfma_f32_16x16x32_bf16(Bt[n][k], At[m][k], acc[ai][bj][m][n], 0, 0, 0); __builtin_amdgcn_s_setprio(0); } while (0)
#define PG8_WAIT_V(n) asm volatile("s_waitcnt vmcnt(" #n ")" ::: "memory")
#define PG8_WAIT_L(n) asm volatile("s_waitcnt lgkmcnt(" #n ")" ::: "memory")
#define PG8_BAR __builtin_amdgcn_s_barrier()
#define PG8_SCHED __builtin_amdgcn_sched_barrier(0)
    Unit cur, nxt; int ui = 0;
    if (!S.next(0, cur)) return;
    f32x4 acc[2][2][4][2];
#pragma unroll
    for (int a = 0; a < 2; ++a)
#pragma unroll
        for (int b = 0; b < 2; ++b)
#pragma unroll
            for (int m = 0; m < 4; ++m)
#pragma unroll
                for (int n = 0; n < 2; ++n) acc[a][b][m][n] = (f32x4){0.f, 0.f, 0.f, 0.f};
    bf16x8 At[4][2], B0[2][2], B1[2][2];
    const char* cA = (const char*)g.A + (size_t)cur.pm * tstep; const char* cB = (const char*)g.Bt + (size_t)cur.pn * tstep;
    S.a_ready(cur);
    PG8_STAGE(PG8_SB(0, 0), cB, voffB); PG8_STAGE(PG8_SA(0, 0), cA, voffA); PG8_STAGE(PG8_SB(0, 1), cB + hstep, voffB); PG8_STAGE(PG8_SA(0, 1), cA + hstep, voffA);
    if (wr == 1) PG8_BAR;
    PG8_WAIT_V(4); PG8_BAR;
    PG8_STAGE(PG8_SB(1, 0), cB + kstep, voffB); PG8_STAGE(PG8_SA(1, 0), cA + kstep, voffA); PG8_STAGE(PG8_SB(1, 1), cB + hstep + kstep, voffB);
    PG8_WAIT_V(6); PG8_BAR;
    for (;;) {
        const bool has_next = S.next(ui + 1, nxt);
        const char* nA = has_next ? (const char*)g.A + (size_t)nxt.pm * tstep : cA; const char* nB = has_next ? (const char*)g.Bt + (size_t)nxt.pn * tstep : cB;
        for (int t = 0; t < nt; t += 2) {
            const bool last = (t == nt - 2);
            const char* a1 = cA + (size_t)(t + 1) * kstep;
            const char* a2 = last ? nA : cA + (size_t)(t + 2) * kstep; const char* b2 = last ? nB : cB + (size_t)(t + 2) * kstep;
            const char* a3 = a2 + kstep; const char* b3 = b2 + kstep;
            if (last && has_next) S.a_ready(nxt);
            PG8_LDB(B0, 0, 0); PG8_SCHED; PG8_LDA(At, 0, 0); PG8_STAGE(PG8_SA(1, 1), a1 + hstep, voffA);
            PG8_WAIT_L(8); PG8_BAR; PG8_WAIT_L(0); PG8_MMA(0, 0, At, B0); PG8_BAR; PG8_SCHED;
            PG8_LDB(B1, 0, 1); PG8_STAGE(PG8_SB(0, 0), b2, voffB);
            PG8_BAR; PG8_WAIT_L(0); PG8_MMA(0, 1, At, B1); PG8_BAR;
            PG8_LDA(At, 0, 1); PG8_STAGE(PG8_SA(0, 0), a2, voffA);
            PG8_BAR; PG8_WAIT_L(0); PG8_MMA(1, 0, At, B0); PG8_BAR; PG8_SCHED;
            PG8_STAGE(PG8_SB(0, 1), b2 + hstep, voffB);
            PG8_WAIT_V(6); PG8_BAR; PG8_MMA(1, 1, At, B1); PG8_BAR;
            PG8_LDB(B0, 1, 0); PG8_SCHED; PG8_LDA(At, 1, 0); PG8_STAGE(PG8_SA(0, 1), a2 + hstep, voffA);
            PG8_WAIT_L(8); PG8_BAR; PG8_WAIT_L(0); PG8_MMA(0, 0, At, B0); PG8_BAR; PG8_SCHED;
            PG8_LDB(B1, 1, 1); PG8_STAGE(PG8_SB(1, 0), b3, voffB);
            PG8_BAR; PG8_WAIT_L(0); PG8_MMA(0, 1, At, B1); PG8_BAR;
            PG8_LDA(At, 1, 1); PG8_STAGE(PG8_SA(1, 0), a3, voffA);
            PG8_BAR; PG8_WAIT_L(0); PG8_MMA(1, 0, At, B0); PG8_BAR; PG8_SCHED;
            PG8_STAGE(PG8_SB(1, 1), b3 + hstep, voffB);
            PG8_WAIT_V(6); PG8_BAR; PG8_MMA(1, 1, At, B1); PG8_BAR;
        }
        E(acc, cur, wr, wc, fr, fq);
        if (!has_next) break;
#pragma unroll
        for (int a = 0; a < 2; ++a)
#pragma unroll
            for (int b = 0; b < 2; ++b)
#pragma unroll
                for (int m = 0; m < 4; ++m)
#pragma unroll
                    for (int n = 0; n < 2; ++n) acc[a][b][m][n] = (f32x4){0.f, 0.f, 0.f, 0.f};
        cur = nxt; cA = nA; cB = nB; ++ui;
    }
    PG8_WAIT_V(0);
    if (wr == 0) PG8_BAR;
    PG8_BAR;
#undef PG8_SA
#undef PG8_SB
#undef PG8_STAGE
#undef PG8_LDA
#undef PG8_LDB
#undef PG8_MMA
#undef PG8_WAIT_V
#undef PG8_WAIT_L
#undef PG8_BAR
#undef PG8_SCHED
}
}

struct EpiP {
    static constexpr bool PERM = false;
    bf16_t* P;
    __device__ __forceinline__ void operator()(const f32x4 (&acc)[2][2][4][2], const pg8::Unit& u, int wr, int wc, int fr, int fq) const {
        const int row0 = u.pm * 256 + wr * 64 + fr, col0 = u.pn * 256 + wc * 32 + 4 * fq;
#pragma unroll
        for (int ai = 0; ai < 2; ++ai)
#pragma unroll
            for (int m = 0; m < 4; ++m) { bf16_t* rowp = P + (size_t)(row0 + ai * 128 + m * 16) * INW;
#pragma unroll
                for (int bj = 0; bj < 2; ++bj)
#pragma unroll
                    for (int n = 0; n < 2; ++n) { const int c = col0 + bj * 128 + n * 16; const f32x4 v = acc[ai][bj][m][n];
                        if (c < INW) { u32x2 w2; w2.x = cvt_pk_bf16(v[0], v[1]); w2.y = cvt_pk_bf16(v[2], v[3]); *(u32x2*)(rowp + c) = w2; } } }
    }
};
struct EpiRelu2 {
    static constexpr bool PERM = false;
    bf16_t* O;
    __device__ __forceinline__ void operator()(const f32x4 (&acc)[2][2][4][2], const pg8::Unit& u, int wr, int wc, int fr, int fq) const {
        const int row0 = u.pm * 256 + wr * 64 + fr, col0 = u.pn * 256 + wc * 32 + 4 * fq;
#pragma unroll
        for (int ai = 0; ai < 2; ++ai)
#pragma unroll
            for (int m = 0; m < 4; ++m) { bf16_t* rowp = O + (size_t)(row0 + ai * 128 + m * 16) * DFF;
#pragma unroll
                for (int bj = 0; bj < 2; ++bj)
#pragma unroll
                    for (int n = 0; n < 2; ++n) { const int c = col0 + bj * 128 + n * 16; f32x4 v = acc[ai][bj][m][n];
#pragma unroll
                        for (int j = 0; j < 4; ++j) { const float r = fmaxf(v[j], 0.f); v[j] = r * r; }
                        u32x2 w2; w2.x = cvt_pk_bf16(v[0], v[1]); w2.y = cvt_pk_bf16(v[2], v[3]); *(u32x2*)(rowp + c) = w2; } }
    }
};
struct EpiRes {
    static constexpr bool PERM = false;
    const float* xin_lat; const float* xin_ctx; float* xout_lat; float* xout_ctx; const float* gate;
    __device__ __forceinline__ void operator()(const f32x4 (&acc)[2][2][4][2], const pg8::Unit& u, int wr, int wc, int fr, int fq) const {
        const int row0 = u.pm * 256 + wr * 64 + fr, col0 = u.pn * 256 + wc * 32 + 4 * fq;
        const int rb = u.pm * 256;
        const bool isctx = rb >= NLAT;
        const int bidx = isctx ? 8 : (rb >> 12);
        const float* xi = isctx ? xin_ctx - (size_t)NLAT * DM : xin_lat;
        float* xo = isctx ? xout_ctx - (size_t)NLAT * DM : xout_lat;
        const float* gp = gate + (size_t)bidx * 6 * DM;
        f32x4 gv[2][2];
#pragma unroll
        for (int bj = 0; bj < 2; ++bj)
#pragma unroll
            for (int n = 0; n < 2; ++n) gv[bj][n] = *(const f32x4*)(gp + col0 + bj * 128 + n * 16);
#pragma unroll
        for (int ai = 0; ai < 2; ++ai)
#pragma unroll
            for (int m = 0; m < 4; ++m) { const size_t ro = (size_t)(row0 + ai * 128 + m * 16) * DM;
#pragma unroll
                for (int bj = 0; bj < 2; ++bj)
#pragma unroll
                    for (int n = 0; n < 2; ++n) { const int c = col0 + bj * 128 + n * 16; const f32x4 xv = *(const f32x4*)(xi + ro + c);
                        *(f32x4*)(xo + ro + c) = xv + gv[bj][n] * acc[ai][bj][m][n]; } }
    }
};

__device__ void transpose_tile(const float* __restrict__ src, int K, int N, bf16_t* __restrict__ dst, int tk, int tn, float* tile) {
    const int tid = otid(), k0 = tk * 64, n0 = tn * 64, cl = tid & 63, r0 = tid >> 6;
#pragma unroll
    for (int i = 0; i < 8; ++i) { const int r = r0 + 8 * i, n = n0 + cl; tile[r * 65 + cl] = (n < N) ? src[(size_t)(k0 + r) * N + n] : 0.f; }
    __syncthreads();
#pragma unroll
    for (int i = 0; i < 8; ++i) { const int rn = r0 + 8 * i; dst[(size_t)(n0 + rn) * K + k0 + cl] = f2bf(tile[cl * 65 + rn]); }
    __syncthreads();
}
__device__ void phase_prep(const Params& p, unsigned char* lds) {
    float* tile = (float*)lds;
    const int tid = otid();
    constexpr int T_IN = 16 * 60, T_OUT = 16 * 16, T_1 = 16 * 64, T_2 = 64 * 16, T_L = T_IN + T_OUT + T_1 + T_2;
    for (int t = blockIdx.x; t < 2 * T_L; t += gridDim.x) {
        const int l = t / T_L; int r = t % T_L;
        if (r < T_IN) transpose_tile(p.w_in + (size_t)l * DM * INW, DM, INW, (bf16_t*)(p.ws + WS_WIN) + (size_t)l * INWP * DM, r / 60, r % 60, tile);
        else if ((r -= T_IN) < T_OUT) transpose_tile(p.w_out + (size_t)l * DM * DM, DM, DM, (bf16_t*)(p.ws + WS_WOUT) + (size_t)l * DM * DM, r / 16, r % 16, tile);
        else if ((r -= T_OUT) < T_1) transpose_tile(p.w_mlp1 + (size_t)l * DM * DFF, DM, DFF, (bf16_t*)(p.ws + WS_W1) + (size_t)l * DFF * DM, r / 64, r % 64, tile);
        else { r -= T_1; transpose_tile(p.w_mlp2 + (size_t)l * DFF * DM, DFF, DM, (bf16_t*)(p.ws + WS_W2) + (size_t)l * DM * DFF, r / 16, r % 16, tile); }
    }
    float* red = (float*)lds;
    const int w = tid >> 6, lane = tid & 63;
    for (int it = blockIdx.x; it < 2 * 96; it += gridDim.x) {
        const int l = it / 96, j0 = (it % 96) * 64;
        float a[9];
#pragma unroll
        for (int r = 0; r < 9; ++r) a[r] = 0.f;
        const float* wp = p.ada_w + (size_t)l * DM * 6 * DM + j0 + lane;
        for (int k = w * 128; k < w * 128 + 128; ++k) {
            const float wv = wp[(size_t)k * 6 * DM];
#pragma unroll
            for (int r = 0; r < 9; ++r) { const float cv = (r < 8) ? p.c[r * DM + k] : p.c_ctx[k]; a[r] += silu_f(cv) * wv; }
        }
        __syncthreads();
#pragma unroll
        for (int r = 0; r < 9; ++r) red[(w * 9 + r) * 64 + lane] = a[r];
        __syncthreads();
        for (int idx = tid; idx < 9 * 64; idx += 512) { const int r = idx >> 6, ln = idx & 63; float s = 0.f;
#pragma unroll
            for (int ww = 0; ww < 8; ++ww) s += red[(ww * 9 + r) * 64 + ln];
            ((float*)(p.ws + WS_MOD))[((size_t)l * 9 + r) * 6 * DM + j0 + ln] = s + p.ada_b[(size_t)l * 6 * DM + j0 + ln]; }
    }
    if (blockIdx.x == gridDim.x - 1) {
        float* tab = (float*)(p.ws + WS_TAB);
        for (int idx = tid; idx < 2048; idx += 512) { const int pos = idx >> 5, i = idx & 31; const float inv = powf(10000.0f, -(float)i / 32.0f); const float ang = (float)pos * inv;
            tab[idx] = cosf(ang); tab[2048 + idx] = sinf(ang); }
    }
    __syncthreads();
}

__device__ __forceinline__ const float* xrow(const float* lat, const float* ctx, int m) { return m < NLAT ? lat + (size_t)m * DM : ctx + (size_t)(m - NLAT) * DM; }
__device__ void phase_norm(const Params& p, const float* xl, const float* xc, const float* g, const float* mod_l, int sh_off, int nrows) {
    const int tid_ = otid(); const int lane = tid_ & 63, gw = blockIdx.x * 8 + (tid_ >> 6), nw = gridDim.x * 8;
    bf16_t* H = (bf16_t*)(p.ws + WS_H);
    for (int m = gw; m < nrows; m += nw) {
        const float* xr = xrow(xl, xc, m);
        const int b = m < NLAT ? (m >> 12) : 8;
        const float* sh = mod_l + (size_t)b * 6 * DM + sh_off; const float* sc = sh + DM;
        f32x4 v[4]; float ss = 0.f;
#pragma unroll
        for (int i = 0; i < 4; ++i) { v[i] = *(const f32x4*)(xr + 4 * lane + 256 * i); ss += v[i][0] * v[i][0] + v[i][1] * v[i][1] + v[i][2] * v[i][2] + v[i][3] * v[i][3]; }
#pragma unroll
        for (int o = 32; o >= 1; o >>= 1) ss += __shfl_xor(ss, o);
        const float rinv = rsqrtf(ss * (1.0f / DM) + 1e-6f);
#pragma unroll
        for (int i = 0; i < 4; ++i) { const int c = 4 * lane + 256 * i; const f32x4 gg = *(const f32x4*)(g + c), s1 = *(const f32x4*)(sc + c), s0 = *(const f32x4*)(sh + c);
            f32x4 y;
#pragma unroll
            for (int j = 0; j < 4; ++j) y[j] = (v[i][j] * rinv * gg[j]) * (1.f + s1[j]) + s0[j];
            u32x2 w2; w2.x = cvt_pk_bf16(y[0], y[1]); w2.y = cvt_pk_bf16(y[2], y[3]); *(u32x2*)(H + (size_t)m * DM + c) = w2; }
    }
}
__device__ void phase_final(const Params& p) {
    const int tid_ = otid(); const int lane = tid_ & 63, gw = blockIdx.x * 8 + (tid_ >> 6), nw = gridDim.x * 8;
    for (int m = gw; m < NLAT; m += nw) {
        float* xr = p.out + (size_t)m * DM;
        f32x4 v[4]; float ss = 0.f;
#pragma unroll
        for (int i = 0; i < 4; ++i) { v[i] = *(const f32x4*)(xr + 4 * lane + 256 * i); ss += v[i][0] * v[i][0] + v[i][1] * v[i][1] + v[i][2] * v[i][2] + v[i][3] * v[i][3]; }
#pragma unroll
        for (int o = 32; o >= 1; o >>= 1) ss += __shfl_xor(ss, o);
        const float rinv = rsqrtf(ss * (1.0f / DM) + 1e-6f);
#pragma unroll
        for (int i = 0; i < 4; ++i) { const int c = 4 * lane + 256 * i; const f32x4 gg = *(const f32x4*)(p.final_g + c);
            f32x4 y;
#pragma unroll
            for (int j = 0; j < 4; ++j) y[j] = v[i][j] * rinv * gg[j];
            *(f32x4*)(xr + c) = y; }
    }
}

__device__ void phase_merge(const Params& p, int l, int nrows) {
    const int tid_ = otid(); const int lane = tid_ & 63, gw = blockIdx.x * 8 + (tid_ >> 6), nw = gridDim.x * 8;
    bf16_t* H = (bf16_t*)(p.ws + WS_H); const bf16_t* OB = (const bf16_t*)(p.ws + WS_OB); const bf16_t* P = (const bf16_t*)(p.ws + WS_P);
    const bool isgla = lane >= 32;
    const int gcol = isgla ? (2560 + 16 * lane) : (1536 + 16 * lane);
    const float* gn = p.gla_norm_g + l * 128 + ((16 * lane) & 127);
    for (int m = gw; m < nrows; m += nw) {
        const bf16x8 f0 = *(const bf16x8*)(H + (size_t)m * DM + 16 * lane), f1 = *(const bf16x8*)(H + (size_t)m * DM + 16 * lane + 8);
#ifdef NO_SCAN
        const bf16x8 b0 = (bf16x8){0,0,0,0,0,0,0,0}, b1 = b0; (void)OB;
#else
        const bf16x8 b0 = *(const bf16x8*)(OB + (size_t)m * DM + 16 * lane), b1 = *(const bf16x8*)(OB + (size_t)m * DM + 16 * lane + 8);
#endif
        const bf16x8 g0 = *(const bf16x8*)(P + (size_t)m * INW + gcol), g1 = *(const bf16x8*)(P + (size_t)m * INW + gcol + 8);
        float r[16]; float s1 = 0.f, s2 = 0.f;
#pragma unroll
        for (int j = 0; j < 8; ++j) { r[j] = bf2f(f0[j]) + bf2f(b0[j]); r[8 + j] = bf2f(f1[j]) + bf2f(b1[j]); }
#ifdef SANITIZE
#pragma unroll
        for (int j = 0; j < 16; ++j) { if (!(fabsf(r[j]) < 1e30f)) r[j] = 0.f; }
#endif
#ifdef SKIP_GLA
        if (isgla) {
#pragma unroll
            for (int j = 0; j < 16; ++j) r[j] = 0.f; }
#endif
#ifdef SKIP_RET
        if (!isgla) {
#pragma unroll
            for (int j = 0; j < 16; ++j) r[j] = 0.f; }
#endif
#pragma unroll
        for (int j = 0; j < 16; ++j) { s1 += r[j]; s2 += r[j] * r[j]; }
#pragma unroll
        for (int o = 1; o <= 4; o <<= 1) { s1 += __shfl_xor(s1, o); s2 += __shfl_xor(s2, o); }
        float y[16];
        if (!isgla) {
            const float mu = s1 * (1.f / 128.f); float sv = 0.f;
#pragma unroll
            for (int j = 0; j < 16; ++j) { const float d = r[j] - mu; sv += d * d; }
#pragma unroll
            for (int o = 1; o <= 4; o <<= 1) sv += __shfl_xor(sv, o);
            const float rs = rsqrtf(sv * (1.f / 128.f) + 1e-6f);
#pragma unroll
            for (int j = 0; j < 16; ++j) y[j] = (r[j] - mu) * rs;
        } else {
            float sv = 0.f;
#pragma unroll
            for (int o = 1; o <= 4; o <<= 1) sv += __shfl_xor(sv, o);
            const float rs = rsqrtf(s2 * (1.f / 128.f) + 1e-6f);
#pragma unroll
            for (int j = 0; j < 16; ++j) y[j] = r[j] * rs * gn[j] + 0.f * sv;
        }
        u32x4 o0, o1;
#pragma unroll
        for (int j = 0; j < 8; ++j) { y[j] *= silu_f(bf2f(g0[j])); y[8 + j] *= silu_f(bf2f(g1[j])); }
        o0.x = cvt_pk_bf16(y[0], y[1]); o0.y = cvt_pk_bf16(y[2], y[3]); o0.z = cvt_pk_bf16(y[4], y[5]); o0.w = cvt_pk_bf16(y[6], y[7]);
        o1.x = cvt_pk_bf16(y[8], y[9]); o1.y = cvt_pk_bf16(y[10], y[11]); o1.z = cvt_pk_bf16(y[12], y[13]); o1.w = cvt_pk_bf16(y[14], y[15]);
        *(u32x4*)(H + (size_t)m * DM + 16 * lane) = o0; *(u32x4*)(H + (size_t)m * DM + 16 * lane + 8) = o1;
    }
}

template <int DK, bool GLA>
__device__ __forceinline__ void scan_item(const Params& p, int l, unsigned char* lds, int b, int h, int dir, int dvs) {
    constexpr int QS = DK + 8, TS = 72, NT = DK / 32, NKS = DK / 32;
    bf16_t* QD = (bf16_t*)lds;
    bf16_t* KI = QD + 64 * QS;
    bf16_t* ST = KI + 64 * QS;
    bf16_t* KET = ST + 64 * QS;
    bf16_t* VT = KET + DK * TS;
    bf16_t* SC = VT + 64 * TS;
    float* DVEC = (float*)(SC + 64 * TS);
    float* CL = DVEC + DK;
    float* CUM = CL + DK;
    float* UP = CUM + 64 * 68;
    const int tid = otid(), lane = tid & 63, w = tid >> 6, fr = lane & 15, fq = lane >> 4;
    const bf16_t* P = (const bf16_t*)(p.ws + WS_P);
    bf16_t* O = (bf16_t*)(p.ws + (dir ? WS_OB : WS_H));
    const float* TABC = (const float*)(p.ws + WS_TAB); const float* TABS = TABC + 2048;
    const int ocol = (GLA ? 512 : 0) + 128 * h + 64 * dvs;
    const int qcol = GLA ? 2048 + 64 * h : 128 * h, kcol = GLA ? 2304 + 64 * h : 512 + 128 * h, vcol = (GLA ? 2560 : 1024) + 128 * h + 64 * dvs;
    float g = 0.f;
    if (!GLA) g = log1pf(-__expf(p.ret_decay[l * 8 + dir * 4 + h]));
    const int dkt = (DK == 128) ? w : (w >> 1);
    const int dvt0 = (DK == 128) ? 0 : 2 * (w & 1);
    f32x4 S[NT];
#pragma unroll
    for (int i = 0; i < NT; ++i) S[i] = (f32x4){0.f, 0.f, 0.f, 0.f};
    __syncthreads();
    for (int i = tid; i < 64 * QS / 2; i += 512) ((unsigned*)ST)[i] = 0u;
    if (GLA) {
        for (int i = tid; i < 16 * 64; i += 512) UP[i] = p.gate_up[((size_t)(l * 2 + dir) * 16 + (i >> 6)) * 256 + 64 * h + (i & 63)];
        if (tid < 64) UP[1024 + tid] = p.gate_b[(l * 2 + dir) * 256 + 64 * h + tid];
    } else {
        if (tid < DK) DVEC[tid] = __expf(64.f * g);
    }
    __syncthreads();
    const int s_a = tid >> 3, pr = tid & 7, c8a = (pr & 3) + 8 * (pr >> 2), c8g = tid & 7;
    bf16x8 nq1, nq2, nk1, nk2, nv1, nd0, nd1; f32x4 nc0, nc1, ns0, ns1;
    nq2 = nq1 = nk1 = nk2 = nv1 = nd0 = nd1 = (bf16x8){0, 0, 0, 0, 0, 0, 0, 0}; nc0 = nc1 = ns0 = ns1 = (f32x4){0.f, 0.f, 0.f, 0.f};
#define SCAN_STEP_GEOM(stp, isctx_, chunk_, m0_) \
    const bool isctx_ = (stp) < 4; \
    const int chunk_ = dir == 0 ? (isctx_ ? (stp) : (stp) - 4) : (isctx_ ? 3 - (stp) : 67 - (stp)); \
    const int m0_ = isctx_ ? (NLAT + b * CTXL + chunk_ * 64) : (b * SEQ + chunk_ * 64);
#define SCAN_ISSUE(stp) do { SCAN_STEP_GEOM(stp, ic_, ch_, mm_) \
        const bf16_t* rp_ = P + (size_t)(mm_ + s_a) * INW; \
        if (GLA) { const bf16_t* dp_ = P + (size_t)(mm_ + lane) * INW + 3584 + 16 * dir; nd0 = *(const bf16x8*)dp_; nd1 = *(const bf16x8*)(dp_ + 8); \
            nq1 = *(const bf16x8*)(rp_ + qcol + 8 * c8g); nk1 = *(const bf16x8*)(rp_ + kcol + 8 * c8g); } \
        else { nq1 = *(const bf16x8*)(rp_ + qcol + 8 * c8a); nq2 = *(const bf16x8*)(rp_ + qcol + 8 * (c8a + 4)); \
            nk1 = *(const bf16x8*)(rp_ + kcol + 8 * c8a); nk2 = *(const bf16x8*)(rp_ + kcol + 8 * (c8a + 4)); \
            const int pos_ = ic_ ? 0 : ((pr >> 2) ? s_a : ch_); \
            nc0 = *(const f32x4*)(TABC + pos_ * 32 + 8 * (pr & 3)); nc1 = *(const f32x4*)(TABC + pos_ * 32 + 8 * (pr & 3) + 4); \
            ns0 = *(const f32x4*)(TABS + pos_ * 32 + 8 * (pr & 3)); ns1 = *(const f32x4*)(TABS + pos_ * 32 + 8 * (pr & 3) + 4); } \
        nv1 = *(const bf16x8*)(rp_ + vcol + 8 * c8g); } while (0)
#define TSW(row, sgrp) ((row) * TS + (((((sgrp)) ^ ((row) >> 4)) & 7) << 3))
    SCAN_ISSUE(0);
    for (int step = 0; step < 68; ++step) {
        SCAN_STEP_GEOM(step, isctx, chunk, m0)
        const bf16x8 q1 = nq1, q2 = nq2, k1 = nk1, k2 = nk2, v1 = nv1, d0 = nd0, d1 = nd1; const f32x4 tc0 = nc0, tc1 = nc1, ts0 = ns0, ts1 = ns1;
        { const int nstep = step + 1 < 68 ? step + 1 : 67; SCAN_ISSUE(nstep); }
        (void)chunk;
        if (GLA) {
            float df[16];
#pragma unroll
            for (int r = 0; r < 8; ++r) { df[r] = bf2f(d0[r]); df[8 + r] = bf2f(d1[r]); }
#pragma unroll
            for (int c = 0; c < 8; ++c) {
                const int ch = 8 * w + c;
                float z = UP[1024 + ch];
#pragma unroll
                for (int r = 0; r < 16; ++r) z += df[r] * UP[r * 64 + ch];
                float v = (fminf(z, 0.f) - __logf(1.f + __expf(-fabsf(z)))) * (1.0f / 16.0f);
                if (dir == 0) {
#pragma unroll
                    for (int o = 1; o < 64; o <<= 1) { const float t = __shfl_up(v, o); if (lane >= o) v += t; }
                } else {
#pragma unroll
                    for (int o = 1; o < 64; o <<= 1) { const float t = __shfl_down(v, o); if (lane + o < 64) v += t; }
                }
                CUM[lane * 68 + ch] = v;
                const float tot = __shfl(v, dir == 0 ? 63 : 0);
                if (lane == 0) { CL[ch] = tot; DVEC[ch] = __expf(tot); }
            }
            __syncthreads();
        }
        {
            const int s = s_a;
            if (!GLA) {
                const float cum = dir == 0 ? g * (float)(s + 1) : g * (float)(64 - s), cl = 64.f * g;
                const float eq = __expf(cum) * 0.08838834764831845f, eki = __expf(-cum), eke = __expf(cl - cum);
                float cs[8], sn[8];
#pragma unroll
                for (int j = 0; j < 4; ++j) { cs[j] = isctx ? 1.f : tc0[j]; cs[4 + j] = isctx ? 1.f : tc1[j]; sn[j] = isctx ? 0.f : ts0[j]; sn[4 + j] = isctx ? 0.f : ts1[j]; }
                float qa[8], qb[8], ka[8], kb[8];
#pragma unroll
                for (int j = 0; j < 8; ++j) {
                    const float a1 = bf2f(q1[j]), a2 = bf2f(q2[j]), b1 = bf2f(k1[j]), b2 = bf2f(k2[j]);
                    qa[j] = a1 * cs[j] - a2 * sn[j]; qb[j] = a1 * sn[j] + a2 * cs[j];
                    ka[j] = b1 * cs[j] - b2 * sn[j]; kb[j] = b1 * sn[j] + b2 * cs[j];
                }
                u32x4 o;
                o.x = cvt_pk_bf16(qa[0] * eq, qa[1] * eq); o.y = cvt_pk_bf16(qa[2] * eq, qa[3] * eq); o.z = cvt_pk_bf16(qa[4] * eq, qa[5] * eq); o.w = cvt_pk_bf16(qa[6] * eq, qa[7] * eq);
                *(u32x4*)(QD + s * QS + 8 * c8a) = o;
                o.x = cvt_pk_bf16(qb[0] * eq, qb[1] * eq); o.y = cvt_pk_bf16(qb[2] * eq, qb[3] * eq); o.z = cvt_pk_bf16(qb[4] * eq, qb[5] * eq); o.w = cvt_pk_bf16(qb[6] * eq, qb[7] * eq);
                *(u32x4*)(QD + s * QS + 8 * (c8a + 4)) = o;
                o.x = cvt_pk_bf16(ka[0] * eki, ka[1] * eki); o.y = cvt_pk_bf16(ka[2] * eki, ka[3] * eki); o.z = cvt_pk_bf16(ka[4] * eki, ka[5] * eki); o.w = cvt_pk_bf16(ka[6] * eki, ka[7] * eki);
                *(u32x4*)(KI + s * QS + 8 * c8a) = o;
                o.x = cvt_pk_bf16(kb[0] * eki, kb[1] * eki); o.y = cvt_pk_bf16(kb[2] * eki, kb[3] * eki); o.z = cvt_pk_bf16(kb[4] * eki, kb[5] * eki); o.w = cvt_pk_bf16(kb[6] * eki, kb[7] * eki);
                *(u32x4*)(KI + s * QS + 8 * (c8a + 4)) = o;
#pragma unroll
                for (int j = 0; j < 8; ++j) { KET[TSW(8 * c8a + j, s >> 3) + (s & 7)] = f2bf(ka[j] * eke); KET[TSW(8 * (c8a + 4) + j, s >> 3) + (s & 7)] = f2bf(kb[j] * eke); }
            } else {
                const int c8 = c8g;
                const f32x4 cu0 = *(const f32x4*)(CUM + s * 68 + 8 * c8), cu1 = *(const f32x4*)(CUM + s * 68 + 8 * c8 + 4);
                const f32x4 cl0 = *(const f32x4*)(CL + 8 * c8), cl1 = *(const f32x4*)(CL + 8 * c8 + 4);
                float qd[8], ki[8];
#pragma unroll
                for (int j = 0; j < 8; ++j) {
                    const float cu = j < 4 ? cu0[j & 3] : cu1[j & 3], cl = j < 4 ? cl0[j & 3] : cl1[j & 3];
                    const float qv = bf2f(q1[j]), kv = bf2f(k1[j]);
                    qd[j] = qv * 0.125f * __expf(cu); ki[j] = kv * __expf(-cu);
                    KET[TSW(8 * c8 + j, s >> 3) + (s & 7)] = f2bf(kv * __expf(cl - cu));
                }
                u32x4 o;
                o.x = cvt_pk_bf16(qd[0], qd[1]); o.y = cvt_pk_bf16(qd[2], qd[3]); o.z = cvt_pk_bf16(qd[4], qd[5]); o.w = cvt_pk_bf16(qd[6], qd[7]);
                *(u32x4*)(QD + s * QS + 8 * c8) = o;
                o.x = cvt_pk_bf16(ki[0], ki[1]); o.y = cvt_pk_bf16(ki[2], ki[3]); o.z = cvt_pk_bf16(ki[4], ki[5]); o.w = cvt_pk_bf16(ki[6], ki[7]);
                *(u32x4*)(KI + s * QS + 8 * c8) = o;
            }
            {
                const int c8 = c8g;
#pragma unroll
                for (int j = 0; j < 8; ++j) VT[TSW(8 * c8 + j, s >> 3) + (s & 7)] = (bf16_t)v1[j];
            }
        }
        __syncthreads();
        {
            const int tt = w >> 1;
#pragma unroll
            for (int si = 0; si < 2; ++si) {
                const int st = 2 * (w & 1) + si;
                f32x4 acc = (f32x4){0.f, 0.f, 0.f, 0.f};
#pragma unroll
                for (int ks = 0; ks < NKS; ++ks) {
                    const bf16x8 a = *(const bf16x8*)(KI + (16 * st + fr) * QS + 32 * ks + 8 * fq);
                    const bf16x8 bb = *(const bf16x8*)(QD + (16 * tt + fr) * QS + 32 * ks + 8 * fq);
                    acc = __builtin_amdgcn_mfma_f32_16x16x32_bf16(a, bb, acc, 0, 0, 0);
                }
                const int t = 16 * tt + fr, s0 = 16 * st + 4 * fq;
                float v[4];
#pragma unroll
                for (int r = 0; r < 4; ++r) { const int s = s0 + r; const bool keep = dir == 0 ? (s <= t) : (s > t); v[r] = keep ? acc[r] : 0.f; }
                u32x2 w2; w2.x = cvt_pk_bf16(v[0], v[1]); w2.y = cvt_pk_bf16(v[2], v[3]);
                *(u32x2*)(SC + t * TS + s0) = w2;
            }
        }
        __syncthreads();
        {
            const int tt = w >> 1;
#pragma unroll
            for (int di = 0; di < 2; ++di) {
                const int dvt = 2 * (w & 1) + di;
                f32x4 acc = (f32x4){0.f, 0.f, 0.f, 0.f};
#pragma unroll
                for (int ks = 0; ks < 2; ++ks) {
                    const bf16x8 a = *(const bf16x8*)(VT + TSW(16 * dvt + fr, 4 * ks + fq));
                    const bf16x8 bb = *(const bf16x8*)(SC + (16 * tt + fr) * TS + 32 * ks + 8 * fq);
                    acc = __builtin_amdgcn_mfma_f32_16x16x32_bf16(a, bb, acc, 0, 0, 0);
                }
#pragma unroll
                for (int ks = 0; ks < NKS; ++ks) {
                    const bf16x8 a = *(const bf16x8*)(ST + (16 * dvt + fr) * QS + 32 * ks + 8 * fq);
                    const bf16x8 bb = *(const bf16x8*)(QD + (16 * tt + fr) * QS + 32 * ks + 8 * fq);
                    acc = __builtin_amdgcn_mfma_f32_16x16x32_bf16(a, bb, acc, 0, 0, 0);
                }
                u32x2 w2; w2.x = cvt_pk_bf16(acc[0], acc[1]); w2.y = cvt_pk_bf16(acc[2], acc[3]);
                *(u32x2*)(O + (size_t)(m0 + 16 * tt + fr) * DM + ocol + 16 * dvt + 4 * fq) = w2;
            }
            const f32x4 dv4 = *(const f32x4*)(DVEC + 16 * dkt + 4 * fq);
#pragma unroll
            for (int i = 0; i < NT; ++i) {
                const int dvt = dvt0 + i;
                S[i] = S[i] * dv4;
#pragma unroll
                for (int ks = 0; ks < 2; ++ks) {
                    const bf16x8 a = *(const bf16x8*)(KET + TSW(16 * dkt + fr, 4 * ks + fq));
                    const bf16x8 bb = *(const bf16x8*)(VT + TSW(16 * dvt + fr, 4 * ks + fq));
                    S[i] = __builtin_amdgcn_mfma_f32_16x16x32_bf16(a, bb, S[i], 0, 0, 0);
                }
            }
        }
        __syncthreads();
#pragma unroll
        for (int i = 0; i < NT; ++i) {
            const int dvt = dvt0 + i;
            u32x2 w2; w2.x = cvt_pk_bf16(S[i][0], S[i][1]); w2.y = cvt_pk_bf16(S[i][2], S[i][3]);
            *(u32x2*)(ST + (16 * dvt + fr) * QS + 16 * dkt + 4 * fq) = w2;
        }
    }
    __syncthreads();
#undef SCAN_STEP_GEOM
#undef SCAN_ISSUE
#undef TSW
}
__device__ void phase_scan(const Params& p, int l, unsigned char* lds) {
    for (int it = blockIdx.x; it < 256; it += gridDim.x) {
        const int isgla = it & 1, r = it >> 1;
        const int dvs = r & 1, dir = (r >> 1) & 1, h = (r >> 2) & 3, b = r >> 4;
#ifdef SKIP_GLA
        if (isgla) continue;
#endif
#ifdef SKIP_RET
        if (!isgla) continue;
#endif
        if (isgla) scan_item<64, true>(p, l, lds, b, h, dir, dvs);
        else scan_item<128, false>(p, l, lds, b, h, dir, dvs);
    }
}

__global__ void __launch_bounds__(512, 2) fwd_megakernel(Params p) {
    extern __shared__ __attribute__((aligned(16))) unsigned char shm[];
    cg::grid_group grid = cg::this_grid();
    const float* MOD = (const float*)(p.ws + WS_MOD);
    for (int ph = p.ph_lo; ph < p.ph_hi; ++ph) {
        if (ph == 0) phase_prep(p, shm);
        else if (ph == NPHASE - 1) phase_final(p);
        else {
            const int l = (ph - 1) >> 3, sub = (ph - 1) & 7;
            const float* mod_l = MOD + (size_t)l * 9 * 6 * DM;
            const float* xin_lat = l == 0 ? p.x : p.out; const float* xin_ctx = l == 0 ? p.ctx : (const float*)(p.ws + WS_XCTX);
            float* xo_lat = p.out; float* xo_ctx = (float*)(p.ws + WS_XCTX);
            const int mrows = l == 0 ? MTOT : NLAT;
            bf16_t* H = (bf16_t*)(p.ws + WS_H); bf16_t* Pm = (bf16_t*)(p.ws + WS_P);
            pg8::StaticOrder S;
            if (sub == 0) phase_norm(p, xin_lat, xin_ctx, p.norm1_g + l * DM, mod_l, 0, MTOT);
#ifndef NO_G1
            else if (sub == 1) { pg8::Gemm g{H, (const bf16_t*)(p.ws + WS_WIN) + (size_t)l * INWP * DM, MTOT, INWP, DM}; S.init(g.M, g.N, gridDim.x, blockIdx.x);
                EpiP E{Pm}; pg8::gemm_phase(( LAS unsigned char*)shm, g, S, E); }
#endif
#ifndef NO_SCAN
            else if (sub == 2) phase_scan(p, l, shm);
#endif
            else if (sub == 3) phase_merge(p, l, mrows);
#ifndef NO_G2
            else if (sub == 4) { pg8::Gemm g{H, (const bf16_t*)(p.ws + WS_WOUT) + (size_t)l * DM * DM, mrows, DM, DM}; S.init(g.M, g.N, gridDim.x, blockIdx.x);
                EpiRes E{xin_lat, xin_ctx, xo_lat, xo_ctx, mod_l + 2 * DM}; pg8::gemm_phase((LAS unsigned char*)shm, g, S, E); }
#endif
            else if (sub == 5) phase_norm(p, xo_lat, xo_ctx, p.norm2_g + l * DM, mod_l, 3 * DM, mrows);
#ifndef NO_G3
            else if (sub == 6) { pg8::Gemm g{H, (const bf16_t*)(p.ws + WS_W1) + (size_t)l * DFF * DM, mrows, DFF, DM}; S.init(g.M, g.N, gridDim.x, blockIdx.x);
                EpiRelu2 E{Pm}; pg8::gemm_phase((LAS unsigned char*)shm, g, S, E); }
#endif
#ifndef NO_G4
            else if (sub == 7) { pg8::Gemm g{Pm, (const bf16_t*)(p.ws + WS_W2) + (size_t)l * DM * DFF, mrows, DM, DFF}; S.init(g.M, g.N, gridDim.x, blockIdx.x);
                EpiRes E{xo_lat, xo_ctx, xo_lat, xo_ctx, mod_l + 5 * DM}; pg8::gemm_phase((LAS unsigned char*)shm, g, S, E); }
#endif
        }
        if (ph + 1 < p.ph_hi) grid.sync();
    }
}

extern "C" void kernel_launch(void* const* d_in, const int* in_sizes, int n_in, void* d_out, int out_size, void* d_ws, size_t ws_size, hipStream_t stream) {
    static int grid_blocks = 0;
    if (!grid_blocks) {
        int dev = 0, cus = 0, per_cu = 0;
        hipGetDevice(&dev);
        hipDeviceGetAttribute(&cus, hipDeviceAttributeMultiprocessorCount, dev);
        if (hipFuncSetAttribute((const void*)fwd_megakernel, hipFuncAttributeMaxDynamicSharedMemorySize, LDS_BYTES) != hipSuccess) fprintf(stderr, "hipFuncSetAttribute failed\n");
        if (hipOccupancyMaxActiveBlocksPerMultiprocessor(&per_cu, (const void*)fwd_megakernel, 512, LDS_BYTES) != hipSuccess || per_cu < 1) { fprintf(stderr, "occupancy query: %d\n", per_cu); per_cu = 1; }
        (void)hipGetLastError();
        grid_blocks = cus * per_cu;
        if (ws_size < WS_END) fprintf(stderr, "workspace too small: %zu < %zu\n", ws_size, (size_t)WS_END);
    }
    Params p{};
    p.x = (const float*)d_in[0]; p.c = (const float*)d_in[1]; p.ctx = (const float*)d_in[2]; p.c_ctx = (const float*)d_in[3]; p.ada_w = (const float*)d_in[4];
    p.ada_b = (const float*)d_in[5]; p.norm1_g = (const float*)d_in[6]; p.w_in = (const float*)d_in[7]; p.ret_decay = (const float*)d_in[8];
    p.gate_up = (const float*)d_in[9]; p.gate_b = (const float*)d_in[10]; p.gla_norm_g = (const float*)d_in[11]; p.w_out = (const float*)d_in[12];
    p.norm2_g = (const float*)d_in[13]; p.w_mlp1 = (const float*)d_in[14]; p.w_mlp2 = (const float*)d_in[15]; p.final_g = (const float*)d_in[16];
    p.out = (float*)d_out; p.ws = (unsigned char*)d_ws;
#if MULTI
    for (int ph = 0; ph < NPHASE; ++ph) {
        p.ph_lo = ph; p.ph_hi = ph + 1;
        hipLaunchKernelGGL(fwd_megakernel, dim3(grid_blocks), dim3(512), LDS_BYTES, stream, p);
    }
#else
    p.ph_lo = 0; p.ph_hi = NPHASE;
    void* args[] = {&p};
    hipError_t e = hipLaunchCooperativeKernel((const void*)fwd_megakernel, dim3(grid_blocks), dim3(512), args, LDS_BYTES, stream);
    if (e != hipSuccess) fprintf(stderr, "cooperative launch failed: %s (grid %d)\n", hipGetErrorString(e), grid_blocks);
#endif
}
```

```cpp
#include <hip/hip_runtime.h>
#include <hip/hip_cooperative_groups.h>
#include <cstdio>
namespace cg = cooperative_groups;

#ifndef MULTI
#define MULTI 0
#endif

#define LAS __attribute__((address_space(3)))
typedef unsigned short bf16_t;
typedef short bf16x8 __attribute__((ext_vector_type(8)));
typedef float f32x4 __attribute__((ext_vector_type(4)));
typedef unsigned u32x2 __attribute__((ext_vector_type(2)));
typedef unsigned u32x4 __attribute__((ext_vector_type(4)));

constexpr int DM = 1024, NB = 8, SEQ = 4096, CTXL = 256, NLAT = NB * SEQ, NCTX = NB * CTXL, MTOT = NLAT + NCTX;
constexpr int INW = 3616, INWP = 3840, DFF = 4096;
constexpr int NPHASE = 18;
constexpr int LDS_BYTES = 131072;

constexpr size_t WS_WIN = 0;
constexpr size_t WS_WOUT = WS_WIN + (size_t)2 * INWP * DM * 2;
constexpr size_t WS_W1 = WS_WOUT + (size_t)2 * DM * DM * 2;
constexpr size_t WS_W2 = WS_W1 + (size_t)2 * DFF * DM * 2;
constexpr size_t WS_MOD = WS_W2 + (size_t)2 * DM * DFF * 2;
constexpr size_t WS_TAB = WS_MOD + (size_t)2 * 9 * 6 * DM * 4;
constexpr size_t WS_XCTX = WS_TAB + (size_t)2 * 2048 * 4;
constexpr size_t WS_H = WS_XCTX + (size_t)NCTX * DM * 4;
constexpr size_t WS_P = WS_H + (size_t)MTOT * DM * 2;
constexpr size_t WS_OB = WS_P + (size_t)MTOT * INW * 2;
constexpr size_t WS_END = WS_OB + (size_t)MTOT * DM * 2;
static_assert((size_t)MTOT * DFF * 2 <= WS_END - WS_P, "hmlp alias");
static_assert(WS_END <= (size_t)536870912, "ws");

struct Params {
    const float* x; const float* c; const float* ctx; const float* c_ctx; const float* ada_w; const float* ada_b; const float* norm1_g;
    const float* w_in; const float* ret_decay; const float* gate_up; const float* gate_b; const float* gla_norm_g; const float* w_out;
    const float* norm2_g; const float* w_mlp1; const float* w_mlp2; const float* final_g;
    float* out; unsigned char* ws; int ph_lo, ph_hi;
};

typedef float f32x2_t __attribute__((ext_vector_type(2)));
typedef __bf16 bf16x2_t __attribute__((ext_vector_type(2)));
__device__ __forceinline__ unsigned cvt_pk_bf16(float lo, float hi) { f32x2_t v = {lo, hi}; bf16x2_t b = __builtin_convertvector(v, bf16x2_t); return __builtin_bit_cast(unsigned, b); }
__device__ __forceinline__ bf16_t f2bf(float f) { return (bf16_t)(cvt_pk_bf16(f, 0.f) & 0xffffu); }
__device__ __forceinline__ float bf2f(short b) { return __uint_as_float(((unsigned)(unsigned short)b) << 16); }
__device__ __forceinline__ int otid() { int t = threadIdx.x; asm volatile("" : "+v"(t)); return t; }
__device__ __forceinline__ float silu_f(float v) { return v / (1.f + __expf(-v)); }

namespace pg8 {
constexpr int BM = 256, BK = 64, HALF = 128, HTB = HALF * BK * 2, STAGE_BYTES = 8 * HTB, NXCD = 8, WGM = 8;
__host__ __device__ __forceinline__ int lds_byte(int r, int c) { const int st = (r >> 4) * 2 + (c >> 5), rr = r & 15, cc = c & 31, ob = rr * 64 + cc * 2; return st * 1024 + (ob ^ (((ob >> 9) & 1) << 5)); }
__host__ __device__ __forceinline__ void stage_rc(int b, int& R, int& C) { const int st = b / 1024, sb = b % 1024, swz = sb ^ (((sb >> 9) & 1) << 5); R = (st >> 1) * 16 + swz / 64; C = (st & 1) * 32 + (swz % 64) / 2; }
__host__ __device__ __forceinline__ int perm32(int rho) { const int n = rho >> 4, i = rho & 15; return 8 * (i >> 2) + 4 * n + (i & 3); }
struct Unit { int pm, pn; };
struct Gemm { const bf16_t* A; const bf16_t* Bt; int M, N, K; };
struct StaticOrder {
    int nM, nN, nwg, G, c;
    __host__ __device__ void init(int M, int N, int G_, int c_) { nM = M / BM; nN = N / BM; nwg = nM * nN; G = G_; c = c_; }
    __host__ __device__ bool next(int i, Unit& u) const {
        const long L = (long)i * G + c; if (L >= nwg) return false;
        int wgid = (int)L; { const int q = nwg / NXCD, r = nwg % NXCD, xcd = wgid % NXCD, off = wgid / NXCD; wgid = (xcd < r ? xcd * (q + 1) : r * (q + 1) + (xcd - r) * q) + off; }
        const int nig = WGM * nN, gid = wgid / nig, fm = gid * WGM, gsz = (nM - fm) < WGM ? (nM - fm) : WGM;
        u.pm = fm + ((wgid % nig) % gsz); u.pn = (wgid % nig) / gsz; return true;
    }
    __device__ __forceinline__ void a_ready(const Unit&) const {}
    __device__ __forceinline__ void done(const Unit&) const {}
};

template <class Epi, class Sched>
__device__ __forceinline__ void gemm_phase(LAS unsigned char* lds, const Gemm g, const Sched& S, const Epi& E) {
    const int tid = otid(), wid = __builtin_amdgcn_readfirstlane(tid >> 6), lane = tid & 63, wr = wid >> 2, wc = wid & 3, fr = lane & 15, fq = lane >> 4;
    const int K = g.K, nt = K / BK;
    unsigned voffA[2], voffB[2];
#pragma unroll
    for (int i = 0; i < 2; ++i) { int R, C; stage_rc(tid * 16 + i * 8192, R, C); const int Rb = Epi::PERM ? ((R & ~31) + perm32(R & 31)) : R;
        voffA[i] = (unsigned)(R * K + C) * 2u; voffB[i] = (unsigned)(Rb * K + C) * 2u; }
    const size_t kstep = (size_t)(BK * 2);
    const size_t hstep = (size_t)HALF * K * 2;
    const size_t tstep = 2 * hstep;
    const unsigned ldsw = (unsigned)wid * 1024u;
    const int aoff = lds_byte(wr * 64 + fr, fq * 8), boff = lds_byte(wc * 32 + fr, fq * 8);
#define PG8_SA(b, h) (((b) * 2 + (h)) * HTB)
#define PG8_SB(b, h) ((4 + (b) * 2 + (h)) * HTB)
#define PG8_STAGE(bufoff, gbase, voff) do { _Pragma("unroll") for (int _i = 0; _i < 2; ++_i) \
        __builtin_amdgcn_global_load_lds((const unsigned*)((const char*)(gbase) + (voff)[_i]), (LAS unsigned*)(lds + (bufoff) + ldsw + _i * 8192), 16, 0, 0); } while (0)
#define PG8_LDA(dst, b, h) do { _Pragma("unroll") for (int m = 0; m < 4; ++m) _Pragma("unroll") for (int k = 0; k < 2; ++k) dst[m][k] = *(const LAS bf16x8*)(lds + PG8_SA(b, h) + aoff + m * 2048 + k * 1024); } while (0)
#define PG8_LDB(dst, b, h) do { _Pragma("unroll") for (int n = 0; n < 2; ++n) _Pragma("unroll") for (int k = 0; k < 2; ++k) dst[n][k] = *(const LAS bf16x8*)(lds + PG8_SB(b, h) + boff + n * 2048 + k * 1024); } while (0)
#define PG8_MMA(ai, bj, At, Bt) do { __builtin_amdgcn_s_setprio(1); _Pragma("unroll") for (int m = 0; m < 4; ++m) _Pragma("unroll") for (int n = 0; n < 2; ++n) _Pragma("unroll") for (int k = 0; k < 2; ++k) \
        acc[ai][bj][m][n] = __builtin_amdgcn_mfma_f32_16x16x32_bf16(Bt[n][k], At[m][k], acc[ai][bj][m][n], 0, 0, 0); __builtin_amdgcn_s_setprio(0); } while (0)
#define PG8_WAIT_V(n) asm volatile("s_waitcnt vmcnt(" #n ")" ::: "memory")
#define PG8_WAIT_L(n) asm volatile("s_waitcnt lgkmcnt(" #n ")" ::: "memory")
#define PG8_BAR __builtin_amdgcn_s_barrier()
#define PG8_SCHED __builtin_amdgcn_sched_barrier(0)
    Unit cur, nxt; int ui = 0;
    if (!S.next(0, cur)) return;
    f32x4 acc[2][2][4][2];
#pragma unroll
    for (int a = 0; a < 2; ++a)
#pragma unroll
        for (int b = 0; b < 2; ++b)
#pragma unroll
            for (int m = 0; m < 4; ++m)
#pragma unroll
                for (int n = 0; n < 2; ++n) acc[a][b][m][n] = (f32x4){0.f, 0.f, 0.f, 0.f};
    bf16x8 At[4][2], B0[2][2], B1[2][2];
    const char* cA = (const char*)g.A + (size_t)cur.pm * tstep; const char* cB = (const char*)g.Bt + (size_t)cur.pn * tstep;
    S.a_ready(cur);
    PG8_STAGE(PG8_SB(0, 0), cB, voffB); PG8_STAGE(PG8_SA(0, 0), cA, voffA); PG8_STAGE(PG8_SB(0, 1), cB + hstep, voffB); PG8_STAGE(PG8_SA(0, 1), cA + hstep, voffA);
    if (wr == 1) PG8_BAR;
    PG8_WAIT_V(4); PG8_BAR;
    PG8_STAGE(PG8_SB(1, 0), cB + kstep, voffB); PG8_STAGE(PG8_SA(1, 0), cA + kstep, voffA); PG8_STAGE(PG8_SB(1, 1), cB + hstep + kstep, voffB);
    PG8_WAIT_V(6); PG8_BAR;
    for (;;) {
        const bool has_next = S.next(ui + 1, nxt);
        const char* nA = has_next ? (const char*)g.A + (size_t)nxt.pm * tstep : cA; const char* nB = has_next ? (const char*)g.Bt + (size_t)nxt.pn * tstep : cB;
        for (int t = 0; t < nt; t += 2) {
            const bool last = (t == nt - 2);
            const char* a1 = cA + (size_t)(t + 1) * kstep;
            const char* a2 = last ? nA : cA + (size_t)(t + 2) * kstep; const char* b2 = last ? nB : cB + (size_t)(t + 2) * kstep;
            const char* a3 = a2 + kstep; const char* b3 = b2 + kstep;
            if (last && has_next) S.a_ready(nxt);
            PG8_LDB(B0, 0, 0); PG8_SCHED; PG8_LDA(At, 0, 0); PG8_STAGE(PG8_SA(1, 1), a1 + hstep, voffA);
            PG8_WAIT_L(8); PG8_BAR; PG8_WAIT_L(0); PG8_MMA(0, 0, At, B0); PG8_BAR; PG8_SCHED;
            PG8_LDB(B1, 0, 1); PG8_STAGE(PG8_SB(0, 0), b2, voffB);
            PG8_BAR; PG8_WAIT_L(0); PG8_MMA(0, 1, At, B1); PG8_BAR;
            PG8_LDA(At, 0, 1); PG8_STAGE(PG8_SA(0, 0), a2, voffA);
            PG8_BAR; PG8_WAIT_L(0); PG8_MMA(1, 0, At, B0); PG8_BAR; PG8_SCHED;
            PG8_STAGE(PG8_SB(0, 1), b2 + hstep, voffB);
            PG8_WAIT_V(6); PG8_BAR; PG8_MMA(1, 1, At, B1); PG8_BAR;
            PG8_LDB(B0, 1, 0); PG8_SCHED; PG8_LDA(At, 1, 0); PG8_STAGE(PG8_SA(0, 1), a2 + hstep, voffA);
            PG8_WAIT_L(8); PG8_BAR; PG8_WAIT_L(0); PG8_MMA(0, 0, At, B0); PG8_BAR; PG8_SCHED;
            PG8_LDB(B1, 1, 1); PG8_STAGE(PG8_SB(1, 0), b3, voffB);
            PG8_BAR; PG8_WAIT_L(0); PG8_MMA(0, 1, At, B1); PG8_BAR;
            PG8_LDA(At, 1, 1); PG8_STAGE(PG8_SA(1, 0), a3, voffA);
            PG8_BAR; PG8_WAIT_L(0); PG8_MMA(1, 0, At, B0); PG8_BAR; PG8_SCHED;
            PG8_STAGE(PG8_SB(1, 1), b3 + hstep, voffB);
            PG8_WAIT_V(6); PG8_BAR; PG8_MMA(1, 1, At, B1); PG8_BAR;
        }
        E(acc, cur, wr, wc, fr, fq);
        if (!has_next) break;
#pragma unroll
        for (int a = 0; a < 2; ++a)
#pragma unroll
            for (int b = 0; b < 2; ++b)
#pragma unroll
                for (int m = 0; m < 4; ++m)
#pragma unroll
                    for (int n = 0; n < 2; ++n) acc[a][b][m][n] = (f32x4){0.f, 0.f, 0.f, 0.f};
        cur = nxt; cA = nA; cB = nB; ++ui;
    }
    PG8_WAIT_V(0);
    if (wr == 0) PG8_BAR;
    PG8_BAR;
#undef PG8_SA
#undef PG8_SB
#undef PG8_STAGE
#undef PG8_LDA
#undef PG8_LDB
#undef PG8_MMA
#undef PG8_WAIT_V
#undef PG8_WAIT_L
#undef PG8_BAR
#undef PG8_SCHED
}
}

struct EpiP {
    static constexpr bool PERM = false;
    bf16_t* P;
    __device__ __forceinline__ void operator()(const f32x4 (&acc)[2][2][4][2], const pg8::Unit& u, int wr, int wc, int fr, int fq) const {
        const int row0 = u.pm * 256 + wr * 64 + fr, col0 = u.pn * 256 + wc * 32 + 4 * fq;
#pragma unroll
        for (int ai = 0; ai < 2; ++ai)
#pragma unroll
            for (int m = 0; m < 4; ++m) { bf16_t* rowp = P + (size_t)(row0 + ai * 128 + m * 16) * INW;
#pragma unroll
                for (int bj = 0; bj < 2; ++bj)
#pragma unroll
                    for (int n = 0; n < 2; ++n) { const int c = col0 + bj * 128 + n * 16; const f32x4 v = acc[ai][bj][m][n];
                        if (c < INW) { u32x2 w2; w2.x = cvt_pk_bf16(v[0], v[1]); w2.y = cvt_pk_bf16(v[2], v[3]); *(u32x2*)(rowp + c) = w2; } } }
    }
};
struct EpiRelu2 {
    static constexpr bool PERM = false;
    bf16_t* O;
    __device__ __forceinline__ void operator()(const f32x4 (&acc)[2][2][4][2], const pg8::Unit& u, int wr, int wc, int fr, int fq) const {
        const int row0 = u.pm * 256 + wr * 64 + fr, col0 = u.pn * 256 + wc * 32 + 4 * fq;
#pragma unroll
        for (int ai = 0; ai < 2; ++ai)
#pragma unroll
            for (int m = 0; m < 4; ++m) { bf16_t* rowp = O + (size_t)(row0 + ai * 128 + m * 16) * DFF;
#pragma unroll
                for (int bj = 0; bj < 2; ++bj)
#pragma unroll
                    for (int n = 0; n < 2; ++n) { const int c = col0 + bj * 128 + n * 16; f32x4 v = acc[ai][bj][m][n];
#pragma unroll
                        for (int j = 0; j < 4; ++j) { const float r = fmaxf(v[j], 0.f); v[j] = r * r; }
                        u32x2 w2; w2.x = cvt_pk_bf16(v[0], v[1]); w2.y = cvt_pk_bf16(v[2], v[3]); *(u32x2*)(rowp + c) = w2; } }
    }
};
struct EpiRes {
    static constexpr bool PERM = false;
    const float* xin_lat; const float* xin_ctx; float* xout_lat; float* xout_ctx; const float* gate;
    __device__ __forceinline__ void operator()(const f32x4 (&acc)[2][2][4][2], const pg8::Unit& u, int wr, int wc, int fr, int fq) const {
        const int row0 = u.pm * 256 + wr * 64 + fr, col0 = u.pn * 256 + wc * 32 + 4 * fq;
        const int rb = u.pm * 256;
        const bool isctx = rb >= NLAT;
        const int bidx = isctx ? 8 : (rb >> 12);
        const float* xi = isctx ? xin_ctx - (size_t)NLAT * DM : xin_lat;
        float* xo = isctx ? xout_ctx - (size_t)NLAT * DM : xout_lat;
        const float* gp = gate + (size_t)bidx * 6 * DM;
        f32x4 gv[2][2];
#pragma unroll
        for (int bj = 0; bj < 2; ++bj)
#pragma unroll
            for (int n = 0; n < 2; ++n) gv[bj][n] = *(const f32x4*)(gp + col0 + bj * 128 + n * 16);
#pragma unroll
        for (int ai = 0; ai < 2; ++ai)
#pragma unroll
            for (int m = 0; m < 4; ++m) { const size_t ro = (size_t)(row0 + ai * 128 + m * 16) * DM;
#pragma unroll
                for (int bj = 0; bj < 2; ++bj)
#pragma unroll
                    for (int n = 0; n < 2; ++n) { const int c = col0 + bj * 128 + n * 16; const f32x4 xv = *(const f32x4*)(xi + ro + c);
                        *(f32x4*)(xo + ro + c) = xv + gv[bj][n] * acc[ai][bj][m][n]; } }
    }
};

__device__ void transpose_tile(const float* __restrict__ src, int K, int N, bf16_t* __restrict__ dst, int tk, int tn, float* tile) {
    const int tid = otid(), k0 = tk * 64, n0 = tn * 64, cl = tid & 63, r0 = tid >> 6;
#pragma unroll
    for (int i = 0; i < 8; ++i) { const int r = r0 + 8 * i, n = n0 + cl; tile[r * 65 + cl] = (n < N) ? src[(size_t)(k0 + r) * N + n] : 0.f; }
    __syncthreads();
#pragma unroll
    for (int i = 0; i < 8; ++i) { const int rn = r0 + 8 * i; dst[(size_t)(n0 + rn) * K + k0 + cl] = f2bf(tile[cl * 65 + rn]); }
    __syncthreads();
}
__device__ void phase_prep(const Params& p, unsigned char* lds) {
    float* tile = (float*)lds;
    const int tid = otid();
    constexpr int T_IN = 16 * 60, T_OUT = 16 * 16, T_1 = 16 * 64, T_2 = 64 * 16, T_L = T_IN + T_OUT + T_1 + T_2;
    for (int t = blockIdx.x; t < 2 * T_L; t += gridDim.x) {
        const int l = t / T_L; int r = t % T_L;
        if (r < T_IN) transpose_tile(p.w_in + (size_t)l * DM * INW, DM, INW, (bf16_t*)(p.ws + WS_WIN) + (size_t)l * INWP * DM, r / 60, r % 60, tile);
        else if ((r -= T_IN) < T_OUT) transpose_tile(p.w_out + (size_t)l * DM * DM, DM, DM, (bf16_t*)(p.ws + WS_WOUT) + (size_t)l * DM * DM, r / 16, r % 16, tile);
        else if ((r -= T_OUT) < T_1) transpose_tile(p.w_mlp1 + (size_t)l * DM * DFF, DM, DFF, (bf16_t*)(p.ws + WS_W1) + (size_t)l * DFF * DM, r / 64, r % 64, tile);
        else { r -= T_1; transpose_tile(p.w_mlp2 + (size_t)l * DFF * DM, DFF, DM, (bf16_t*)(p.ws + WS_W2) + (size_t)l * DM * DFF, r / 16, r % 16, tile); }
    }
    float* red = (float*)lds;
    const int w = tid >> 6, lane = tid & 63;
    for (int it = blockIdx.x; it < 2 * 96; it += gridDim.x) {
        const int l = it / 96, j0 = (it % 96) * 64;
        float a[9];
#pragma unroll
        for (int r = 0; r < 9; ++r) a[r] = 0.f;
        const float* wp = p.ada_w + (size_t)l * DM * 6 * DM + j0 + lane;
        for (int k = w * 128; k < w * 128 + 128; ++k) {
            const float wv = wp[(size_t)k * 6 * DM];
#pragma unroll
            for (int r = 0; r < 9; ++r) { const float cv = (r < 8) ? p.c[r * DM + k] : p.c_ctx[k]; a[r] += silu_f(cv) * wv; }
        }
        __syncthreads();
#pragma unroll
        for (int r = 0; r < 9; ++r) red[(w * 9 + r) * 64 + lane] = a[r];
        __syncthreads();
        for (int idx = tid; idx < 9 * 64; idx += 512) { const int r = idx >> 6, ln = idx & 63; float s = 0.f;
#pragma unroll
            for (int ww = 0; ww < 8; ++ww) s += red[(ww * 9 + r) * 64 + ln];
            ((float*)(p.ws + WS_MOD))[((size_t)l * 9 + r) * 6 * DM + j0 + ln] = s + p.ada_b[(size_t)l * 6 * DM + j0 + ln]; }
    }
    if (blockIdx.x == gridDim.x - 1) {
        float* tab = (float*)(p.ws + WS_TAB);
        for (int idx = tid; idx < 2048; idx += 512) { const int pos = idx >> 5, i = idx & 31; const float inv = powf(10000.0f, -(float)i / 32.0f); const float ang = (float)pos * inv;
            tab[idx] = cosf(ang); tab[2048 + idx] = sinf(ang); }
    }
    __syncthreads();
}

__device__ __forceinline__ const float* xrow(const float* lat, const float* ctx, int m) { return m < NLAT ? lat + (size_t)m * DM : ctx + (size_t)(m - NLAT) * DM; }
__device__ void phase_norm(const Params& p, const float* xl, const float* xc, const float* g, const float* mod_l, int sh_off, int nrows) {
    const int tid_ = otid(); const int lane = tid_ & 63, gw = blockIdx.x * 8 + (tid_ >> 6), nw = gridDim.x * 8;
    bf16_t* H = (bf16_t*)(p.ws + WS_H);
    for (int m = gw; m < nrows; m += nw) {
        const float* xr = xrow(xl, xc, m);
        const int b = m < NLAT ? (m >> 12) : 8;
        const float* sh = mod_l + (size_t)b * 6 * DM + sh_off; const float* sc = sh + DM;
        f32x4 v[4]; float ss = 0.f;
#pragma unroll
        for (int i = 0; i < 4; ++i) { v[i] = *(const f32x4*)(xr + 4 * lane + 256 * i); ss += v[i][0] * v[i][0] + v[i][1] * v[i][1] + v[i][2] * v[i][2] + v[i][3] * v[i][3]; }
#pragma unroll
        for (int o = 32; o >= 1; o >>= 1) ss += __shfl_xor(ss, o);
        const float rinv = rsqrtf(ss * (1.0f / DM) + 1e-6f);
#pragma unroll
        for (int i = 0; i < 4; ++i) { const int c = 4 * lane + 256 * i; const f32x4 gg = *(const f32x4*)(g + c), s1 = *(const f32x4*)(sc + c), s0 = *(const f32x4*)(sh + c);
            f32x4 y;
#pragma unroll
            for (int j = 0; j < 4; ++j) y[j] = (v[i][j] * rinv * gg[j]) * (1.f + s1[j]) + s0[j];
            u32x2 w2; w2.x = cvt_pk_bf16(y[0], y[1]); w2.y = cvt_pk_bf16(y[2], y[3]); *(u32x2*)(H + (size_t)m * DM + c) = w2; }
    }
}
__device__ void phase_final(const Params& p) {
    const int tid_ = otid(); const int lane = tid_ & 63, gw = blockIdx.x * 8 + (tid_ >> 6), nw = gridDim.x * 8;
    for (int m = gw; m < NLAT; m += nw) {
        float* xr = p.out + (size_t)m * DM;
        f32x4 v[4]; float ss = 0.f;
#pragma unroll
        for (int i = 0; i < 4; ++i) { v[i] = *(const f32x4*)(xr + 4 * lane + 256 * i); ss += v[i][0] * v[i][0] + v[i][1] * v[i][1] + v[i][2] * v[i][2] + v[i][3] * v[i][3]; }
#pragma unroll
        for (int o = 32; o >= 1; o >>= 1) ss += __shfl_xor(ss, o);
        const float rinv = rsqrtf(ss * (1.0f / DM) + 1e-6f);
#pragma unroll
        for (int i = 0; i < 4; ++i) { const int c = 4 * lane + 256 * i; const f32x4 gg = *(const f32x4*)(p.final_g + c);
            f32x4 y;
#pragma unroll
            for (int j = 0; j < 4; ++j) y[j] = v[i][j] * rinv * gg[j];
            *(f32x4*)(xr + c) = y; }
    }
}

__device__ void phase_merge(const Params& p, int l, int nrows) {
    const int tid_ = otid(); const int lane = tid_ & 63, gw = blockIdx.x * 8 + (tid_ >> 6), nw = gridDim.x * 8;
    bf16_t* H = (bf16_t*)(p.ws + WS_H); const bf16_t* OB = (const bf16_t*)(p.ws + WS_OB); const bf16_t* P = (const bf16_t*)(p.ws + WS_P);
    const bool isgla = lane >= 32;
    const int gcol = isgla ? (2560 + 16 * lane) : (1536 + 16 * lane);
    const float* gn = p.gla_norm_g + l * 128 + ((16 * lane) & 127);
    for (int m = gw; m < nrows; m += nw) {
        const bf16x8 f0 = *(const bf16x8*)(H + (size_t)m * DM + 16 * lane), f1 = *(const bf16x8*)(H + (size_t)m * DM + 16 * lane + 8);
#ifdef NO_SCAN
        const bf16x8 b0 = (bf16x8){0,0,0,0,0,0,0,0}, b1 = b0; (void)OB;
#else
        const bf16x8 b0 = *(const bf16x8*)(OB + (size_t)m * DM + 16 * lane), b1 = *(const bf16x8*)(OB + (size_t)m * DM + 16 * lane + 8);
#endif
        const bf16x8 g0 = *(const bf16x8*)(P + (size_t)m * INW + gcol), g1 = *(const bf16x8*)(P + (size_t)m * INW + gcol + 8);
        float r[16]; float s1 = 0.f, s2 = 0.f;
#pragma unroll
        for (int j = 0; j < 8; ++j) { r[j] = bf2f(f0[j]) + bf2f(b0[j]); r[8 + j] = bf2f(f1[j]) + bf2f(b1[j]); }
#ifdef SANITIZE
#pragma unroll
        for (int j = 0; j < 16; ++j) { if (!(fabsf(r[j]) < 1e30f)) r[j] = 0.f; }
#endif
#ifdef SKIP_GLA
        if (isgla) {
#pragma unroll
            for (int j = 0; j < 16; ++j) r[j] = 0.f; }
#endif
#ifdef SKIP_RET
        if (!isgla) {
#pragma unroll
            for (int j = 0; j < 16; ++j) r[j] = 0.f; }
#endif
#pragma unroll
        for (int j = 0; j < 16; ++j) { s1 += r[j]; s2 += r[j] * r[j]; }
#pragma unroll
        for (int o = 1; o <= 4; o <<= 1) { s1 += __shfl_xor(s1, o); s2 += __shfl_xor(s2, o); }
        float y[16];
        if (!isgla) {
            const float mu = s1 * (1.f / 128.f); float sv = 0.f;
#pragma unroll
            for (int j = 0; j < 16; ++j) { const float d = r[j] - mu; sv += d * d; }
#pragma unroll
            for (int o = 1; o <= 4; o <<= 1) sv += __shfl_xor(sv, o);
            const float rs = rsqrtf(sv * (1.f / 128.f) + 1e-6f);
#pragma unroll
            for (int j = 0; j < 16; ++j) y[j] = (r[j] - mu) * rs;
        } else {
            float sv = 0.f;
#pragma unroll
            for (int o = 1; o <= 4; o <<= 1) sv += __shfl_xor(sv, o);
            const float rs = rsqrtf(s2 * (1.f / 128.f) + 1e-6f);
#pragma unroll
            for (int j = 0; j < 16; ++j) y[j] = r[j] * rs * gn[j] + 0.f * sv;
        }
        u32x4 o0, o1;
#pragma unroll
        for (int j = 0; j < 8; ++j) { y[j] *= silu_f(bf2f(g0[j])); y[8 + j] *= silu_f(bf2f(g1[j])); }
        o0.x = cvt_pk_bf16(y[0], y[1]); o0.y = cvt_pk_bf16(y[2], y[3]); o0.z = cvt_pk_bf16(y[4], y[5]); o0.w = cvt_pk_bf16(y[6], y[7]);
        o1.x = cvt_pk_bf16(y[8], y[9]); o1.y = cvt_pk_bf16(y[10], y[11]); o1.z = cvt_pk_bf16(y[12], y[13]); o1.w = cvt_pk_bf16(y[14], y[15]);
        *(u32x4*)(H + (size_t)m * DM + 16 * lane) = o0; *(u32x4*)(H + (size_t)m * DM + 16 * lane + 8) = o1;
    }
}

template <int DK, bool GLA>
__device__ __forceinline__ void scan_item(const Params& p, int l, unsigned char* lds, int b, int h, int dir, int dvs) {
    constexpr int QS = DK + 8, TS = 72, NT = DK / 32, NKS = DK / 32;
    bf16_t* QD = (bf16_t*)lds;
    bf16_t* KI = QD + 64 * QS;
    bf16_t* ST = KI + 64 * QS;
    bf16_t* KET = ST + 64 * QS;
    bf16_t* VT = KET + DK * TS;
    bf16_t* SC = VT + 64 * TS;
    float* DVEC = (float*)(SC + 64 * TS);
    float* CL = DVEC + DK;
    float* CUM = CL + DK;
    float* UP = CUM + 64 * 68;
    const int tid = otid(), lane = tid & 63, w = tid >> 6, fr = lane & 15, fq = lane >> 4;
    const bf16_t* P = (const bf16_t*)(p.ws + WS_P);
    bf16_t* O = (bf16_t*)(p.ws + (dir ? WS_OB : WS_H));
    const float* TABC = (const float*)(p.ws + WS_TAB); const float* TABS = TABC + 2048;
    const int ocol = (GLA ? 512 : 0) + 128 * h + 64 * dvs;
    const int qcol = GLA ? 2048 + 64 * h : 128 * h, kcol = GLA ? 2304 + 64 * h : 512 + 128 * h, vcol = (GLA ? 2560 : 1024) + 128 * h + 64 * dvs;
    float g = 0.f;
    if (!GLA) g = log1pf(-__expf(p.ret_decay[l * 8 + dir * 4 + h]));
    const int dkt = (DK == 128) ? w : (w >> 1);
    const int dvt0 = (DK == 128) ? 0 : 2 * (w & 1);
    f32x4 S[NT];
#pragma unroll
    for (int i = 0; i < NT; ++i) S[i] = (f32x4){0.f, 0.f, 0.f, 0.f};
    __syncthreads();
    for (int i = tid; i < 64 * QS / 2; i += 512) ((unsigned*)ST)[i] = 0u;
    bf16x8 uph[2], upl[2]; float ubv[2];
    uph[0] = uph[1] = upl[0] = upl[1] = (bf16x8){0, 0, 0, 0, 0, 0, 0, 0}; ubv[0] = ubv[1] = 0.f;
    float* TT = UP;
    if (GLA) {
#pragma unroll
        for (int ci = 0; ci < 2; ++ci) {
            const int ch = 16 * (2 * (w & 1) + ci) + fr;
#pragma unroll
            for (int j = 0; j < 8; ++j) {
                const float val = (fq < 2) ? p.gate_up[((size_t)(l * 2 + dir) * 16 + 8 * fq + j) * 256 + 64 * h + ch] : 0.f;
                const bf16_t hi = f2bf(val); const float rem = val - bf2f((short)hi);
                uph[ci][j] = (short)hi; upl[ci][j] = (short)f2bf(rem);
            }
            ubv[ci] = p.gate_b[(l * 2 + dir) * 256 + 64 * h + ch];
        }
    } else {
        if (tid < DK) DVEC[tid] = __expf(64.f * g);
    }
    __syncthreads();
    const int s_a = tid >> 3, pr = tid & 7, c8a = (pr & 3) + 8 * (pr >> 2), c8g = tid & 7;
    bf16x8 nq1, nq2, nk1, nk2, nv1, nd0, nd1; f32x4 nc0, nc1, ns0, ns1;
    nq2 = nq1 = nk1 = nk2 = nv1 = nd0 = nd1 = (bf16x8){0, 0, 0, 0, 0, 0, 0, 0}; nc0 = nc1 = ns0 = ns1 = (f32x4){0.f, 0.f, 0.f, 0.f};
#define SCAN_STEP_GEOM(stp, isctx_, chunk_, m0_) \
    const bool isctx_ = (stp) < 4; \
    const int chunk_ = dir == 0 ? (isctx_ ? (stp) : (stp) - 4) : (isctx_ ? 3 - (stp) : 67 - (stp)); \
    const int m0_ = isctx_ ? (NLAT + b * CTXL + chunk_ * 64) : (b * SEQ + chunk_ * 64);
#define SCAN_ISSUE(stp) do { SCAN_STEP_GEOM(stp, ic_, ch_, mm_) \
        const bf16_t* rp_ = P + (size_t)(mm_ + s_a) * INW; \
        if (GLA) { if (fq < 2) { const bf16_t* dp_ = P + (size_t)(mm_ + 16 * (w >> 1) + fr) * INW + 3584 + 16 * dir + 8 * fq; nd0 = *(const bf16x8*)dp_; } \
            nq1 = *(const bf16x8*)(rp_ + qcol + 8 * c8g); nk1 = *(const bf16x8*)(rp_ + kcol + 8 * c8g); } \
        else { nq1 = *(const bf16x8*)(rp_ + qcol + 8 * c8a); nq2 = *(const bf16x8*)(rp_ + qcol + 8 * (c8a + 4)); \
            nk1 = *(const bf16x8*)(rp_ + kcol + 8 * c8a); nk2 = *(const bf16x8*)(rp_ + kcol + 8 * (c8a + 4)); \
            const int pos_ = ic_ ? 0 : ((pr >> 2) ? s_a : ch_); \
            nc0 = *(const f32x4*)(TABC + pos_ * 32 + 8 * (pr & 3)); nc1 = *(const f32x4*)(TABC + pos_ * 32 + 8 * (pr & 3) + 4); \
            ns0 = *(const f32x4*)(TABS + pos_ * 32 + 8 * (pr & 3)); ns1 = *(const f32x4*)(TABS + pos_ * 32 + 8 * (pr & 3) + 4); } \
        nv1 = *(const bf16x8*)(rp_ + vcol + 8 * c8g); } while (0)
#define TSW(row, sgrp) ((row) * TS + (((((sgrp)) ^ ((row) >> 4)) & 7) << 3))
    SCAN_ISSUE(0);
    for (int step = 0; step < 68; ++step) {
        SCAN_STEP_GEOM(step, isctx, chunk, m0)
        const bf16x8 q1 = nq1, q2 = nq2, k1 = nk1, k2 = nk2, v1 = nv1, d0 = nd0, d1 = nd1; const f32x4 tc0 = nc0, tc1 = nc1, ts0 = ns0, ts1 = ns1;
        { const int nstep = step + 1 < 68 ? step + 1 : 67; SCAN_ISSUE(nstep); }
        (void)chunk;
        if (GLA) {
            const int st = w >> 1;
#pragma unroll
            for (int ci = 0; ci < 2; ++ci) {
                const int ch = 16 * (2 * (w & 1) + ci) + fr;
                f32x4 z = __builtin_amdgcn_mfma_f32_16x16x32_bf16(d0, uph[ci], (f32x4){0.f, 0.f, 0.f, 0.f}, 0, 0, 0);
                z = __builtin_amdgcn_mfma_f32_16x16x32_bf16(d0, upl[ci], z, 0, 0, 0);
                float la[4], pz[4];
#pragma unroll
                for (int r = 0; r < 4; ++r) { const float zz = z[r] + ubv[ci]; la[r] = (fminf(zz, 0.f) - __logf(1.f + __expf(-fabsf(zz)))) * (1.0f / 16.0f); }
                float T, ex = 0.f;
                if (dir == 0) {
                    pz[0] = la[0]; pz[1] = pz[0] + la[1]; pz[2] = pz[1] + la[2]; pz[3] = pz[2] + la[3]; T = pz[3];
                    const float t1 = __shfl_up(T, 16), t2 = __shfl_up(T, 32), t3 = __shfl_up(T, 48);
                    if (fq >= 1) ex += t1; if (fq >= 2) ex += t2; if (fq >= 3) ex += t3;
                } else {
                    pz[3] = la[3]; pz[2] = pz[3] + la[2]; pz[1] = pz[2] + la[1]; pz[0] = pz[1] + la[0]; T = pz[0];
                    const float t1 = __shfl_down(T, 16), t2 = __shfl_down(T, 32), t3 = __shfl_down(T, 48);
                    if (fq <= 2) ex += t1; if (fq <= 1) ex += t2; if (fq == 0) ex += t3;
                }
                const float ttot = __shfl(T + ex, dir == 0 ? 48 + fr : fr);
#pragma unroll
                for (int r = 0; r < 4; ++r) CUM[(16 * st + 4 * fq + r) * 68 + ch] = pz[r] + ex;
                if (fq == 0) TT[st * 64 + ch] = ttot;
            }
            __syncthreads();
        }
        {
            const int s = s_a;
            if (!GLA) {
                const float cum = dir == 0 ? g * (float)(s + 1) : g * (float)(64 - s), cl = 64.f * g;
                const float eq = __expf(cum) * 0.08838834764831845f, eki = __expf(-cum), eke = __expf(cl - cum);
                float cs[8], sn[8];
#pragma unroll
                for (int j = 0; j < 4; ++j) { cs[j] = isctx ? 1.f : tc0[j]; cs[4 + j] = isctx ? 1.f : tc1[j]; sn[j] = isctx ? 0.f : ts0[j]; sn[4 + j] = isctx ? 0.f : ts1[j]; }
                float qa[8], qb[8], ka[8], kb[8];
#pragma unroll
                for (int j = 0; j < 8; ++j) {
                    const float a1 = bf2f(q1[j]), a2 = bf2f(q2[j]), b1 = bf2f(k1[j]), b2 = bf2f(k2[j]);
                    qa[j] = a1 * cs[j] - a2 * sn[j]; qb[j] = a1 * sn[j] + a2 * cs[j];
                    ka[j] = b1 * cs[j] - b2 * sn[j]; kb[j] = b1 * sn[j] + b2 * cs[j];
                }
                u32x4 o;
                o.x = cvt_pk_bf16(qa[0] * eq, qa[1] * eq); o.y = cvt_pk_bf16(qa[2] * eq, qa[3] * eq); o.z = cvt_pk_bf16(qa[4] * eq, qa[5] * eq); o.w = cvt_pk_bf16(qa[6] * eq, qa[7] * eq);
                *(u32x4*)(QD + s * QS + 8 * c8a) = o;
                o.x = cvt_pk_bf16(qb[0] * eq, qb[1] * eq); o.y = cvt_pk_bf16(qb[2] * eq, qb[3] * eq); o.z = cvt_pk_bf16(qb[4] * eq, qb[5] * eq); o.w = cvt_pk_bf16(qb[6] * eq, qb[7] * eq);
                *(u32x4*)(QD + s * QS + 8 * (c8a + 4)) = o;
                o.x = cvt_pk_bf16(ka[0] * eki, ka[1] * eki); o.y = cvt_pk_bf16(ka[2] * eki, ka[3] * eki); o.z = cvt_pk_bf16(ka[4] * eki, ka[5] * eki); o.w = cvt_pk_bf16(ka[6] * eki, ka[7] * eki);
                *(u32x4*)(KI + s * QS + 8 * c8a) = o;
                o.x = cvt_pk_bf16(kb[0] * eki, kb[1] * eki); o.y = cvt_pk_bf16(kb[2] * eki, kb[3] * eki); o.z = cvt_pk_bf16(kb[4] * eki, kb[5] * eki); o.w = cvt_pk_bf16(kb[6] * eki, kb[7] * eki);
                *(u32x4*)(KI + s * QS + 8 * (c8a + 4)) = o;
#pragma unroll
                for (int j = 0; j < 8; ++j) { KET[TSW(8 * c8a + j, s >> 3) + (s & 7)] = f2bf(ka[j] * eke); KET[TSW(8 * (c8a + 4) + j, s >> 3) + (s & 7)] = f2bf(kb[j] * eke); }
            } else {
                const int c8 = c8g;
                f32x4 cu0 = *(const f32x4*)(CUM + s * 68 + 8 * c8), cu1 = *(const f32x4*)(CUM + s * 68 + 8 * c8 + 4);
                f32x4 cl0 = (f32x4){0.f, 0.f, 0.f, 0.f}, cl1 = cl0;
#pragma unroll
                for (int t4 = 0; t4 < 4; ++t4) {
                    const f32x4 a0 = *(const f32x4*)(TT + t4 * 64 + 8 * c8), a1 = *(const f32x4*)(TT + t4 * 64 + 8 * c8 + 4);
                    cl0 += a0; cl1 += a1;
                    const bool inc = dir == 0 ? (t4 < (s >> 4)) : (t4 > (s >> 4));
                    if (inc) { cu0 += a0; cu1 += a1; }
                }
                if (s == 0) {
#pragma unroll
                    for (int j = 0; j < 4; ++j) { DVEC[8 * c8 + j] = __expf(cl0[j]); DVEC[8 * c8 + 4 + j] = __expf(cl1[j]); }
                }
                float qd[8], ki[8];
#pragma unroll
                for (int j = 0; j < 8; ++j) {
                    const float cu = j < 4 ? cu0[j & 3] : cu1[j & 3], cl = j < 4 ? cl0[j & 3] : cl1[j & 3];
                    const float qv = bf2f(q1[j]), kv = bf2f(k1[j]);
                    qd[j] = qv * 0.125f * __expf(cu); ki[j] = kv * __expf(-cu);
                    KET[TSW(8 * c8 + j, s >> 3) + (s & 7)] = f2bf(kv * __expf(cl - cu));
                }
                u32x4 o;
                o.x = cvt_pk_bf16(qd[0], qd[1]); o.y = cvt_pk_bf16(qd[2], qd[3]); o.z = cvt_pk_bf16(qd[4], qd[5]); o.w = cvt_pk_bf16(qd[6], qd[7]);
                *(u32x4*)(QD + s * QS + 8 * c8) = o;
                o.x = cvt_pk_bf16(ki[0], ki[1]); o.y = cvt_pk_bf16(ki[2], ki[3]); o.z = cvt_pk_bf16(ki[4], ki[5]); o.w = cvt_pk_bf16(ki[6], ki[7]);
                *(u32x4*)(KI + s * QS + 8 * c8) = o;
            }
            {
                const int c8 = c8g;
#pragma unroll
                for (int j = 0; j < 8; ++j) VT[TSW(8 * c8 + j, s >> 3) + (s & 7)] = (bf16_t)v1[j];
            }
        }
        __syncthreads();
        {
            const int tt = w >> 1;
#pragma unroll
            for (int si = 0; si < 2; ++si) {
                const int st = 2 * (w & 1) + si;
                f32x4 acc = (f32x4){0.f, 0.f, 0.f, 0.f};
#pragma unroll
                for (int ks = 0; ks < NKS; ++ks) {
                    const bf16x8 a = *(const bf16x8*)(KI + (16 * st + fr) * QS + 32 * ks + 8 * fq);
                    const bf16x8 bb = *(const bf16x8*)(QD + (16 * tt + fr) * QS + 32 * ks + 8 * fq);
                    acc = __builtin_amdgcn_mfma_f32_16x16x32_bf16(a, bb, acc, 0, 0, 0);
                }
                const int t = 16 * tt + fr, s0 = 16 * st + 4 * fq;
                float v[4];
#pragma unroll
                for (int r = 0; r < 4; ++r) { const int s = s0 + r; const bool keep = dir == 0 ? (s <= t) : (s > t); v[r] = keep ? acc[r] : 0.f; }
                u32x2 w2; w2.x = cvt_pk_bf16(v[0], v[1]); w2.y = cvt_pk_bf16(v[2], v[3]);
                *(u32x2*)(SC + t * TS + s0) = w2;
            }
        }
        __syncthreads();
        {
            const int tt = w >> 1;
#pragma unroll
            for (int di = 0; di < 2; ++di) {
                const int dvt = 2 * (w & 1) + di;
                f32x4 acc = (f32x4){0.f, 0.f, 0.f, 0.f};
#pragma unroll
                for (int ks = 0; ks < 2; ++ks) {
                    const bf16x8 a = *(const bf16x8*)(VT + TSW(16 * dvt + fr, 4 * ks + fq));
                    const bf16x8 bb = *(const bf16x8*)(SC + (16 * tt + fr) * TS + 32 * ks + 8 * fq);
                    acc = __builtin_amdgcn_mfma_f32_16x16x32_bf16(a, bb, acc, 0, 0, 0);
                }
#pragma unroll
                for (int ks = 0; ks < NKS; ++ks) {
                    const bf16x8 a = *(const bf16x8*)(ST + (16 * dvt + fr) * QS + 32 * ks + 8 * fq);
                    const bf16x8 bb = *(const bf16x8*)(QD + (16 * tt + fr) * QS + 32 * ks + 8 * fq);
                    acc = __builtin_amdgcn_mfma_f32_16x16x32_bf16(a, bb, acc, 0, 0, 0);
                }
                u32x2 w2; w2.x = cvt_pk_bf16(acc[0], acc[1]); w2.y = cvt_pk_bf16(acc[2], acc[3]);
                *(u32x2*)(O + (size_t)(m0 + 16 * tt + fr) * DM + ocol + 16 * dvt + 4 * fq) = w2;
            }
            const f32x4 dv4 = *(const f32x4*)(DVEC + 16 * dkt + 4 * fq);
#pragma unroll
            for (int i = 0; i < NT; ++i) {
                const int dvt = dvt0 + i;
                S[i] = S[i] * dv4;
#pragma unroll
                for (int ks = 0; ks < 2; ++ks) {
                    const bf16x8 a = *(const bf16x8*)(KET + TSW(16 * dkt + fr, 4 * ks + fq));
                    const bf16x8 bb = *(const bf16x8*)(VT + TSW(16 * dvt + fr, 4 * ks + fq));
                    S[i] = __builtin_amdgcn_mfma_f32_16x16x32_bf16(a, bb, S[i], 0, 0, 0);
                }
            }
        }
        __syncthreads();
#pragma unroll
        for (int i = 0; i < NT; ++i) {
            const int dvt = dvt0 + i;
            u32x2 w2; w2.x = cvt_pk_bf16(S[i][0], S[i][1]); w2.y = cvt_pk_bf16(S[i][2], S[i][3]);
            *(u32x2*)(ST + (16 * dvt + fr) * QS + 16 * dkt + 4 * fq) = w2;
        }
    }
    __syncthreads();
#undef SCAN_STEP_GEOM
#undef SCAN_ISSUE
#undef TSW
}
__device__ void phase_scan(const Params& p, int l, unsigned char* lds) {
    for (int it = blockIdx.x; it < 256; it += gridDim.x) {
        const int isgla = it & 1, r = it >> 1;
        const int dvs = r & 1, dir = (r >> 1) & 1, h = (r >> 2) & 3, b = r >> 4;
#ifdef SKIP_GLA
        if (isgla) continue;
#endif
#ifdef SKIP_RET
        if (!isgla) continue;
#endif
        if (isgla) scan_item<64, true>(p, l, lds, b, h, dir, dvs);
        else scan_item<128, false>(p, l, lds, b, h, dir, dvs);
    }
}

__global__ void __launch_bounds__(512, 2) fwd_megakernel(Params p) {
    extern __shared__ __attribute__((aligned(16))) unsigned char shm[];
    cg::grid_group grid = cg::this_grid();
    const float* MOD = (const float*)(p.ws + WS_MOD);
    for (int ph = p.ph_lo; ph < p.ph_hi; ++ph) {
        if (ph == 0) phase_prep(p, shm);
        else if (ph == NPHASE - 1) phase_final(p);
        else {
            const int l = (ph - 1) >> 3, sub = (ph - 1) & 7;
            const float* mod_l = MOD + (size_t)l * 9 * 6 * DM;
            const float* xin_lat = l == 0 ? p.x : p.out; const float* xin_ctx = l == 0 ? p.ctx : (const float*)(p.ws + WS_XCTX);
            float* xo_lat = p.out; float* xo_ctx = (float*)(p.ws + WS_XCTX);
            const int mrows = l == 0 ? MTOT : NLAT;
            bf16_t* H = (bf16_t*)(p.ws + WS_H); bf16_t* Pm = (bf16_t*)(p.ws + WS_P);
            pg8::StaticOrder S;
            if (sub == 0) phase_norm(p, xin_lat, xin_ctx, p.norm1_g + l * DM, mod_l, 0, MTOT);
#ifndef NO_G1
            else if (sub == 1) { pg8::Gemm g{H, (const bf16_t*)(p.ws + WS_WIN) + (size_t)l * INWP * DM, MTOT, INWP, DM}; S.init(g.M, g.N, gridDim.x, blockIdx.x);
                EpiP E{Pm}; pg8::gemm_phase(( LAS unsigned char*)shm, g, S, E); }
#endif
#ifndef NO_SCAN
            else if (sub == 2) phase_scan(p, l, shm);
#endif
            else if (sub == 3) phase_merge(p, l, mrows);
#ifndef NO_G2
            else if (sub == 4) { pg8::Gemm g{H, (const bf16_t*)(p.ws + WS_WOUT) + (size_t)l * DM * DM, mrows, DM, DM}; S.init(g.M, g.N, gridDim.x, blockIdx.x);
                EpiRes E{xin_lat, xin_ctx, xo_lat, xo_ctx, mod_l + 2 * DM}; pg8::gemm_phase((LAS unsigned char*)shm, g, S, E); }
#endif
            else if (sub == 5) phase_norm(p, xo_lat, xo_ctx, p.norm2_g + l * DM, mod_l, 3 * DM, mrows);
#ifndef NO_G3
            else if (sub == 6) { pg8::Gemm g{H, (const bf16_t*)(p.ws + WS_W1) + (size_t)l * DFF * DM, mrows, DFF, DM}; S.init(g.M, g.N, gridDim.x, blockIdx.x);
                EpiRelu2 E{Pm}; pg8::gemm_phase((LAS unsigned char*)shm, g, S, E); }
#endif
#ifndef NO_G4
            else if (sub == 7) { pg8::Gemm g{Pm, (const bf16_t*)(p.ws + WS_W2) + (size_t)l * DM * DFF, mrows, DM, DFF}; S.init(g.M, g.N, gridDim.x, blockIdx.x);
                EpiRes E{xo_lat, xo_ctx, xo_lat, xo_ctx, mod_l + 5 * DM}; pg8::gemm_phase((LAS unsigned char*)shm, g, S, E); }
#endif
        }
        if (ph + 1 < p.ph_hi) grid.sync();
    }
}

extern "C" void kernel_launch(void* const* d_in, const int* in_sizes, int n_in, void* d_out, int out_size, void* d_ws, size_t ws_size, hipStream_t stream) {
    static int grid_blocks = 0;
    if (!grid_blocks) {
        int dev = 0, cus = 0, per_cu = 0;
        hipGetDevice(&dev);
        hipDeviceGetAttribute(&cus, hipDeviceAttributeMultiprocessorCount, dev);
        if (hipFuncSetAttribute((const void*)fwd_megakernel, hipFuncAttributeMaxDynamicSharedMemorySize, LDS_BYTES) != hipSuccess) fprintf(stderr, "hipFuncSetAttribute failed\n");
        if (hipOccupancyMaxActiveBlocksPerMultiprocessor(&per_cu, (const void*)fwd_megakernel, 512, LDS_BYTES) != hipSuccess || per_cu < 1) { fprintf(stderr, "occupancy query: %d\n", per_cu); per_cu = 1; }
        (void)hipGetLastError();
        grid_blocks = cus * per_cu;
        if (ws_size < WS_END) fprintf(stderr, "workspace too small: %zu < %zu\n", ws_size, (size_t)WS_END);
    }
    Params p{};
    p.x = (const float*)d_in[0]; p.c = (const float*)d_in[1]; p.ctx = (const float*)d_in[2]; p.c_ctx = (const float*)d_in[3]; p.ada_w = (const float*)d_in[4];
    p.ada_b = (const float*)d_in[5]; p.norm1_g = (const float*)d_in[6]; p.w_in = (const float*)d_in[7]; p.ret_decay = (const float*)d_in[8];
    p.gate_up = (const float*)d_in[9]; p.gate_b = (const float*)d_in[10]; p.gla_norm_g = (const float*)d_in[11]; p.w_out = (const float*)d_in[12];
    p.norm2_g = (const float*)d_in[13]; p.w_mlp1 = (const float*)d_in[14]; p.w_mlp2 = (const float*)d_in[15]; p.final_g = (const float*)d_in[16];
    p.out = (float*)d_out; p.ws = (unsigned char*)d_ws;
#if MULTI
    for (int ph = 0; ph < NPHASE; ++ph) {
        p.ph_lo = ph; p.ph_hi = ph + 1;
        hipLaunchKernelGGL(fwd_megakernel, dim3(grid_blocks), dim3(512), LDS_BYTES, stream, p);
    }
#else
    p.ph_lo = 0; p.ph_hi = NPHASE;
    void* args[] = {&p};
    hipError_t e = hipLaunchCooperativeKernel((const void*)fwd_megakernel, dim3(grid_blocks), dim3(512), args, LDS_BYTES, stream);
    if (e != hipSuccess) fprintf(stderr, "cooperative launch failed: %s (grid %d)\n", hipGetErrorString(e), grid_blocks);
#endif
}
```

```cpp
#include <hip/hip_runtime.h>
#include <hip/hip_cooperative_groups.h>
#include <cstdio>
namespace cg = cooperative_groups;

#ifndef MULTI
#define MULTI 0
#endif

#define LAS __attribute__((address_space(3)))
typedef unsigned short bf16_t;
typedef short bf16x8 __attribute__((ext_vector_type(8)));
typedef short s16x4 __attribute__((ext_vector_type(4)));
typedef float f32x4 __attribute__((ext_vector_type(4)));
typedef unsigned u32x2 __attribute__((ext_vector_type(2)));
typedef unsigned u32x4 __attribute__((ext_vector_type(4)));

constexpr int DM = 1024, NB = 8, SEQ = 4096, CTXL = 256, NLAT = NB * SEQ, NCTX = NB * CTXL, MTOT = NLAT + NCTX;
constexpr int INW = 3616, INWP = 3840, DFF = 4096;
constexpr int NPHASE = 18;
constexpr int LDS_BYTES = 131072 + 16;

constexpr size_t WS_WIN = 0;
constexpr size_t WS_WOUT = WS_WIN + (size_t)2 * INWP * DM * 2;
constexpr size_t WS_W1 = WS_WOUT + (size_t)2 * DM * DM * 2;
constexpr size_t WS_W2 = WS_W1 + (size_t)2 * DFF * DM * 2;
constexpr size_t WS_MOD = WS_W2 + (size_t)2 * DM * DFF * 2;
constexpr size_t WS_TAB = WS_MOD + (size_t)2 * 9 * 6 * DM * 4;
constexpr size_t WS_XCTX = WS_TAB + (size_t)2 * 2048 * 4;
constexpr size_t WS_H = WS_XCTX + (size_t)NCTX * DM * 4;
constexpr size_t WS_P = WS_H + (size_t)MTOT * DM * 2;
constexpr size_t WS_OB = WS_P + (size_t)MTOT * INW * 2;
constexpr size_t WS_END = WS_OB + (size_t)MTOT * DM * 2;
static_assert((size_t)MTOT * DFF * 2 <= WS_END - WS_P, "hmlp alias");
constexpr size_t WS_BAR = WS_END;
constexpr size_t BAR_BYTES = 16384;
constexpr size_t WS_SLAB = WS_BAR + BAR_BYTES;
constexpr int NSPLIT = 8;
static_assert(WS_SLAB + (size_t)NSPLIT * NCTX * DM * 4 <= (size_t)536870912, "ws");

struct Params {
    const float* x; const float* c; const float* ctx; const float* c_ctx; const float* ada_w; const float* ada_b; const float* norm1_g;
    const float* w_in; const float* ret_decay; const float* gate_up; const float* gate_b; const float* gla_norm_g; const float* w_out;
    const float* norm2_g; const float* w_mlp1; const float* w_mlp2; const float* final_g;
    float* out; unsigned char* ws; int ph_lo, ph_hi;
};

typedef float f32x2_t __attribute__((ext_vector_type(2)));
typedef __bf16 bf16x2_t __attribute__((ext_vector_type(2)));
__device__ __forceinline__ unsigned cvt_pk_bf16(float lo, float hi) { f32x2_t v = {lo, hi}; bf16x2_t b = __builtin_convertvector(v, bf16x2_t); return __builtin_bit_cast(unsigned, b); }
__device__ __forceinline__ bf16_t f2bf(float f) { return (bf16_t)(cvt_pk_bf16(f, 0.f) & 0xffffu); }
__device__ __forceinline__ float bf2f(short b) { return __uint_as_float(((unsigned)(unsigned short)b) << 16); }
__device__ __forceinline__ int otid() { int t = threadIdx.x; asm volatile("" : "+v"(t)); return t; }
__device__ __forceinline__ float silu_f(float v) { return v / (1.f + __expf(-v)); }

namespace pg8 {
constexpr int STAGGER_TICKS = 0;
constexpr int BM = 256, BK = 64, HALF = 128, HTB = HALF * BK * 2, STAGE_BYTES = 8 * HTB, NXCD = 8, WGM = 8;
__host__ __device__ __forceinline__ int lds_byte(int r, int c) { const int st = (r >> 4) * 2 + (c >> 5), rr = r & 15, cc = c & 31, ob = rr * 64 + cc * 2; return st * 1024 + (ob ^ (((ob >> 9) & 1) << 5)); }
__host__ __device__ __forceinline__ void stage_rc(int b, int& R, int& C) { const int st = b / 1024, sb = b % 1024, swz = sb ^ (((sb >> 9) & 1) << 5); R = (st >> 1) * 16 + swz / 64; C = (st & 1) * 32 + (swz % 64) / 2; }
__host__ __device__ __forceinline__ int perm32(int rho) { const int n = rho >> 4, i = rho & 15; return 8 * (i >> 2) + 4 * n + (i & 3); }
struct Unit { int pm, pn, kofs, ks; };
struct Gemm { const bf16_t* A; const bf16_t* Bt; int M, N, K, ld; };
struct StaticOrder {
    int nM, nN, nwg, G, c;
    __host__ __device__ void init(int M, int N, int G_, int c_) { nM = M / BM; nN = N / BM; nwg = nM * nN; G = G_; c = c_; }
    __host__ __device__ bool next(int i, Unit& u) const {
        const long L = (long)i * G + c; if (L >= nwg) return false;
        int wgid = (int)L; { const int q = nwg / NXCD, r = nwg % NXCD, xcd = wgid % NXCD, off = wgid / NXCD; wgid = (xcd < r ? xcd * (q + 1) : r * (q + 1) + (xcd - r) * q) + off; }
        const int nig = WGM * nN, gid = wgid / nig, fm = gid * WGM, gsz = (nM - fm) < WGM ? (nM - fm) : WGM;
        u.pm = fm + ((wgid % nig) % gsz); u.pn = (wgid % nig) / gsz; u.kofs = 0; u.ks = 0; return true;
    }
    __device__ __forceinline__ void a_ready(const Unit&) const {}
    __device__ __forceinline__ void done(const Unit&) const {}
};

template <int NS, int KS> struct SplitOrder {
    int G, c;
    __device__ bool next(int i, Unit& u) const {
        const int idx = i * G + c; if (idx >= 32 * NS) return false;
        u.ks = idx % NS; const int t = idx / NS; u.pn = t & 3; u.pm = t >> 2; u.kofs = u.ks * KS * 2; return true;
    }
    __device__ __forceinline__ void a_ready(const Unit&) const {}
    __device__ __forceinline__ void done(const Unit&) const {}
};
template <class Epi, class Sched>
__device__ __forceinline__ void gemm_phase(LAS unsigned char* lds, const Gemm g, const Sched& S, const Epi& E) {
    const int tid = otid(), wid = __builtin_amdgcn_readfirstlane(tid >> 6), lane = tid & 63, wr = wid >> 2, wc = wid & 3, fr = lane & 15, fq = lane >> 4;
    const int K = g.ld, nt = g.K / BK;
    unsigned voffA[2], voffB[2];
#pragma unroll
    for (int i = 0; i < 2; ++i) { int R, C; stage_rc(tid * 16 + i * 8192, R, C); const int Rb = Epi::PERM ? ((R & ~31) + perm32(R & 31)) : R;
        voffA[i] = (unsigned)(R * K + C) * 2u; voffB[i] = (unsigned)(Rb * K + C) * 2u; }
    const size_t kstep = (size_t)(BK * 2);
    const size_t hstep = (size_t)HALF * K * 2;
    const size_t tstep = 2 * hstep;
    const unsigned ldsw = (unsigned)wid * 1024u;
    const int aoff = lds_byte(wr * 64 + fr, fq * 8), boff = lds_byte(wc * 32 + fr, fq * 8);
#define PG8_SA(b, h) (((b) * 2 + (h)) * HTB)
#define PG8_SB(b, h) ((4 + (b) * 2 + (h)) * HTB)
#define PG8_STAGE(bufoff, gbase, voff) do { _Pragma("unroll") for (int _i = 0; _i < 2; ++_i) \
        __builtin_amdgcn_global_load_lds((const unsigned*)((const char*)(gbase) + (voff)[_i]), (LAS unsigned*)(lds + (bufoff) + ldsw + _i * 8192), 16, 0, 0); } while (0)
#define PG8_LDA(dst, b, h) do { _Pragma("unroll") for (int m = 0; m < 4; ++m) _Pragma("unroll") for (int k = 0; k < 2; ++k) dst[m][k] = *(const LAS bf16x8*)(lds + PG8_SA(b, h) + aoff + m * 2048 + k * 1024); } while (0)
#define PG8_LDB(dst, b, h) do { _Pragma("unroll") for (int n = 0; n < 2; ++n) _Pragma("unroll") for (int k = 0; k < 2; ++k) dst[n][k] = *(const LAS bf16x8*)(lds + PG8_SB(b, h) + boff + n * 2048 + k * 1024); } while (0)
#define PG8_MMA(ai, bj, At, Bt) do { __builtin_amdgcn_s_setprio(1); _Pragma("unroll") for (int m = 0; m < 4; ++m) _Pragma("unroll") for (int n = 0; n < 2; ++n) _Pragma("unroll") for (int k = 0; k < 2; ++k) \
        acc[ai][bj][m][n] = __builtin_amdgcn_mfma_f32_16x16x32_bf16(Bt[n][k], At[m][k], acc[ai][bj][m][n], 0, 0, 0); __builtin_amdgcn_s_setprio(0); } while (0)
#define PG8_WAIT_V(n) asm volatile("s_waitcnt vmcnt(" #n ")" ::: "memory")
#define PG8_WAIT_L(n) asm volatile("s_waitcnt lgkmcnt(" #n ")" ::: "memory")
#define PG8_BAR __builtin_amdgcn_s_barrier()
#define PG8_SCHED __builtin_amdgcn_sched_barrier(0)
    Unit cur, nxt; int ui = 0;
    if (!S.next(0, cur)) return;
    if (STAGGER_TICKS > 0 && (blockIdx.x & 1)) {
        const unsigned long long t0 = __builtin_amdgcn_s_memrealtime();
        while (__builtin_amdgcn_s_memrealtime() - t0 < (unsigned long long)STAGGER_TICKS) __builtin_amdgcn_s_sleep(8);
    }
    f32x4 acc[2][2][4][2];
#pragma unroll
    for (int a = 0; a < 2; ++a)
#pragma unroll
        for (int b = 0; b < 2; ++b)
#pragma unroll
            for (int m = 0; m < 4; ++m)
#pragma unroll
                for (int n = 0; n < 2; ++n) acc[a][b][m][n] = (f32x4){0.f, 0.f, 0.f, 0.f};
    bf16x8 At[4][2], B0[2][2], B1[2][2];
    const char* cA = (const char*)g.A + (size_t)cur.pm * tstep + cur.kofs; const char* cB = (const char*)g.Bt + (size_t)cur.pn * tstep + cur.kofs;
    S.a_ready(cur);
    PG8_STAGE(PG8_SB(0, 0), cB, voffB); PG8_STAGE(PG8_SA(0, 0), cA, voffA); PG8_STAGE(PG8_SB(0, 1), cB + hstep, voffB); PG8_STAGE(PG8_SA(0, 1), cA + hstep, voffA);
    if (wr == 1) PG8_BAR;
    PG8_WAIT_V(4); PG8_BAR;
    PG8_STAGE(PG8_SB(1, 0), cB + kstep, voffB); PG8_STAGE(PG8_SA(1, 0), cA + kstep, voffA); PG8_STAGE(PG8_SB(1, 1), cB + hstep + kstep, voffB);
    PG8_WAIT_V(6); PG8_BAR;
    for (;;) {
        const bool has_next = S.next(ui + 1, nxt);
        const char* nA = has_next ? (const char*)g.A + (size_t)nxt.pm * tstep + nxt.kofs : cA; const char* nB = has_next ? (const char*)g.Bt + (size_t)nxt.pn * tstep + nxt.kofs : cB;
        for (int t = 0; t < nt; t += 2) {
            const bool last = (t == nt - 2);
            const char* a1 = cA + (size_t)(t + 1) * kstep;
            const char* a2 = last ? nA : cA + (size_t)(t + 2) * kstep; const char* b2 = last ? nB : cB + (size_t)(t + 2) * kstep;
            const char* a3 = a2 + kstep; const char* b3 = b2 + kstep;
            if (last && has_next) S.a_ready(nxt);
            PG8_LDB(B0, 0, 0); PG8_SCHED; PG8_LDA(At, 0, 0); PG8_STAGE(PG8_SA(1, 1), a1 + hstep, voffA);
            PG8_WAIT_L(8); PG8_BAR; PG8_WAIT_L(0); PG8_MMA(0, 0, At, B0); PG8_BAR; PG8_SCHED;
            PG8_LDB(B1, 0, 1); PG8_STAGE(PG8_SB(0, 0), b2, voffB);
            PG8_BAR; PG8_WAIT_L(0); PG8_MMA(0, 1, At, B1); PG8_BAR;
            PG8_LDA(At, 0, 1); PG8_STAGE(PG8_SA(0, 0), a2, voffA);
            PG8_BAR; PG8_WAIT_L(0); PG8_MMA(1, 0, At, B0); PG8_BAR; PG8_SCHED;
            PG8_STAGE(PG8_SB(0, 1), b2 + hstep, voffB);
            PG8_WAIT_V(6); PG8_BAR; PG8_MMA(1, 1, At, B1); PG8_BAR;
            PG8_LDB(B0, 1, 0); PG8_SCHED; PG8_LDA(At, 1, 0); PG8_STAGE(PG8_SA(0, 1), a2 + hstep, voffA);
            PG8_WAIT_L(8); PG8_BAR; PG8_WAIT_L(0); PG8_MMA(0, 0, At, B0); PG8_BAR; PG8_SCHED;
            PG8_LDB(B1, 1, 1); PG8_STAGE(PG8_SB(1, 0), b3, voffB);
            PG8_BAR; PG8_WAIT_L(0); PG8_MMA(0, 1, At, B1); PG8_BAR;
            PG8_LDA(At, 1, 1); PG8_STAGE(PG8_SA(1, 0), a3, voffA);
            PG8_BAR; PG8_WAIT_L(0); PG8_MMA(1, 0, At, B0); PG8_BAR; PG8_SCHED;
            PG8_STAGE(PG8_SB(1, 1), b3 + hstep, voffB);
            PG8_WAIT_V(6); PG8_BAR; PG8_MMA(1, 1, At, B1); PG8_BAR;
        }
        E(acc, cur, wr, wc, fr, fq);
        if (!has_next) break;
#pragma unroll
        for (int a = 0; a < 2; ++a)
#pragma unroll
            for (int b = 0; b < 2; ++b)
#pragma unroll
                for (int m = 0; m < 4; ++m)
#pragma unroll
                    for (int n = 0; n < 2; ++n) acc[a][b][m][n] = (f32x4){0.f, 0.f, 0.f, 0.f};
        cur = nxt; cA = nA; cB = nB; ++ui;
    }
    PG8_WAIT_V(0);
    if (wr == 0) PG8_BAR;
    PG8_BAR;
#undef PG8_SA
#undef PG8_SB
#undef PG8_STAGE
#undef PG8_LDA
#undef PG8_LDB
#undef PG8_MMA
#undef PG8_WAIT_V
#undef PG8_WAIT_L
#undef PG8_BAR
#undef PG8_SCHED
}
}

struct EpiP {
    static constexpr bool PERM = true;
    bf16_t* P;
    __device__ __forceinline__ void operator()(const f32x4 (&acc)[2][2][4][2], const pg8::Unit& u, int wr, int wc, int fr, int fq) const {
        const int row0 = u.pm * 256 + wr * 64 + fr, col0 = u.pn * 256 + wc * 32 + 8 * fq;
#pragma unroll
        for (int ai = 0; ai < 2; ++ai)
#pragma unroll
            for (int m = 0; m < 4; ++m) { bf16_t* rowp = P + (size_t)(row0 + ai * 128 + m * 16) * INW;
#pragma unroll
                for (int bj = 0; bj < 2; ++bj) { const int c = col0 + bj * 128; const f32x4 v0 = acc[ai][bj][m][0], v1 = acc[ai][bj][m][1];
                    if (c < INW) { u32x4 w4; w4.x = cvt_pk_bf16(v0[0], v0[1]); w4.y = cvt_pk_bf16(v0[2], v0[3]); w4.z = cvt_pk_bf16(v1[0], v1[1]); w4.w = cvt_pk_bf16(v1[2], v1[3]); *(u32x4*)(rowp + c) = w4; } } }
    }
};
struct EpiRelu2 {
    static constexpr bool PERM = true;
    bf16_t* O;
    __device__ __forceinline__ void operator()(const f32x4 (&acc)[2][2][4][2], const pg8::Unit& u, int wr, int wc, int fr, int fq) const {
        const int row0 = u.pm * 256 + wr * 64 + fr, col0 = u.pn * 256 + wc * 32 + 8 * fq;
#pragma unroll
        for (int ai = 0; ai < 2; ++ai)
#pragma unroll
            for (int m = 0; m < 4; ++m) { bf16_t* rowp = O + (size_t)(row0 + ai * 128 + m * 16) * DFF;
#pragma unroll
                for (int bj = 0; bj < 2; ++bj) { const int c = col0 + bj * 128; f32x4 v0 = acc[ai][bj][m][0], v1 = acc[ai][bj][m][1];
#pragma unroll
                    for (int j = 0; j < 4; ++j) { const float r0 = fmaxf(v0[j], 0.f), r1 = fmaxf(v1[j], 0.f); v0[j] = r0 * r0; v1[j] = r1 * r1; }
                    u32x4 w4; w4.x = cvt_pk_bf16(v0[0], v0[1]); w4.y = cvt_pk_bf16(v0[2], v0[3]); w4.z = cvt_pk_bf16(v1[0], v1[1]); w4.w = cvt_pk_bf16(v1[2], v1[3]); *(u32x4*)(rowp + c) = w4; } }
    }
};
struct EpiRes {
    static constexpr bool PERM = false;
    const float* xin_lat; const float* xin_ctx; float* xout_lat; float* xout_ctx; const float* gate;
    __device__ __forceinline__ void operator()(const f32x4 (&acc)[2][2][4][2], const pg8::Unit& u, int wr, int wc, int fr, int fq) const {
        const int row0 = u.pm * 256 + wr * 64 + fr, col0 = u.pn * 256 + wc * 32 + 4 * fq;
        const int rb = u.pm * 256;
        const bool isctx = rb >= NLAT;
        const int bidx = isctx ? 8 : (rb >> 12);
        const float* xi = isctx ? xin_ctx - (size_t)NLAT * DM : xin_lat;
        float* xo = isctx ? xout_ctx - (size_t)NLAT * DM : xout_lat;
        const float* gp = gate + (size_t)bidx * 6 * DM;
        f32x4 gv[2][2];
#pragma unroll
        for (int bj = 0; bj < 2; ++bj)
#pragma unroll
            for (int n = 0; n < 2; ++n) gv[bj][n] = *(const f32x4*)(gp + col0 + bj * 128 + n * 16);
#pragma unroll
        for (int ai = 0; ai < 2; ++ai) {
            f32x4 xv[4][2][2];
#pragma unroll
            for (int m = 0; m < 4; ++m) { const size_t ro = (size_t)(row0 + ai * 128 + m * 16) * DM;
#pragma unroll
                for (int bj = 0; bj < 2; ++bj)
#pragma unroll
                    for (int n = 0; n < 2; ++n) xv[m][bj][n] = *(const f32x4*)(xi + ro + col0 + bj * 128 + n * 16); }
#pragma unroll
            for (int m = 0; m < 4; ++m) { const size_t ro = (size_t)(row0 + ai * 128 + m * 16) * DM;
#pragma unroll
                for (int bj = 0; bj < 2; ++bj)
#pragma unroll
                    for (int n = 0; n < 2; ++n) *(f32x4*)(xo + ro + col0 + bj * 128 + n * 16) = xv[m][bj][n] + gv[bj][n] * acc[ai][bj][m][n]; }
        }
    }
};
struct EpiSlab {
    static constexpr bool PERM = false;
    float* slab; int rows;
    __device__ __forceinline__ void operator()(const f32x4 (&acc)[2][2][4][2], const pg8::Unit& u, int wr, int wc, int fr, int fq) const {
        const int row0 = u.pm * 256 + wr * 64 + fr, col0 = u.pn * 256 + wc * 32 + 4 * fq;
        float* base = slab + (size_t)u.ks * rows * DM;
#pragma unroll
        for (int ai = 0; ai < 2; ++ai)
#pragma unroll
            for (int m = 0; m < 4; ++m) { float* rowp = base + (size_t)(row0 + ai * 128 + m * 16) * DM + col0;
#pragma unroll
                for (int bj = 0; bj < 2; ++bj)
#pragma unroll
                    for (int n = 0; n < 2; ++n) *(f32x4*)(rowp + bj * 128 + n * 16) = acc[ai][bj][m][n]; }
    }
};

struct TileDesc { const float* src; bf16_t* dst; int K, N, k0, n0; };
__device__ __forceinline__ TileDesc tile_desc(const Params& p, int t) {
    constexpr int T_IN = 16 * 60, T_OUT = 16 * 16, T_1 = 16 * 64, T_2 = 64 * 16, T_L = T_IN + T_OUT + T_1 + T_2;
    const int l = t / T_L; int r = t % T_L; TileDesc d;
    if (r < T_IN) { d.src = p.w_in + (size_t)l * DM * INW; d.K = DM; d.N = INW; d.dst = (bf16_t*)(p.ws + WS_WIN) + (size_t)l * INWP * DM; d.k0 = (r / 60) * 64; d.n0 = (r % 60) * 64; }
    else if ((r -= T_IN) < T_OUT) { d.src = p.w_out + (size_t)l * DM * DM; d.K = DM; d.N = DM; d.dst = (bf16_t*)(p.ws + WS_WOUT) + (size_t)l * DM * DM; d.k0 = (r / 16) * 64; d.n0 = (r % 16) * 64; }
    else if ((r -= T_OUT) < T_1) { d.src = p.w_mlp1 + (size_t)l * DM * DFF; d.K = DM; d.N = DFF; d.dst = (bf16_t*)(p.ws + WS_W1) + (size_t)l * DFF * DM; d.k0 = (r / 64) * 64; d.n0 = (r % 64) * 64; }
    else { r -= T_1; d.src = p.w_mlp2 + (size_t)l * DFF * DM; d.K = DFF; d.N = DM; d.dst = (bf16_t*)(p.ws + WS_W2) + (size_t)l * DM * DFF; d.k0 = (r / 16) * 64; d.n0 = (r % 16) * 64; }
    return d;
}
__device__ __forceinline__ void tile_load(const TileDesc& d, int tid, f32x4 (&v)[2]) {
    const int r = tid >> 4, n = d.n0 + 4 * (tid & 15); const bool in = n < d.N; const int nc = in ? n : 0;
#pragma unroll
    for (int i = 0; i < 2; ++i) { const f32x4 t = *(const f32x4*)(d.src + (size_t)(d.k0 + r + 32 * i) * d.N + nc); v[i] = in ? t : (f32x4){0.f, 0.f, 0.f, 0.f}; }
}
__device__ __forceinline__ void tile_put(const f32x4 (&v)[2], int tid, float* tile) {
    const int r = tid >> 4, c = 4 * (tid & 15);
#pragma unroll
    for (int i = 0; i < 2; ++i)
#pragma unroll
        for (int j = 0; j < 4; ++j) tile[(r + 32 * i) * 65 + c + j] = v[i][j];
}
__device__ __forceinline__ void tile_store(const TileDesc& d, int tid, const float* tile) {
    const int n = tid >> 3, kg = tid & 7; float f[8];
#pragma unroll
    for (int j = 0; j < 8; ++j) f[j] = tile[(8 * kg + j) * 65 + n];
    u32x4 o; o.x = cvt_pk_bf16(f[0], f[1]); o.y = cvt_pk_bf16(f[2], f[3]); o.z = cvt_pk_bf16(f[4], f[5]); o.w = cvt_pk_bf16(f[6], f[7]);
    *(u32x4*)(d.dst + (size_t)(d.n0 + n) * d.K + d.k0 + 8 * kg) = o;
}
__device__ void phase_prep(const Params& p, unsigned char* lds) {
    float* tile = (float*)lds; float* tile2 = tile + 64 * 65 + 32;
    const int tid = otid();
    constexpr int NT_ALL = 2 * (16 * 60 + 16 * 16 + 16 * 64 + 64 * 16);
    for (int t = blockIdx.x; t < NT_ALL; t += 2 * gridDim.x) {
        const int t2 = t + gridDim.x; const bool has2 = t2 < NT_ALL;
        const TileDesc da = tile_desc(p, t), db = tile_desc(p, has2 ? t2 : t);
        f32x4 va[2], vb[2];
        tile_load(da, tid, va); tile_load(db, tid, vb);
        tile_put(va, tid, tile); tile_put(vb, tid, tile2);
        __syncthreads();
        tile_store(da, tid, tile); if (has2) tile_store(db, tid, tile2);
        __syncthreads();
    }
    float* red = (float*)lds;
    float* scv = red + 8 * 9 * 64;
    const int w = tid >> 6, lane = tid & 63;
    if (blockIdx.x < 2 * 96) {
        __syncthreads();
        for (int i = tid; i < 9 * DM; i += 512) { const float cv = (i < 8 * DM) ? p.c[i] : p.c_ctx[i - 8 * DM]; scv[i] = silu_f(cv); }
        __syncthreads();
    }
    for (int it = blockIdx.x; it < 2 * 96; it += gridDim.x) {
        const int l = it / 96, j0 = (it % 96) * 64;
        float a[9];
#pragma unroll
        for (int r = 0; r < 9; ++r) a[r] = 0.f;
        const float* wp = p.ada_w + (size_t)l * DM * 6 * DM + j0 + lane;
#pragma unroll 16
        for (int k = w * 128; k < w * 128 + 128; ++k) {
            const float wv = wp[(size_t)k * 6 * DM];
#pragma unroll
            for (int r = 0; r < 9; ++r) a[r] += scv[r * DM + k] * wv;
        }
        __syncthreads();
#pragma unroll
        for (int r = 0; r < 9; ++r) red[(w * 9 + r) * 64 + lane] = a[r];
        __syncthreads();
        for (int idx = tid; idx < 9 * 64; idx += 512) { const int r = idx >> 6, ln = idx & 63; float sacc = 0.f;
#pragma unroll
            for (int ww = 0; ww < 8; ++ww) sacc += red[(ww * 9 + r) * 64 + ln];
            ((float*)(p.ws + WS_MOD))[((size_t)l * 9 + r) * 6 * DM + j0 + ln] = sacc + p.ada_b[(size_t)l * 6 * DM + j0 + ln]; }
    }
    if (blockIdx.x == gridDim.x - 1) {
        float* tab = (float*)(p.ws + WS_TAB);
        for (int idx = tid; idx < 2048; idx += 512) { const int pos = idx >> 5, i = idx & 31; const float inv = powf(10000.0f, -(float)i / 32.0f); const float ang = (float)pos * inv;
            tab[idx] = cosf(ang); tab[2048 + idx] = sinf(ang); }
    }
    __syncthreads();
}

__device__ __forceinline__ const float* xrow(const float* lat, const float* ctx, int m) { return m < NLAT ? lat + (size_t)m * DM : ctx + (size_t)(m - NLAT) * DM; }
__device__ void phase_norm(const Params& p, const float* xl, const float* xc, const float* g, const float* mod_l, int sh_off, int nrows,
                           const float* slab, const float* slab_gate) {
    const int tid_ = otid(); const int lane = tid_ & 63, gw = blockIdx.x * 8 + (tid_ >> 6), nw = gridDim.x * 8;
    bf16_t* H = (bf16_t*)(p.ws + WS_H);
    f32x4 nv[4], gg4[4];
#pragma unroll
    for (int i = 0; i < 4; ++i) { nv[i] = (f32x4){0.f, 0.f, 0.f, 0.f}; gg4[i] = *(const f32x4*)(g + 4 * lane + 256 * i); }
    if (gw < nrows) { const float* xr = xrow(xl, xc, gw);
#pragma unroll
        for (int i = 0; i < 4; ++i) nv[i] = *(const f32x4*)(xr + 4 * lane + 256 * i); }
    for (int m = gw; m < nrows; m += nw) {
        const int b = m < NLAT ? (m >> 12) : 8;
        const float* sh = mod_l + (size_t)b * 6 * DM + sh_off; const float* sc = sh + DM;
        f32x4 v[4]; float ss = 0.f;
#pragma unroll
        for (int i = 0; i < 4; ++i) v[i] = nv[i];
        if (m + nw < nrows) { const float* xr = xrow(xl, xc, m + nw);
#pragma unroll
            for (int i = 0; i < 4; ++i) nv[i] = *(const f32x4*)(xr + 4 * lane + 256 * i); }
        f32x4 sc4[4], sh4[4];
#pragma unroll
        for (int i = 0; i < 4; ++i) { sc4[i] = *(const f32x4*)(sc + 4 * lane + 256 * i); sh4[i] = *(const f32x4*)(sh + 4 * lane + 256 * i); }
        asm volatile("" ::: "memory");
#pragma unroll
        for (int i = 0; i < 4; ++i) {
            if (slab != nullptr && m >= NLAT) {
                f32x4 sl[NSPLIT];
#pragma unroll
                for (int ks = 0; ks < NSPLIT; ++ks) sl[ks] = *(const f32x4*)(slab + ((size_t)ks * NCTX + (m - NLAT)) * DM + 4 * lane + 256 * i);
                const f32x4 acc4 = ((sl[0] + sl[1]) + (sl[2] + sl[3])) + ((sl[4] + sl[5]) + (sl[6] + sl[7]));
                v[i] += *(const f32x4*)(slab_gate + 4 * lane + 256 * i) * acc4;
            }
            ss += v[i][0] * v[i][0] + v[i][1] * v[i][1] + v[i][2] * v[i][2] + v[i][3] * v[i][3]; }
#pragma unroll
        for (int o = 32; o >= 1; o >>= 1) ss += __shfl_xor(ss, o);
        const float rinv = rsqrtf(ss * (1.0f / DM) + 1e-6f);
#pragma unroll
        for (int i = 0; i < 4; ++i) { const int c = 4 * lane + 256 * i; const f32x4 gg = gg4[i], s1 = sc4[i], s0 = sh4[i];
            f32x4 y;
#pragma unroll
            for (int j = 0; j < 4; ++j) y[j] = (v[i][j] * rinv * gg[j]) * (1.f + s1[j]) + s0[j];
            u32x2 w2; w2.x = cvt_pk_bf16(y[0], y[1]); w2.y = cvt_pk_bf16(y[2], y[3]); *(u32x2*)(H + (size_t)m * DM + c) = w2; }
    }
}
__device__ void phase_final(const Params& p) {
    const int tid_ = otid(); const int lane = tid_ & 63, gw = blockIdx.x * 8 + (tid_ >> 6), nw = gridDim.x * 8;
    f32x4 nv[4], gg4[4];
#pragma unroll
    for (int i = 0; i < 4; ++i) { nv[i] = (f32x4){0.f, 0.f, 0.f, 0.f}; gg4[i] = *(const f32x4*)(p.final_g + 4 * lane + 256 * i); }
    if (gw < NLAT) {
#pragma unroll
        for (int i = 0; i < 4; ++i) nv[i] = *(const f32x4*)(p.out + (size_t)gw * DM + 4 * lane + 256 * i); }
    for (int m = gw; m < NLAT; m += nw) {
        float* xr = p.out + (size_t)m * DM;
        f32x4 v[4]; float ss = 0.f;
#pragma unroll
        for (int i = 0; i < 4; ++i) v[i] = nv[i];
        if (m + nw < NLAT) {
#pragma unroll
            for (int i = 0; i < 4; ++i) nv[i] = *(const f32x4*)(p.out + (size_t)(m + nw) * DM + 4 * lane + 256 * i); }
        asm volatile("" ::: "memory");
#pragma unroll
        for (int i = 0; i < 4; ++i) ss += v[i][0] * v[i][0] + v[i][1] * v[i][1] + v[i][2] * v[i][2] + v[i][3] * v[i][3];
#pragma unroll
        for (int o = 32; o >= 1; o >>= 1) ss += __shfl_xor(ss, o);
        const float rinv = rsqrtf(ss * (1.0f / DM) + 1e-6f);
#pragma unroll
        for (int i = 0; i < 4; ++i) { const int c = 4 * lane + 256 * i;
            f32x4 y;
#pragma unroll
            for (int j = 0; j < 4; ++j) y[j] = v[i][j] * rinv * gg4[i][j];
            *(f32x4*)(xr + c) = y; }
    }
}

__device__ void phase_merge(const Params& p, int l, int nrows) {
    const int tid_ = otid(); const int lane = tid_ & 63, gw = blockIdx.x * 8 + (tid_ >> 6), nw = gridDim.x * 8;
    bf16_t* H = (bf16_t*)(p.ws + WS_H); const bf16_t* OB = (const bf16_t*)(p.ws + WS_OB); const bf16_t* P = (const bf16_t*)(p.ws + WS_P);
    const bool isgla = lane >= 32;
    const int gcol = isgla ? (2560 + 16 * lane) : (1536 + 16 * lane);
    const float* gnp = p.gla_norm_g + l * 128 + ((16 * lane) & 127);
    float gn[16];
#pragma unroll
    for (int j = 0; j < 16; ++j) gn[j] = gnp[j];
    bf16x8 nf0, nf1, nb0, nb1, ng0, ng1;
    nf0 = nf1 = nb0 = nb1 = ng0 = ng1 = (bf16x8){0, 0, 0, 0, 0, 0, 0, 0};
#define MERGE_LOAD(mm) do { nf0 = *(const bf16x8*)(H + (size_t)(mm) * DM + 16 * lane); nf1 = *(const bf16x8*)(H + (size_t)(mm) * DM + 16 * lane + 8); \
        nb0 = *(const bf16x8*)(OB + (size_t)(mm) * DM + 16 * lane); nb1 = *(const bf16x8*)(OB + (size_t)(mm) * DM + 16 * lane + 8); \
        ng0 = *(const bf16x8*)(P + (size_t)(mm) * INW + gcol); ng1 = *(const bf16x8*)(P + (size_t)(mm) * INW + gcol + 8); } while (0)
    if (gw < nrows) MERGE_LOAD(gw);
    for (int m = gw; m < nrows; m += nw) {
        const bf16x8 f0 = nf0, f1 = nf1, b0 = nb0, b1 = nb1, g0 = ng0, g1 = ng1;
        if (m + nw < nrows) MERGE_LOAD(m + nw);
        asm volatile("" ::: "memory");
        float r[16]; float s1 = 0.f, s2 = 0.f;
#pragma unroll
        for (int j = 0; j < 8; ++j) { r[j] = bf2f(f0[j]) + bf2f(b0[j]); r[8 + j] = bf2f(f1[j]) + bf2f(b1[j]); }
#ifdef SANITIZE
#pragma unroll
        for (int j = 0; j < 16; ++j) { if (!(fabsf(r[j]) < 1e30f)) r[j] = 0.f; }
#endif
#ifdef SKIP_GLA
        if (isgla) {
#pragma unroll
            for (int j = 0; j < 16; ++j) r[j] = 0.f; }
#endif
#ifdef SKIP_RET
        if (!isgla) {
#pragma unroll
            for (int j = 0; j < 16; ++j) r[j] = 0.f; }
#endif
#pragma unroll
        for (int j = 0; j < 16; ++j) { s1 += r[j]; s2 += r[j] * r[j]; }
#pragma unroll
        for (int o = 1; o <= 4; o <<= 1) { s1 += __shfl_xor(s1, o); s2 += __shfl_xor(s2, o); }
        float y[16];
        if (!isgla) {
            const float mu = s1 * (1.f / 128.f); float sv = 0.f;
#pragma unroll
            for (int j = 0; j < 16; ++j) { const float d = r[j] - mu; sv += d * d; }
#pragma unroll
            for (int o = 1; o <= 4; o <<= 1) sv += __shfl_xor(sv, o);
            const float rs = rsqrtf(sv * (1.f / 128.f) + 1e-6f);
#pragma unroll
            for (int j = 0; j < 16; ++j) y[j] = (r[j] - mu) * rs;
        } else {
            float sv = 0.f;
#pragma unroll
            for (int o = 1; o <= 4; o <<= 1) sv += __shfl_xor(sv, o);
            const float rs = rsqrtf(s2 * (1.f / 128.f) + 1e-6f);
#pragma unroll
            for (int j = 0; j < 16; ++j) y[j] = r[j] * rs * gn[j] + 0.f * sv;
        }
        u32x4 o0, o1;
#pragma unroll
        for (int j = 0; j < 8; ++j) { y[j] *= silu_f(bf2f(g0[j])); y[8 + j] *= silu_f(bf2f(g1[j])); }
        o0.x = cvt_pk_bf16(y[0], y[1]); o0.y = cvt_pk_bf16(y[2], y[3]); o0.z = cvt_pk_bf16(y[4], y[5]); o0.w = cvt_pk_bf16(y[6], y[7]);
        o1.x = cvt_pk_bf16(y[8], y[9]); o1.y = cvt_pk_bf16(y[10], y[11]); o1.z = cvt_pk_bf16(y[12], y[13]); o1.w = cvt_pk_bf16(y[14], y[15]);
        *(u32x4*)(H + (size_t)m * DM + 16 * lane) = o0; *(u32x4*)(H + (size_t)m * DM + 16 * lane + 8) = o1;
    }
}

#undef MERGE_LOAD
template <int DK, bool GLA>
__device__ __forceinline__ void scan_item(const Params& p, int l, unsigned char* lds, LAS unsigned char* lds3, int b, int h, int dir, int dvs) {
    constexpr int QS = DK + 8, TS = 72, NT = DK / 32, NKS = DK / 32;
    bf16_t* QD = (bf16_t*)lds;
    bf16_t* KI = QD + 64 * QS;
    bf16_t* ST = KI + 64 * QS;
    bf16_t* VR = ST + 64 * QS;
    bf16_t* SC = VR + 64 * TS;
    constexpr int KI_B = 64 * QS * 2, VR_B = 3 * 64 * QS * 2;
    float* DVEC = (float*)(SC + 64 * TS);
    float* CL = DVEC + DK;
    float* CUM = CL + DK;
    float* UP = CUM + 2 * 64 * 68;
    const int tid = otid(), lane = tid & 63, w = __builtin_amdgcn_readfirstlane(tid >> 6), fr = lane & 15, fq = lane >> 4;
    const bf16_t* P = (const bf16_t*)(p.ws + WS_P);
    bf16_t* O = (bf16_t*)(p.ws + (dir ? WS_OB : WS_H));
    const float* TABC = (const float*)(p.ws + WS_TAB); const float* TABS = TABC + 2048;
    const int ocol = (GLA ? 512 : 0) + 128 * h + 64 * dvs;
    const int qcol = GLA ? 2048 + 64 * h : 128 * h, kcol = GLA ? 2304 + 64 * h : 512 + 128 * h, vcol = (GLA ? 2560 : 1024) + 128 * h + 64 * dvs;
    float g = 0.f;
    if (!GLA) g = log1pf(-__expf(p.ret_decay[l * 8 + dir * 4 + h]));
    constexpr int NDK = DK / 64;
    const int dkt0 = NDK * (w >> 1), dvt0 = 2 * (w & 1);
    f32x4 S[NT];
#pragma unroll
    for (int i = 0; i < NT; ++i) S[i] = (f32x4){0.f, 0.f, 0.f, 0.f};
    __syncthreads();
    for (int i = tid; i < 64 * QS / 2; i += 512) ((unsigned*)ST)[i] = 0u;
    bf16x8 uph[2], upl[2]; float ubv[2];
    uph[0] = uph[1] = upl[0] = upl[1] = (bf16x8){0, 0, 0, 0, 0, 0, 0, 0}; ubv[0] = ubv[1] = 0.f;
    float* TT = UP;
    if (GLA) {
#pragma unroll
        for (int ci = 0; ci < 2; ++ci) {
            const int ch = 16 * (2 * (w & 1) + ci) + fr;
#pragma unroll
            for (int j = 0; j < 8; ++j) {
                const float val = (fq < 2) ? p.gate_up[((size_t)(l * 2 + dir) * 16 + 8 * fq + j) * 256 + 64 * h + ch] : 0.f;
                const bf16_t hi = f2bf(val); const float rem = val - bf2f((short)hi);
                uph[ci][j] = (short)hi; upl[ci][j] = (short)f2bf(rem);
            }
            ubv[ci] = p.gate_b[(l * 2 + dir) * 256 + 64 * h + ch];
        }
    } else {
        if (tid < DK) DVEC[tid] = __expf(64.f * g);
    }
    __syncthreads();
    const int s_a = tid >> 3, pr = tid & 7, c8a = (pr & 3) + 8 * (pr >> 2), c8g = tid & 7;
    bf16x8 nq1, nq2, nk1, nk2, nv1, nd0, nd1; f32x4 nc0, nc1, ns0, ns1;
    nq2 = nq1 = nk1 = nk2 = nv1 = nd0 = nd1 = (bf16x8){0, 0, 0, 0, 0, 0, 0, 0}; nc0 = nc1 = ns0 = ns1 = (f32x4){0.f, 0.f, 0.f, 0.f};
#define SCAN_STEP_GEOM(stp, isctx_, chunk_, m0_) \
    const bool isctx_ = (stp) < 4; \
    const int chunk_ = dir == 0 ? (isctx_ ? (stp) : (stp) - 4) : (isctx_ ? 3 - (stp) : 67 - (stp)); \
    const int m0_ = isctx_ ? (NLAT + b * CTXL + chunk_ * 64) : (b * SEQ + chunk_ * 64);
#define SCAN_ISSUE(stp) do { SCAN_STEP_GEOM(stp, ic_, ch_, mm_) \
        const bf16_t* rp_ = P + (size_t)(mm_ + s_a) * INW; \
        if (GLA) { \
            nq1 = *(const bf16x8*)(rp_ + qcol + 8 * c8g); nk1 = *(const bf16x8*)(rp_ + kcol + 8 * c8g); } \
        else { nq1 = *(const bf16x8*)(rp_ + qcol + 8 * c8a); nq2 = *(const bf16x8*)(rp_ + qcol + 8 * (c8a + 4)); \
            nk1 = *(const bf16x8*)(rp_ + kcol + 8 * c8a); nk2 = *(const bf16x8*)(rp_ + kcol + 8 * (c8a + 4)); \
            const int pos_ = ic_ ? 0 : ((pr >> 2) ? s_a : ch_); \
            nc0 = *(const f32x4*)(TABC + pos_ * 32 + 8 * (pr & 3)); nc1 = *(const f32x4*)(TABC + pos_ * 32 + 8 * (pr & 3) + 4); \
            ns0 = *(const f32x4*)(TABS + pos_ * 32 + 8 * (pr & 3)); ns1 = *(const f32x4*)(TABS + pos_ * 32 + 8 * (pr & 3) + 4); } \
        nv1 = *(const bf16x8*)(rp_ + vcol + 8 * c8g); } while (0)
#define SCAN_ISSUE_D(stp) do { SCAN_STEP_GEOM(stp, icd_, chd_, mmd_) (void)chd_; \
        if (GLA && fq < 2) { const bf16_t* dp_ = P + (size_t)(mmd_ + 16 * (w >> 1) + fr) * INW + 3584 + 16 * dir + 8 * fq; nd0 = *(const bf16x8*)dp_; } } while (0)
    auto gate_stage = [&](const bf16x8 dfrag, float* CUMb, float* TTb) {
        const int st = w >> 1;
#pragma unroll
        for (int ci = 0; ci < 2; ++ci) {
            const int ch = 16 * (2 * (w & 1) + ci) + fr;
            f32x4 z = __builtin_amdgcn_mfma_f32_16x16x32_bf16(dfrag, uph[ci], (f32x4){0.f, 0.f, 0.f, 0.f}, 0, 0, 0);
            z = __builtin_amdgcn_mfma_f32_16x16x32_bf16(dfrag, upl[ci], z, 0, 0, 0);
            float la[4], pz[4];
#pragma unroll
            for (int r = 0; r < 4; ++r) { const float zz = z[r] + ubv[ci]; la[r] = (fminf(zz, 0.f) - __logf(1.f + __expf(-fabsf(zz)))) * (1.0f / 16.0f); }
            float T, ex = 0.f;
            if (dir == 0) {
                pz[0] = la[0]; pz[1] = pz[0] + la[1]; pz[2] = pz[1] + la[2]; pz[3] = pz[2] + la[3]; T = pz[3];
                const float t1 = __shfl_up(T, 16), t2 = __shfl_up(T, 32), t3 = __shfl_up(T, 48);
                if (fq >= 1) ex += t1; if (fq >= 2) ex += t2; if (fq >= 3) ex += t3;
            } else {
                pz[3] = la[3]; pz[2] = pz[3] + la[2]; pz[1] = pz[2] + la[1]; pz[0] = pz[1] + la[0]; T = pz[0];
                const float t1 = __shfl_down(T, 16), t2 = __shfl_down(T, 32), t3 = __shfl_down(T, 48);
                if (fq <= 2) ex += t1; if (fq <= 1) ex += t2; if (fq == 0) ex += t3;
            }
            const float ttot = __shfl(T + ex, dir == 0 ? 48 + fr : fr);
#pragma unroll
            for (int r = 0; r < 4; ++r) CUMb[(16 * st + 4 * fq + r) * 68 + ch] = pz[r] + ex;
            if (fq == 0) TTb[st * 64 + ch] = ttot;
        }
    };
    SCAN_ISSUE(0);
    if (GLA) {
        SCAN_ISSUE_D(0);
        const bf16x8 dfirst = nd0;
        SCAN_ISSUE_D(1);
        gate_stage(dfirst, CUM, TT);
        __syncthreads();
    }
    for (int step = 0; step < 68; ++step) {
        SCAN_STEP_GEOM(step, isctx, chunk, m0)
        const bf16x8 q1 = nq1, q2 = nq2, k1 = nk1, k2 = nk2, v1 = nv1, d0 = nd0, d1 = nd1; const f32x4 tc0 = nc0, tc1 = nc1, ts0 = ns0, ts1 = ns1;
        { const int nstep = step + 1 < 68 ? step + 1 : 67; SCAN_ISSUE(nstep); }
        if (GLA) { const int dstep = step + 2 < 68 ? step + 2 : 67; SCAN_ISSUE_D(dstep); }
        (void)chunk; (void)d1;
        float* CUMc = CUM + (step & 1) * 64 * 68; float* TTc = TT + (step & 1) * 256;
        {
            const int s = s_a;
            if (!GLA) {
                const float cum = dir == 0 ? g * (float)(s + 1) : g * (float)(64 - s), cl = 64.f * g;
                const float eq = __expf(cum) * 0.08838834764831845f, eki = __expf(-cum); (void)cl;
                float cs[8], sn[8];
#pragma unroll
                for (int j = 0; j < 4; ++j) { cs[j] = isctx ? 1.f : tc0[j]; cs[4 + j] = isctx ? 1.f : tc1[j]; sn[j] = isctx ? 0.f : ts0[j]; sn[4 + j] = isctx ? 0.f : ts1[j]; }
                float qa[8], qb[8], ka[8], kb[8];
#pragma unroll
                for (int j = 0; j < 8; ++j) {
                    const float a1 = bf2f(q1[j]), a2 = bf2f(q2[j]), b1 = bf2f(k1[j]), b2 = bf2f(k2[j]);
                    qa[j] = a1 * cs[j] - a2 * sn[j]; qb[j] = a1 * sn[j] + a2 * cs[j];
                    ka[j] = b1 * cs[j] - b2 * sn[j]; kb[j] = b1 * sn[j] + b2 * cs[j];
                }
                u32x4 o;
                o.x = cvt_pk_bf16(qa[0] * eq, qa[1] * eq); o.y = cvt_pk_bf16(qa[2] * eq, qa[3] * eq); o.z = cvt_pk_bf16(qa[4] * eq, qa[5] * eq); o.w = cvt_pk_bf16(qa[6] * eq, qa[7] * eq);
                *(u32x4*)(QD + s * QS + 8 * c8a) = o;
                o.x = cvt_pk_bf16(qb[0] * eq, qb[1] * eq); o.y = cvt_pk_bf16(qb[2] * eq, qb[3] * eq); o.z = cvt_pk_bf16(qb[4] * eq, qb[5] * eq); o.w = cvt_pk_bf16(qb[6] * eq, qb[7] * eq);
                *(u32x4*)(QD + s * QS + 8 * (c8a + 4)) = o;
                o.x = cvt_pk_bf16(ka[0] * eki, ka[1] * eki); o.y = cvt_pk_bf16(ka[2] * eki, ka[3] * eki); o.z = cvt_pk_bf16(ka[4] * eki, ka[5] * eki); o.w = cvt_pk_bf16(ka[6] * eki, ka[7] * eki);
                *(u32x4*)(KI + s * QS + 8 * c8a) = o;
                o.x = cvt_pk_bf16(kb[0] * eki, kb[1] * eki); o.y = cvt_pk_bf16(kb[2] * eki, kb[3] * eki); o.z = cvt_pk_bf16(kb[4] * eki, kb[5] * eki); o.w = cvt_pk_bf16(kb[6] * eki, kb[7] * eki);
                *(u32x4*)(KI + s * QS + 8 * (c8a + 4)) = o;
            } else {
                const int c8 = c8g;
                f32x4 cu0 = *(const f32x4*)(CUMc + s * 68 + 8 * c8), cu1 = *(const f32x4*)(CUMc + s * 68 + 8 * c8 + 4);
                {
                    const int stile = w >> 1;
#pragma unroll
                    for (int t4 = 0; t4 < 4; ++t4) {
                        const bool inc = dir == 0 ? (t4 < stile) : (t4 > stile);
                        if (inc) { cu0 += *(const f32x4*)(TTc + t4 * 64 + 8 * c8); cu1 += *(const f32x4*)(TTc + t4 * 64 + 8 * c8 + 4); }
                    }
                }
                if (s == 0) {
                    f32x4 cl0 = (f32x4){0.f, 0.f, 0.f, 0.f}, cl1 = cl0;
#pragma unroll
                    for (int t4 = 0; t4 < 4; ++t4) { cl0 += *(const f32x4*)(TTc + t4 * 64 + 8 * c8); cl1 += *(const f32x4*)(TTc + t4 * 64 + 8 * c8 + 4); }
#pragma unroll
                    for (int j = 0; j < 4; ++j) { DVEC[8 * c8 + j] = __expf(cl0[j]); DVEC[8 * c8 + 4 + j] = __expf(cl1[j]); }
                }
                float qd[8], ki[8];
#pragma unroll
                for (int j = 0; j < 8; ++j) {
                    const float cu = j < 4 ? cu0[j & 3] : cu1[j & 3];
                    const float e = __expf(cu);
                    qd[j] = bf2f(q1[j]) * (0.125f * e); ki[j] = bf2f(k1[j]) * __builtin_amdgcn_rcpf(e);
                }
                u32x4 o;
                o.x = cvt_pk_bf16(qd[0], qd[1]); o.y = cvt_pk_bf16(qd[2], qd[3]); o.z = cvt_pk_bf16(qd[4], qd[5]); o.w = cvt_pk_bf16(qd[6], qd[7]);
                *(u32x4*)(QD + s * QS + 8 * c8) = o;
                o.x = cvt_pk_bf16(ki[0], ki[1]); o.y = cvt_pk_bf16(ki[2], ki[3]); o.z = cvt_pk_bf16(ki[4], ki[5]); o.w = cvt_pk_bf16(ki[6], ki[7]);
                *(u32x4*)(KI + s * QS + 8 * c8) = o;
            }
            *(bf16x8*)(VR + s * TS + 8 * c8g) = v1;
        }
        __syncthreads();
        bf16x8 qf[NKS];
        {
            const int tt = w >> 1;
#pragma unroll
            for (int ks = 0; ks < NKS; ++ks) qf[ks] = *(const bf16x8*)(QD + (16 * tt + fr) * QS + 32 * ks + 8 * fq);
#pragma unroll
            for (int si = 0; si < 2; ++si) {
                const int st = 2 * (w & 1) + si;
                f32x4 acc = (f32x4){0.f, 0.f, 0.f, 0.f};
#pragma unroll
                for (int ks = 0; ks < NKS; ++ks) {
                    const bf16x8 a = *(const bf16x8*)(KI + (16 * st + fr) * QS + 32 * ks + 8 * fq);
                    acc = __builtin_amdgcn_mfma_f32_16x16x32_bf16(a, qf[ks], acc, 0, 0, 0);
                }
                const int t = 16 * tt + fr, s0 = 16 * st + 4 * fq;
                float v[4];
#pragma unroll
                for (int r = 0; r < 4; ++r) { const int s = s0 + r; const bool keep = dir == 0 ? (s <= t) : (s > t); v[r] = keep ? acc[r] : 0.f; }
                u32x2 w2; w2.x = cvt_pk_bf16(v[0], v[1]); w2.y = cvt_pk_bf16(v[2], v[3]);
                *(u32x2*)(SC + t * TS + s0) = w2;
            }
        }
        __syncthreads();
        if (GLA && step + 1 < 68) gate_stage(d0, CUM + ((step + 1) & 1) * 64 * 68, TT + ((step + 1) & 1) * 256);
        {
            const int tt = w >> 1;
            bf16x8 scf[2], kitf[NDK][2], vtf[2][2];
            const int trow = 8 * fq + (fr >> 2), tcol = 4 * (fr & 3);
#pragma unroll
            for (int ks = 0; ks < 2; ++ks) {
                scf[ks] = *(const bf16x8*)(SC + (16 * tt + fr) * TS + 32 * ks + 8 * fq);
#pragma unroll
                for (int a = 0; a < NDK; ++a) {
                    const s16x4 lo = __builtin_amdgcn_ds_read_tr16_b64_v4i16((LAS s16x4*)(lds3 + KI_B + ((32 * ks + trow) * QS + 16 * (dkt0 + a) + tcol) * 2));
                    const s16x4 hi = __builtin_amdgcn_ds_read_tr16_b64_v4i16((LAS s16x4*)(lds3 + KI_B + ((32 * ks + 4 + trow) * QS + 16 * (dkt0 + a) + tcol) * 2));
                    kitf[a][ks] = __builtin_shufflevector(lo, hi, 0, 1, 2, 3, 4, 5, 6, 7);
                }
#pragma unroll
                for (int c = 0; c < 2; ++c) {
                    const s16x4 lo = __builtin_amdgcn_ds_read_tr16_b64_v4i16((LAS s16x4*)(lds3 + VR_B + ((32 * ks + trow) * TS + 16 * (dvt0 + c) + tcol) * 2));
                    const s16x4 hi = __builtin_amdgcn_ds_read_tr16_b64_v4i16((LAS s16x4*)(lds3 + VR_B + ((32 * ks + 4 + trow) * TS + 16 * (dvt0 + c) + tcol) * 2));
                    vtf[c][ks] = __builtin_shufflevector(lo, hi, 0, 1, 2, 3, 4, 5, 6, 7);
                }
            }
#pragma unroll
            for (int di = 0; di < 2; ++di) {
                const int dvt = dvt0 + di;
                f32x4 acc = (f32x4){0.f, 0.f, 0.f, 0.f};
#pragma unroll
                for (int ks = 0; ks < 2; ++ks) acc = __builtin_amdgcn_mfma_f32_16x16x32_bf16(vtf[di][ks], scf[ks], acc, 0, 0, 0);
#pragma unroll
                for (int ks = 0; ks < NKS; ++ks) {
                    const bf16x8 a = *(const bf16x8*)(ST + (16 * dvt + fr) * QS + 32 * ks + 8 * fq);
                    acc = __builtin_amdgcn_mfma_f32_16x16x32_bf16(a, qf[ks], acc, 0, 0, 0);
                }
                u32x2 w2; w2.x = cvt_pk_bf16(acc[0], acc[1]); w2.y = cvt_pk_bf16(acc[2], acc[3]);
                *(u32x2*)(O + (size_t)(m0 + 16 * tt + fr) * DM + ocol + 16 * dvt + 4 * fq) = w2;
            }
#pragma unroll
            for (int a = 0; a < NDK; ++a) {
                const f32x4 dv4 = *(const f32x4*)(DVEC + 16 * (dkt0 + a) + 4 * fq);
#pragma unroll
                for (int c = 0; c < 2; ++c) {
#pragma unroll
                    for (int ks = 0; ks < 2; ++ks) S[a * 2 + c] = __builtin_amdgcn_mfma_f32_16x16x32_bf16(kitf[a][ks], vtf[c][ks], S[a * 2 + c], 0, 0, 0);
                    S[a * 2 + c] = S[a * 2 + c] * dv4;
                }
            }
        }
        __syncthreads();
#pragma unroll
        for (int a = 0; a < NDK; ++a)
#pragma unroll
            for (int c = 0; c < 2; ++c) {
                u32x2 w2; w2.x = cvt_pk_bf16(S[a * 2 + c][0], S[a * 2 + c][1]); w2.y = cvt_pk_bf16(S[a * 2 + c][2], S[a * 2 + c][3]);
                *(u32x2*)(ST + (16 * (dvt0 + c) + fr) * QS + 16 * (dkt0 + a) + 4 * fq) = w2;
            }
    }
    __syncthreads();
#undef SCAN_STEP_GEOM
#undef SCAN_ISSUE
#undef SCAN_ISSUE_D
}
__device__ void phase_scan(const Params& p, int l, unsigned char* lds) {
    for (int it = blockIdx.x; it < 256; it += gridDim.x) {
        const int isgla = it & 1, r = it >> 1;
        const int dvs = r & 1, dir = (r >> 1) & 1, h = (r >> 2) & 3, b = r >> 4;
#ifdef SKIP_GLA
        if (isgla) continue;
#endif
#ifdef SKIP_RET
        if (!isgla) continue;
#endif
        if (isgla) scan_item<64, true>(p, l, lds, (LAS unsigned char*)lds, b, h, dir, dvs);
        else scan_item<128, false>(p, l, lds, (LAS unsigned char*)lds, b, h, dir, dvs);
    }
}

#define XB_TMO      128
#define XB_XCNT(j)  (256  + 64 * (j))
#define XB_XSUB(j)  (1280 + 64 * (j))
#define XB_XGEN(j)  (2304 + 64 * (j))
#define XB_TOP      3328
#define XB_TOPGEN   3392
#define XCD_BAR_WORDS 3456
#define XB_SPIN_CAP (1u << 20)
__device__ __forceinline__ unsigned xb_ld(unsigned* p)              { return __hip_atomic_load(p, __ATOMIC_RELAXED, __HIP_MEMORY_SCOPE_AGENT); }
__device__ __forceinline__ unsigned xb_add(unsigned* p, unsigned v) { return __hip_atomic_fetch_add(p, v, __ATOMIC_RELAXED, __HIP_MEMORY_SCOPE_AGENT); }
__device__ __forceinline__ unsigned xb_xcc_id() { return (unsigned)__builtin_amdgcn_s_getreg((3 << 11) | 20) & 0xFu; }
#define XB_SPIN(cond, bar) do { unsigned _sp = 0; while (cond) { __builtin_amdgcn_s_sleep(1); \
    if ((++_sp & 255u) == 0u) { if (xb_ld(&(bar)[XB_TMO])) break; if (_sp > XB_SPIN_CAP) { atomicAdd(&(bar)[XB_TMO], 1u); break; } } } } while (0)
struct XcdBarrier { unsigned* bar; unsigned x; volatile LAS unsigned* st; };
__device__ __forceinline__ XcdBarrier xcd_barrier_post(unsigned* bar, volatile LAS unsigned* st) {
    XcdBarrier b; b.bar = bar; b.x = xb_xcc_id(); b.st = st;
    if (threadIdx.x == 0) (void)xb_add(&bar[XB_XCNT(b.x)], 1u);
    return b;
}
__device__ __forceinline__ void xcd_barrier_complete(unsigned* bar, unsigned x, unsigned& nloc, unsigned& nx) {
    const unsigned G = gridDim.x * gridDim.y * gridDim.z;
    unsigned sum, cnt, mine, sp = 0u;
    for (;;) {
        sum = 0u; cnt = 0u; mine = 0u;
#pragma unroll
        for (unsigned j = 0; j < 16; ++j) { const unsigned c = xb_ld(&bar[XB_XCNT(j)]); sum += c; cnt += (c > 0u) ? 1u : 0u; mine = (j == x) ? c : mine; }
        if (sum == G) break;
        __builtin_amdgcn_s_sleep(1);
        if ((++sp & 255u) == 0u) { if (xb_ld(&bar[XB_TMO])) break; if (sp > XB_SPIN_CAP) { atomicAdd(&bar[XB_TMO], 1u); break; } }
    }
    nloc = mine > 0u ? mine : 1u; nx = cnt > 0u ? cnt : 1u;
}
__device__ __forceinline__ void xcd_barrier(const XcdBarrier& b) {
    asm volatile("s_waitcnt vmcnt(0)" ::: "memory");
    __syncthreads();
    if (threadIdx.x == 0) {
        unsigned* bar = b.bar;
        __builtin_amdgcn_s_waitcnt(0);
        unsigned nloc = b.st[0], nx = b.st[1];
        if (nloc == 0u) { xcd_barrier_complete(bar, b.x, nloc, nx); b.st[0] = nloc; b.st[1] = nx; }
        const unsigned old = xb_add(&bar[XB_XSUB(b.x)], 1u);
        const unsigned gen = old / nloc;
        if (old + 1u == (gen + 1u) * nloc) {
            __builtin_amdgcn_fence(__ATOMIC_RELEASE, "agent");
            asm volatile("s_waitcnt vmcnt(0)" ::: "memory");
            const unsigned og = xb_add(&bar[XB_TOP], 1u);
            const unsigned tg = og / nx;
            if (og + 1u == (tg + 1u) * nx) xb_add(&bar[XB_TOPGEN], 1u);
            else XB_SPIN(xb_ld(&bar[XB_TOPGEN]) == tg, bar);
            __builtin_amdgcn_fence(__ATOMIC_ACQUIRE, "agent");
            xb_add(&bar[XB_XGEN(b.x)], 1u);
            asm volatile("s_waitcnt vmcnt(0)" ::: "memory");
        } else {
            XB_SPIN(xb_ld(&bar[XB_XGEN(b.x)]) == gen, bar);
            __builtin_amdgcn_fence(__ATOMIC_ACQUIRE, "agent");
            asm volatile("s_waitcnt vmcnt(0)" ::: "memory");
        }
    }
    __syncthreads();
}

__global__ void __launch_bounds__(512, 2) fwd_megakernel(Params p) {
    extern __shared__ __attribute__((aligned(16))) unsigned char shm[];
    cg::grid_group grid = cg::this_grid();
    const float* MOD = (const float*)(p.ws + WS_MOD);
    volatile LAS unsigned* xst = (volatile LAS unsigned*)((LAS unsigned char*)shm + 131072);
    if (threadIdx.x == 0) { xst[0] = 0u; xst[1] = 0u; xst[2] = 0u; xst[3] = 0u; }
    __syncthreads();
    const XcdBarrier xbar = xcd_barrier_post((unsigned*)(p.ws + WS_BAR), xst);
    for (int ph = p.ph_lo; ph < p.ph_hi; ++ph) {
        if (ph == 0) phase_prep(p, shm);
        else if (ph == NPHASE - 1) phase_final(p);
        else {
            const int l = (ph - 1) >> 3, sub = (ph - 1) & 7;
            const float* mod_l = MOD + (size_t)l * 9 * 6 * DM;
            const float* xin_lat = l == 0 ? p.x : p.out; const float* xin_ctx = l == 0 ? p.ctx : (const float*)(p.ws + WS_XCTX);
            float* xo_lat = p.out; float* xo_ctx = (float*)(p.ws + WS_XCTX);
            const int mrows = l == 0 ? MTOT : NLAT;
            bf16_t* H = (bf16_t*)(p.ws + WS_H); bf16_t* Pm = (bf16_t*)(p.ws + WS_P);
            pg8::StaticOrder S;
            if (sub == 0) phase_norm(p, xin_lat, xin_ctx, p.norm1_g + l * DM, mod_l, 0, MTOT, l == 1 ? (const float*)(p.ws + WS_SLAB) : nullptr, MOD + 8 * 6 * DM + 5 * DM);
#ifndef NO_G1
            else if (sub == 1) { pg8::Gemm g{H, (const bf16_t*)(p.ws + WS_WIN) + (size_t)l * INWP * DM, MTOT, INWP, DM, DM}; S.init(g.M, g.N, gridDim.x, blockIdx.x);
                EpiP E{Pm}; pg8::gemm_phase(( LAS unsigned char*)shm, g, S, E); }
#endif
#ifndef NO_SCAN
            else if (sub == 2) phase_scan(p, l, shm);
#endif
            else if (sub == 3) phase_merge(p, l, mrows);
#ifndef NO_G2
            else if (sub == 4) { pg8::Gemm g{H, (const bf16_t*)(p.ws + WS_WOUT) + (size_t)l * DM * DM, mrows, DM, DM, DM}; S.init(g.M, g.N, gridDim.x, blockIdx.x);
                EpiRes E{xin_lat, xin_ctx, xo_lat, xo_ctx, mod_l + 2 * DM}; pg8::gemm_phase((LAS unsigned char*)shm, g, S, E); }
#endif
            else if (sub == 5) phase_norm(p, xo_lat, xo_ctx, p.norm2_g + l * DM, mod_l, 3 * DM, mrows, nullptr, nullptr);
#ifndef NO_G3
            else if (sub == 6) { pg8::Gemm g{H, (const bf16_t*)(p.ws + WS_W1) + (size_t)l * DFF * DM, mrows, DFF, DM, DM}; S.init(g.M, g.N, gridDim.x, blockIdx.x);
                EpiRelu2 E{Pm}; pg8::gemm_phase((LAS unsigned char*)shm, g, S, E); }
#endif
#ifndef NO_G4
            else if (sub == 7) { pg8::Gemm g{Pm, (const bf16_t*)(p.ws + WS_W2) + (size_t)l * DM * DFF, NLAT, DM, DFF, DFF}; S.init(g.M, g.N, gridDim.x, blockIdx.x);
                EpiRes E{xo_lat, xo_ctx, xo_lat, xo_ctx, mod_l + 5 * DM}; pg8::gemm_phase((LAS unsigned char*)shm, g, S, E);
                if (l == 0) {
                    pg8::Gemm g2{Pm + (size_t)NLAT * DFF, g.Bt, NCTX, DM, DFF / NSPLIT, DFF};
                    pg8::SplitOrder<NSPLIT, DFF / NSPLIT> S2; S2.G = gridDim.x; S2.c = blockIdx.x;
                    EpiSlab E2{(float*)(p.ws + WS_SLAB), NCTX}; pg8::gemm_phase((LAS unsigned char*)shm, g2, S2, E2);
                } }
#endif
        }
        if (ph + 1 < p.ph_hi) {
            if (p.ph_hi > NPHASE) grid.sync();
            xcd_barrier(xbar);
        }
    }
}

extern "C" void kernel_launch(void* const* d_in, const int* in_sizes, int n_in, void* d_out, int out_size, void* d_ws, size_t ws_size, hipStream_t stream) {
    static int grid_blocks = 0;
    if (!grid_blocks) {
        int dev = 0, cus = 0, per_cu = 0;
        hipGetDevice(&dev);
        hipDeviceGetAttribute(&cus, hipDeviceAttributeMultiprocessorCount, dev);
        if (hipFuncSetAttribute((const void*)fwd_megakernel, hipFuncAttributeMaxDynamicSharedMemorySize, LDS_BYTES) != hipSuccess) fprintf(stderr, "hipFuncSetAttribute failed\n");
        if (hipOccupancyMaxActiveBlocksPerMultiprocessor(&per_cu, (const void*)fwd_megakernel, 512, LDS_BYTES) != hipSuccess || per_cu < 1) { fprintf(stderr, "occupancy query: %d\n", per_cu); per_cu = 1; }
        (void)hipGetLastError();
        grid_blocks = cus * per_cu;
        if (ws_size < WS_SLAB + (size_t)NSPLIT * NCTX * DM * 4) fprintf(stderr, "workspace too small: %zu < %zu\n", ws_size, (size_t)WS_END);
    }
    Params p{};
    p.x = (const float*)d_in[0]; p.c = (const float*)d_in[1]; p.ctx = (const float*)d_in[2]; p.c_ctx = (const float*)d_in[3]; p.ada_w = (const float*)d_in[4];
    p.ada_b = (const float*)d_in[5]; p.norm1_g = (const float*)d_in[6]; p.w_in = (const float*)d_in[7]; p.ret_decay = (const float*)d_in[8];
    p.gate_up = (const float*)d_in[9]; p.gate_b = (const float*)d_in[10]; p.gla_norm_g = (const float*)d_in[11]; p.w_out = (const float*)d_in[12];
    p.norm2_g = (const float*)d_in[13]; p.w_mlp1 = (const float*)d_in[14]; p.w_mlp2 = (const float*)d_in[15]; p.final_g = (const float*)d_in[16];
    p.out = (float*)d_out; p.ws = (unsigned char*)d_ws;
    if (hipMemsetAsync((unsigned char*)d_ws + WS_BAR, 0, BAR_BYTES, stream) != hipSuccess) fprintf(stderr, "memset of barrier words failed\n");
#if MULTI
    for (int ph = 0; ph < NPHASE; ++ph) {
        p.ph_lo = ph; p.ph_hi = ph + 1;
        hipLaunchKernelGGL(fwd_megakernel, dim3(grid_blocks), dim3(512), LDS_BYTES, stream, p);
    }
#else
    p.ph_lo = 0; p.ph_hi = NPHASE;
    void* args[] = {&p};
    hipError_t e = hipLaunchCooperativeKernel((const void*)fwd_megakernel, dim3(grid_blocks), dim3(512), args, LDS_BYTES, stream);
    if (e != hipSuccess) fprintf(stderr, "cooperative launch failed: %s (grid %d)\n", hipGetErrorString(e), grid_blocks);
#endif
}
```

```cpp
#include <hip/hip_runtime.h>
#include <hip/hip_cooperative_groups.h>
#include <cstdio>
namespace cg = cooperative_groups;

#ifndef MULTI
#define MULTI 0
#endif

#define LAS __attribute__((address_space(3)))
typedef unsigned short bf16_t;
typedef short bf16x8 __attribute__((ext_vector_type(8)));
typedef short s16x4 __attribute__((ext_vector_type(4)));
typedef float f32x4 __attribute__((ext_vector_type(4)));
typedef unsigned u32x2 __attribute__((ext_vector_type(2)));
typedef unsigned u32x4 __attribute__((ext_vector_type(4)));

constexpr int DM = 1024, NB = 8, SEQ = 4096, CTXL = 256, NLAT = NB * SEQ, NCTX = NB * CTXL, MTOT = NLAT + NCTX;
constexpr int INW = 3616, INWP = 3840, DFF = 4096;
constexpr int NPHASE = 18;
constexpr int LDS_BYTES = 131072 + 16;

constexpr size_t WS_WIN = 0;
constexpr size_t WS_WOUT = WS_WIN + (size_t)2 * INWP * DM * 2;
constexpr size_t WS_W1 = WS_WOUT + (size_t)2 * DM * DM * 2;
constexpr size_t WS_W2 = WS_W1 + (size_t)2 * DFF * DM * 2;
constexpr size_t WS_MOD = WS_W2 + (size_t)2 * DM * DFF * 2;
constexpr size_t WS_TAB = WS_MOD + (size_t)2 * 9 * 6 * DM * 4;
constexpr size_t WS_XCTX = WS_TAB + (size_t)2 * 2048 * 4;
constexpr size_t WS_H = WS_XCTX + (size_t)NCTX * DM * 4;
constexpr size_t WS_P = WS_H + (size_t)MTOT * DM * 2;
constexpr size_t WS_OB = WS_P + (size_t)MTOT * INW * 2;
constexpr size_t WS_END = WS_OB + (size_t)MTOT * DM * 2;
static_assert((size_t)MTOT * DFF * 2 <= WS_END - WS_P, "hmlp alias");
constexpr size_t WS_BAR = WS_END;
constexpr size_t BAR_BYTES = 16384;
constexpr size_t WS_SLAB = WS_BAR + BAR_BYTES;
constexpr int NSPLIT = 8;
static_assert(WS_SLAB + (size_t)NSPLIT * NCTX * DM * 4 <= (size_t)536870912, "ws");

struct Params {
    const float* x; const float* c; const float* ctx; const float* c_ctx; const float* ada_w; const float* ada_b; const float* norm1_g;
    const float* w_in; const float* ret_decay; const float* gate_up; const float* gate_b; const float* gla_norm_g; const float* w_out;
    const float* norm2_g; const float* w_mlp1; const float* w_mlp2; const float* final_g;
    float* out; unsigned char* ws; int ph_lo, ph_hi;
};

typedef float f32x2_t __attribute__((ext_vector_type(2)));
typedef __bf16 bf16x2_t __attribute__((ext_vector_type(2)));
__device__ __forceinline__ unsigned cvt_pk_bf16(float lo, float hi) { f32x2_t v = {lo, hi}; bf16x2_t b = __builtin_convertvector(v, bf16x2_t); return __builtin_bit_cast(unsigned, b); }
__device__ __forceinline__ bf16_t f2bf(float f) { return (bf16_t)(cvt_pk_bf16(f, 0.f) & 0xffffu); }
__device__ __forceinline__ float bf2f(short b) { return __uint_as_float(((unsigned)(unsigned short)b) << 16); }
__device__ __forceinline__ int otid() { int t = threadIdx.x; asm volatile("" : "+v"(t)); return t; }
__device__ __forceinline__ float silu_f(float v) { return v / (1.f + __expf(-v)); }

namespace pg8 {
constexpr int STAGGER_TICKS = 0;
constexpr int BM = 256, BK = 64, HALF = 128, HTB = HALF * BK * 2, STAGE_BYTES = 8 * HTB, NXCD = 8, WGM = 8;
__host__ __device__ __forceinline__ int lds_byte(int r, int c) { const int st = (r >> 4) * 2 + (c >> 5), rr = r & 15, cc = c & 31, ob = rr * 64 + cc * 2; return st * 1024 + (ob ^ (((ob >> 9) & 1) << 5)); }
__host__ __device__ __forceinline__ void stage_rc(int b, int& R, int& C) { const int st = b / 1024, sb = b % 1024, swz = sb ^ (((sb >> 9) & 1) << 5); R = (st >> 1) * 16 + swz / 64; C = (st & 1) * 32 + (swz % 64) / 2; }
__host__ __device__ __forceinline__ int perm32(int rho) { const int n = rho >> 4, i = rho & 15; return 8 * (i >> 2) + 4 * n + (i & 3); }
struct Unit { int pm, pn, kofs, ks; };
struct Gemm { const bf16_t* A; const bf16_t* Bt; int M, N, K, ld; };
struct StaticOrder {
    int nM, nN, nwg, G, c;
    __host__ __device__ void init(int M, int N, int G_, int c_) { nM = M / BM; nN = N / BM; nwg = nM * nN; G = G_; c = c_; }
    __host__ __device__ bool next(int i, Unit& u) const {
        const long L = (long)i * G + c; if (L >= nwg) return false;
        int wgid = (int)L; { const int q = nwg / NXCD, r = nwg % NXCD, xcd = wgid % NXCD, off = wgid / NXCD; wgid = (xcd < r ? xcd * (q + 1) : r * (q + 1) + (xcd - r) * q) + off; }
        const int nig = WGM * nN, gid = wgid / nig, fm = gid * WGM, gsz = (nM - fm) < WGM ? (nM - fm) : WGM;
        u.pm = fm + ((wgid % nig) % gsz); u.pn = (wgid % nig) / gsz; u.kofs = 0; u.ks = 0; return true;
    }
    __device__ __forceinline__ void a_ready(const Unit&) const {}
    __device__ __forceinline__ void done(const Unit&) const {}
};

template <int NS, int KS> struct SplitOrder {
    int G, c;
    __device__ bool next(int i, Unit& u) const {
        const int idx = i * G + c; if (idx >= 32 * NS) return false;
        u.ks = idx % NS; const int t = idx / NS; u.pn = t & 3; u.pm = t >> 2; u.kofs = u.ks * KS * 2; return true;
    }
    __device__ __forceinline__ void a_ready(const Unit&) const {}
    __device__ __forceinline__ void done(const Unit&) const {}
};
template <class Epi, class Sched>
__device__ __forceinline__ void gemm_phase(LAS unsigned char* lds, const Gemm g, const Sched& S, const Epi& E) {
    const int tid = otid(), wid = __builtin_amdgcn_readfirstlane(tid >> 6), lane = tid & 63, wr = wid >> 2, wc = wid & 3, fr = lane & 15, fq = lane >> 4;
    const int K = g.ld, nt = g.K / BK;
    unsigned voffA[2], voffB[2];
#pragma unroll
    for (int i = 0; i < 2; ++i) { int R, C; stage_rc(tid * 16 + i * 8192, R, C); const int Rb = Epi::PERM ? ((R & ~31) + perm32(R & 31)) : R;
        voffA[i] = (unsigned)(R * K + C) * 2u; voffB[i] = (unsigned)(Rb * K + C) * 2u; }
    const size_t kstep = (size_t)(BK * 2);
    const size_t hstep = (size_t)HALF * K * 2;
    const size_t tstep = 2 * hstep;
    const unsigned ldsw = (unsigned)wid * 1024u;
    const int aoff = lds_byte(wr * 64 + fr, fq * 8), boff = lds_byte(wc * 32 + fr, fq * 8);
#define PG8_SA(b, h) (((b) * 2 + (h)) * HTB)
#define PG8_SB(b, h) ((4 + (b) * 2 + (h)) * HTB)
#define PG8_STAGE(bufoff, gbase, voff) do { _Pragma("unroll") for (int _i = 0; _i < 2; ++_i) \
        __builtin_amdgcn_global_load_lds((const unsigned*)((const char*)(gbase) + (voff)[_i]), (LAS unsigned*)(lds + (bufoff) + ldsw + _i * 8192), 16, 0, 0); } while (0)
#define PG8_LDA(dst, b, h) do { _Pragma("unroll") for (int m = 0; m < 4; ++m) _Pragma("unroll") for (int k = 0; k < 2; ++k) dst[m][k] = *(const LAS bf16x8*)(lds + PG8_SA(b, h) + aoff + m * 2048 + k * 1024); } while (0)
#define PG8_LDB(dst, b, h) do { _Pragma("unroll") for (int n = 0; n < 2; ++n) _Pragma("unroll") for (int k = 0; k < 2; ++k) dst[n][k] = *(const LAS bf16x8*)(lds + PG8_SB(b, h) + boff + n * 2048 + k * 1024); } while (0)
#define PG8_MMA(ai, bj, At, Bt) do { __builtin_amdgcn_s_setprio(1); _Pragma("unroll") for (int m = 0; m < 4; ++m) _Pragma("unroll") for (int n = 0; n < 2; ++n) _Pragma("unroll") for (int k = 0; k < 2; ++k) \
        acc[ai][bj][m][n] = __builtin_amdgcn_mfma_f32_16x16x32_bf16(Bt[n][k], At[m][k], acc[ai][bj][m][n], 0, 0, 0); __builtin_amdgcn_s_setprio(0); } while (0)
#define PG8_WAIT_V(n) asm volatile("s_waitcnt vmcnt(" #n ")" ::: "memory")
#define PG8_WAIT_L(n) asm volatile("s_waitcnt lgkmcnt(" #n ")" ::: "memory")
#define PG8_BAR __builtin_amdgcn_s_barrier()
#define PG8_SCHED __builtin_amdgcn_sched_barrier(0)
    Unit cur, nxt; int ui = 0;
    if (!S.next(0, cur)) return;
    if (STAGGER_TICKS > 0 && (blockIdx.x & 1)) {
        const unsigned long long t0 = __builtin_amdgcn_s_memrealtime();
        while (__builtin_amdgcn_s_memrealtime() - t0 < (unsigned long long)STAGGER_TICKS) __builtin_amdgcn_s_sleep(8);
    }
    f32x4 acc[2][2][4][2];
#pragma unroll
    for (int a = 0; a < 2; ++a)
#pragma unroll
        for (int b = 0; b < 2; ++b)
#pragma unroll
            for (int m = 0; m < 4; ++m)
#pragma unroll
                for (int n = 0; n < 2; ++n) acc[a][b][m][n] = (f32x4){0.f, 0.f, 0.f, 0.f};
    bf16x8 At[4][2], B0[2][2], B1[2][2];
    const char* cA = (const char*)g.A + (size_t)cur.pm * tstep + cur.kofs; const char* cB = (const char*)g.Bt + (size_t)cur.pn * tstep + cur.kofs;
    S.a_ready(cur);
    PG8_STAGE(PG8_SB(0, 0), cB, voffB); PG8_STAGE(PG8_SA(0, 0), cA, voffA); PG8_STAGE(PG8_SB(0, 1), cB + hstep, voffB); PG8_STAGE(PG8_SA(0, 1), cA + hstep, voffA);
    if (wr == 1) PG8_BAR;
    PG8_WAIT_V(4); PG8_BAR;
    PG8_STAGE(PG8_SB(1, 0), cB + kstep, voffB); PG8_STAGE(PG8_SA(1, 0), cA + kstep, voffA); PG8_STAGE(PG8_SB(1, 1), cB + hstep + kstep, voffB);
    PG8_WAIT_V(6); PG8_BAR;
    for (;;) {
        const bool has_next = S.next(ui + 1, nxt);
        const char* nA = has_next ? (const char*)g.A + (size_t)nxt.pm * tstep + nxt.kofs : cA; const char* nB = has_next ? (const char*)g.Bt + (size_t)nxt.pn * tstep + nxt.kofs : cB;
        for (int t = 0; t < nt; t += 2) {
            const bool last = (t == nt - 2);
            const char* a1 = cA + (size_t)(t + 1) * kstep;
            const char* a2 = last ? nA : cA + (size_t)(t + 2) * kstep; const char* b2 = last ? nB : cB + (size_t)(t + 2) * kstep;
            const char* a3 = a2 + kstep; const char* b3 = b2 + kstep;
            if (last && has_next) S.a_ready(nxt);
            PG8_LDB(B0, 0, 0); PG8_SCHED; PG8_LDA(At, 0, 0); PG8_STAGE(PG8_SA(1, 1), a1 + hstep, voffA);
            PG8_WAIT_L(8); PG8_BAR; PG8_WAIT_L(0); PG8_MMA(0, 0, At, B0); PG8_BAR; PG8_SCHED;
            PG8_LDB(B1, 0, 1); PG8_STAGE(PG8_SB(0, 0), b2, voffB);
            PG8_BAR; PG8_WAIT_L(0); PG8_MMA(0, 1, At, B1); PG8_BAR;
            PG8_LDA(At, 0, 1); PG8_STAGE(PG8_SA(0, 0), a2, voffA);
            PG8_BAR; PG8_WAIT_L(0); PG8_MMA(1, 0, At, B0); PG8_BAR; PG8_SCHED;
            PG8_STAGE(PG8_SB(0, 1), b2 + hstep, voffB);
            PG8_WAIT_V(6); PG8_BAR; PG8_MMA(1, 1, At, B1); PG8_BAR;
            PG8_LDB(B0, 1, 0); PG8_SCHED; PG8_LDA(At, 1, 0); PG8_STAGE(PG8_SA(0, 1), a2 + hstep, voffA);
            PG8_WAIT_L(8); PG8_BAR; PG8_WAIT_L(0); PG8_MMA(0, 0, At, B0); PG8_BAR; PG8_SCHED;
            PG8_LDB(B1, 1, 1); PG8_STAGE(PG8_SB(1, 0), b3, voffB);
            PG8_BAR; PG8_WAIT_L(0); PG8_MMA(0, 1, At, B1); PG8_BAR;
            PG8_LDA(At, 1, 1); PG8_STAGE(PG8_SA(1, 0), a3, voffA);
            PG8_BAR; PG8_WAIT_L(0); PG8_MMA(1, 0, At, B0); PG8_BAR; PG8_SCHED;
            PG8_STAGE(PG8_SB(1, 1), b3 + hstep, voffB);
            PG8_WAIT_V(6); PG8_BAR; PG8_MMA(1, 1, At, B1); PG8_BAR;
        }
        E(acc, cur, wr, wc, fr, fq);
        if (!has_next) break;
#pragma unroll
        for (int a = 0; a < 2; ++a)
#pragma unroll
            for (int b = 0; b < 2; ++b)
#pragma unroll
                for (int m = 0; m < 4; ++m)
#pragma unroll
                    for (int n = 0; n < 2; ++n) acc[a][b][m][n] = (f32x4){0.f, 0.f, 0.f, 0.f};
        cur = nxt; cA = nA; cB = nB; ++ui;
    }
    PG8_WAIT_V(0);
    if (wr == 0) PG8_BAR;
    PG8_BAR;
#undef PG8_SA
#undef PG8_SB
#undef PG8_STAGE
#undef PG8_LDA
#undef PG8_LDB
#undef PG8_MMA
#undef PG8_WAIT_V
#undef PG8_WAIT_L
#undef PG8_BAR
#undef PG8_SCHED
}
}

struct EpiP {
    static constexpr bool PERM = true;
    bf16_t* P;
    __device__ __forceinline__ void operator()(const f32x4 (&acc)[2][2][4][2], const pg8::Unit& u, int wr, int wc, int fr, int fq) const {
        const int row0 = u.pm * 256 + wr * 64 + fr, col0 = u.pn * 256 + wc * 32 + 8 * fq;
#pragma unroll
        for (int ai = 0; ai < 2; ++ai)
#pragma unroll
            for (int m = 0; m < 4; ++m) { bf16_t* rowp = P + (size_t)(row0 + ai * 128 + m * 16) * INW;
#pragma unroll
                for (int bj = 0; bj < 2; ++bj) { const int c = col0 + bj * 128; const f32x4 v0 = acc[ai][bj][m][0], v1 = acc[ai][bj][m][1];
                    if (c < INW) { u32x4 w4; w4.x = cvt_pk_bf16(v0[0], v0[1]); w4.y = cvt_pk_bf16(v0[2], v0[3]); w4.z = cvt_pk_bf16(v1[0], v1[1]); w4.w = cvt_pk_bf16(v1[2], v1[3]); *(u32x4*)(rowp + c) = w4; } } }
    }
};
struct EpiRelu2 {
    static constexpr bool PERM = true;
    bf16_t* O;
    __device__ __forceinline__ void operator()(const f32x4 (&acc)[2][2][4][2], const pg8::Unit& u, int wr, int wc, int fr, int fq) const {
        const int row0 = u.pm * 256 + wr * 64 + fr, col0 = u.pn * 256 + wc * 32 + 8 * fq;
#pragma unroll
        for (int ai = 0; ai < 2; ++ai)
#pragma unroll
            for (int m = 0; m < 4; ++m) { bf16_t* rowp = O + (size_t)(row0 + ai * 128 + m * 16) * DFF;
#pragma unroll
                for (int bj = 0; bj < 2; ++bj) { const int c = col0 + bj * 128; f32x4 v0 = acc[ai][bj][m][0], v1 = acc[ai][bj][m][1];
#pragma unroll
                    for (int j = 0; j < 4; ++j) { const float r0 = fmaxf(v0[j], 0.f), r1 = fmaxf(v1[j], 0.f); v0[j] = r0 * r0; v1[j] = r1 * r1; }
                    u32x4 w4; w4.x = cvt_pk_bf16(v0[0], v0[1]); w4.y = cvt_pk_bf16(v0[2], v0[3]); w4.z = cvt_pk_bf16(v1[0], v1[1]); w4.w = cvt_pk_bf16(v1[2], v1[3]); *(u32x4*)(rowp + c) = w4; } }
    }
};
struct EpiRes {
    static constexpr bool PERM = false;
    const float* xin_lat; const float* xin_ctx; float* xout_lat; float* xout_ctx; const float* gate;
    __device__ __forceinline__ void operator()(const f32x4 (&acc)[2][2][4][2], const pg8::Unit& u, int wr, int wc, int fr, int fq) const {
        const int row0 = u.pm * 256 + wr * 64 + fr, col0 = u.pn * 256 + wc * 32 + 4 * fq;
        const int rb = u.pm * 256;
        const bool isctx = rb >= NLAT;
        const int bidx = isctx ? 8 : (rb >> 12);
        const float* xi = isctx ? xin_ctx - (size_t)NLAT * DM : xin_lat;
        float* xo = isctx ? xout_ctx - (size_t)NLAT * DM : xout_lat;
        const float* gp = gate + (size_t)bidx * 6 * DM;
        f32x4 gv[2][2];
#pragma unroll
        for (int bj = 0; bj < 2; ++bj)
#pragma unroll
            for (int n = 0; n < 2; ++n) gv[bj][n] = *(const f32x4*)(gp + col0 + bj * 128 + n * 16);
#pragma unroll
        for (int ai = 0; ai < 2; ++ai) {
            f32x4 xv[4][2][2];
#pragma unroll
            for (int m = 0; m < 4; ++m) { const size_t ro = (size_t)(row0 + ai * 128 + m * 16) * DM;
#pragma unroll
                for (int bj = 0; bj < 2; ++bj)
#pragma unroll
                    for (int n = 0; n < 2; ++n) xv[m][bj][n] = *(const f32x4*)(xi + ro + col0 + bj * 128 + n * 16); }
#pragma unroll
            for (int m = 0; m < 4; ++m) { const size_t ro = (size_t)(row0 + ai * 128 + m * 16) * DM;
#pragma unroll
                for (int bj = 0; bj < 2; ++bj)
#pragma unroll
                    for (int n = 0; n < 2; ++n) *(f32x4*)(xo + ro + col0 + bj * 128 + n * 16) = xv[m][bj][n] + gv[bj][n] * acc[ai][bj][m][n]; }
        }
    }
};
struct EpiSlab {
    static constexpr bool PERM = false;
    float* slab; int rows;
    __device__ __forceinline__ void operator()(const f32x4 (&acc)[2][2][4][2], const pg8::Unit& u, int wr, int wc, int fr, int fq) const {
        const int row0 = u.pm * 256 + wr * 64 + fr, col0 = u.pn * 256 + wc * 32 + 4 * fq;
        float* base = slab + (size_t)u.ks * rows * DM;
#pragma unroll
        for (int ai = 0; ai < 2; ++ai)
#pragma unroll
            for (int m = 0; m < 4; ++m) { float* rowp = base + (size_t)(row0 + ai * 128 + m * 16) * DM + col0;
#pragma unroll
                for (int bj = 0; bj < 2; ++bj)
#pragma unroll
                    for (int n = 0; n < 2; ++n) *(f32x4*)(rowp + bj * 128 + n * 16) = acc[ai][bj][m][n]; }
    }
};

struct TileDesc { const float* src; bf16_t* dst; int K, N, k0, n0; };
__device__ __forceinline__ TileDesc tile_desc(const Params& p, int t) {
    constexpr int T_IN = 16 * 60, T_OUT = 16 * 16, T_1 = 16 * 64, T_2 = 64 * 16, T_L = T_IN + T_OUT + T_1 + T_2;
    const int l = t / T_L; int r = t % T_L; TileDesc d;
    if (r < T_IN) { d.src = p.w_in + (size_t)l * DM * INW; d.K = DM; d.N = INW; d.dst = (bf16_t*)(p.ws + WS_WIN) + (size_t)l * INWP * DM; d.k0 = (r / 60) * 64; d.n0 = (r % 60) * 64; }
    else if ((r -= T_IN) < T_OUT) { d.src = p.w_out + (size_t)l * DM * DM; d.K = DM; d.N = DM; d.dst = (bf16_t*)(p.ws + WS_WOUT) + (size_t)l * DM * DM; d.k0 = (r / 16) * 64; d.n0 = (r % 16) * 64; }
    else if ((r -= T_OUT) < T_1) { d.src = p.w_mlp1 + (size_t)l * DM * DFF; d.K = DM; d.N = DFF; d.dst = (bf16_t*)(p.ws + WS_W1) + (size_t)l * DFF * DM; d.k0 = (r / 64) * 64; d.n0 = (r % 64) * 64; }
    else { r -= T_1; d.src = p.w_mlp2 + (size_t)l * DFF * DM; d.K = DFF; d.N = DM; d.dst = (bf16_t*)(p.ws + WS_W2) + (size_t)l * DM * DFF; d.k0 = (r / 16) * 64; d.n0 = (r % 16) * 64; }
    return d;
}
__device__ __forceinline__ void tile_load(const TileDesc& d, int tid, f32x4 (&v)[2]) {
    const int r = tid >> 4, n = d.n0 + 4 * (tid & 15); const bool in = n < d.N; const int nc = in ? n : 0;
#pragma unroll
    for (int i = 0; i < 2; ++i) { const f32x4 t = *(const f32x4*)(d.src + (size_t)(d.k0 + r + 32 * i) * d.N + nc); v[i] = in ? t : (f32x4){0.f, 0.f, 0.f, 0.f}; }
}
__device__ __forceinline__ void tile_put(const f32x4 (&v)[2], int tid, float* tile) {
    const int r = tid >> 4, c = 4 * (tid & 15);
#pragma unroll
    for (int i = 0; i < 2; ++i)
#pragma unroll
        for (int j = 0; j < 4; ++j) tile[(r + 32 * i) * 65 + c + j] = v[i][j];
}
__device__ __forceinline__ void tile_store(const TileDesc& d, int tid, const float* tile) {
    const int n = tid >> 3, kg = tid & 7; float f[8];
#pragma unroll
    for (int j = 0; j < 8; ++j) f[j] = tile[(8 * kg + j) * 65 + n];
    u32x4 o; o.x = cvt_pk_bf16(f[0], f[1]); o.y = cvt_pk_bf16(f[2], f[3]); o.z = cvt_pk_bf16(f[4], f[5]); o.w = cvt_pk_bf16(f[6], f[7]);
    *(u32x4*)(d.dst + (size_t)(d.n0 + n) * d.K + d.k0 + 8 * kg) = o;
}
constexpr int NT_LAYER = 16 * 60 + 16 * 16 + 16 * 64 + 64 * 16;
__device__ void convert_weights(const Params& p, unsigned char* lds, int t_lo, int t_hi, int rank, int nranks) {
    float* tile = (float*)lds; float* tile2 = tile + 64 * 65 + 32;
    const int tid = otid();
    for (int t = t_lo + rank; t < t_hi; t += 2 * nranks) {
        const int t2 = t + nranks; const bool has2 = t2 < t_hi;
        const TileDesc da = tile_desc(p, t), db = tile_desc(p, has2 ? t2 : t);
        f32x4 va[2], vb[2];
        tile_load(da, tid, va); tile_load(db, tid, vb);
        tile_put(va, tid, tile); tile_put(vb, tid, tile2);
        __syncthreads();
        tile_store(da, tid, tile); if (has2) tile_store(db, tid, tile2);
        __syncthreads();
    }
}
__device__ void phase_prep(const Params& p, unsigned char* lds) {
    float* tile = (float*)lds; float* tile2 = tile + 64 * 65 + 32;
    const int tid = otid();
    convert_weights(p, lds, 0, NT_LAYER, blockIdx.x, gridDim.x);
    float* red = (float*)lds;
    float* scv = red + 8 * 9 * 64;
    const int w = tid >> 6, lane = tid & 63;
    if (blockIdx.x < 2 * 96) {
        __syncthreads();
        for (int i = tid; i < 9 * DM; i += 512) { const float cv = (i < 8 * DM) ? p.c[i] : p.c_ctx[i - 8 * DM]; scv[i] = silu_f(cv); }
        __syncthreads();
    }
    for (int it = blockIdx.x; it < 2 * 96; it += gridDim.x) {
        const int l = it / 96, j0 = (it % 96) * 64;
        float a[9];
#pragma unroll
        for (int r = 0; r < 9; ++r) a[r] = 0.f;
        const float* wp = p.ada_w + (size_t)l * DM * 6 * DM + j0 + lane;
#pragma unroll 4
        for (int k = w * 128; k < w * 128 + 128; ++k) {
            const float wv = wp[(size_t)k * 6 * DM];
#pragma unroll
            for (int r = 0; r < 9; ++r) a[r] += scv[r * DM + k] * wv;
        }
        __syncthreads();
#pragma unroll
        for (int r = 0; r < 9; ++r) red[(w * 9 + r) * 64 + lane] = a[r];
        __syncthreads();
        for (int idx = tid; idx < 9 * 64; idx += 512) { const int r = idx >> 6, ln = idx & 63; float sacc = 0.f;
#pragma unroll
            for (int ww = 0; ww < 8; ++ww) sacc += red[(ww * 9 + r) * 64 + ln];
            ((float*)(p.ws + WS_MOD))[((size_t)l * 9 + r) * 6 * DM + j0 + ln] = sacc + p.ada_b[(size_t)l * 6 * DM + j0 + ln]; }
    }
    if (blockIdx.x == gridDim.x - 1) {
        float* tab = (float*)(p.ws + WS_TAB);
        for (int idx = tid; idx < 2048; idx += 512) { const int pos = idx >> 5, i = idx & 31; const float inv = powf(10000.0f, -(float)i / 32.0f); const float ang = (float)pos * inv;
            tab[idx] = cosf(ang); tab[2048 + idx] = sinf(ang); }
    }
    __syncthreads();
}

__device__ __forceinline__ const float* xrow(const float* lat, const float* ctx, int m) { return m < NLAT ? lat + (size_t)m * DM : ctx + (size_t)(m - NLAT) * DM; }
__device__ void phase_norm(const Params& p, const float* xl, const float* xc, const float* g, const float* mod_l, int sh_off, int nrows,
                           const float* slab, const float* slab_gate) {
    const int tid_ = otid(); const int lane = tid_ & 63, gw = blockIdx.x * 8 + (tid_ >> 6), nw = gridDim.x * 8;
    bf16_t* H = (bf16_t*)(p.ws + WS_H);
    f32x4 nv[4], gg4[4];
#pragma unroll
    for (int i = 0; i < 4; ++i) { nv[i] = (f32x4){0.f, 0.f, 0.f, 0.f}; gg4[i] = *(const f32x4*)(g + 4 * lane + 256 * i); }
    if (gw < nrows) { const float* xr = xrow(xl, xc, gw);
#pragma unroll
        for (int i = 0; i < 4; ++i) nv[i] = *(const f32x4*)(xr + 4 * lane + 256 * i); }
    for (int m = gw; m < nrows; m += nw) {
        const int b = m < NLAT ? (m >> 12) : 8;
        const float* sh = mod_l + (size_t)b * 6 * DM + sh_off; const float* sc = sh + DM;
        f32x4 v[4]; float ss = 0.f;
#pragma unroll
        for (int i = 0; i < 4; ++i) v[i] = nv[i];
        if (m + nw < nrows) { const float* xr = xrow(xl, xc, m + nw);
#pragma unroll
            for (int i = 0; i < 4; ++i) nv[i] = *(const f32x4*)(xr + 4 * lane + 256 * i); }
        f32x4 sc4[4], sh4[4];
#pragma unroll
        for (int i = 0; i < 4; ++i) { sc4[i] = *(const f32x4*)(sc + 4 * lane + 256 * i); sh4[i] = *(const f32x4*)(sh + 4 * lane + 256 * i); }
        asm volatile("" ::: "memory");
#pragma unroll
        for (int i = 0; i < 4; ++i) {
            if (slab != nullptr && m >= NLAT) {
                f32x4 sl[NSPLIT];
#pragma unroll
                for (int ks = 0; ks < NSPLIT; ++ks) sl[ks] = *(const f32x4*)(slab + ((size_t)ks * NCTX + (m - NLAT)) * DM + 4 * lane + 256 * i);
                const f32x4 acc4 = ((sl[0] + sl[1]) + (sl[2] + sl[3])) + ((sl[4] + sl[5]) + (sl[6] + sl[7]));
                v[i] += *(const f32x4*)(slab_gate + 4 * lane + 256 * i) * acc4;
            }
            ss += v[i][0] * v[i][0] + v[i][1] * v[i][1] + v[i][2] * v[i][2] + v[i][3] * v[i][3]; }
#pragma unroll
        for (int o = 32; o >= 1; o >>= 1) ss += __shfl_xor(ss, o);
        const float rinv = rsqrtf(ss * (1.0f / DM) + 1e-6f);
#pragma unroll
        for (int i = 0; i < 4; ++i) { const int c = 4 * lane + 256 * i; const f32x4 gg = gg4[i], s1 = sc4[i], s0 = sh4[i];
            f32x4 y;
#pragma unroll
            for (int j = 0; j < 4; ++j) y[j] = (v[i][j] * rinv * gg[j]) * (1.f + s1[j]) + s0[j];
            u32x2 w2; w2.x = cvt_pk_bf16(y[0], y[1]); w2.y = cvt_pk_bf16(y[2], y[3]); *(u32x2*)(H + (size_t)m * DM + c) = w2; }
    }
}
__device__ void phase_final(const Params& p) {
    const int tid_ = otid(); const int lane = tid_ & 63, gw = blockIdx.x * 8 + (tid_ >> 6), nw = gridDim.x * 8;
    f32x4 nv[4], gg4[4];
#pragma unroll
    for (int i = 0; i < 4; ++i) { nv[i] = (f32x4){0.f, 0.f, 0.f, 0.f}; gg4[i] = *(const f32x4*)(p.final_g + 4 * lane + 256 * i); }
    if (gw < NLAT) {
#pragma unroll
        for (int i = 0; i < 4; ++i) nv[i] = *(const f32x4*)(p.out + (size_t)gw * DM + 4 * lane + 256 * i); }
    for (int m = gw; m < NLAT; m += nw) {
        float* xr = p.out + (size_t)m * DM;
        f32x4 v[4]; float ss = 0.f;
#pragma unroll
        for (int i = 0; i < 4; ++i) v[i] = nv[i];
        if (m + nw < NLAT) {
#pragma unroll
            for (int i = 0; i < 4; ++i) nv[i] = *(const f32x4*)(p.out + (size_t)(m + nw) * DM + 4 * lane + 256 * i); }
        asm volatile("" ::: "memory");
#pragma unroll
        for (int i = 0; i < 4; ++i) ss += v[i][0] * v[i][0] + v[i][1] * v[i][1] + v[i][2] * v[i][2] + v[i][3] * v[i][3];
#pragma unroll
        for (int o = 32; o >= 1; o >>= 1) ss += __shfl_xor(ss, o);
        const float rinv = rsqrtf(ss * (1.0f / DM) + 1e-6f);
#pragma unroll
        for (int i = 0; i < 4; ++i) { const int c = 4 * lane + 256 * i;
            f32x4 y;
#pragma unroll
            for (int j = 0; j < 4; ++j) y[j] = v[i][j] * rinv * gg4[i][j];
            *(f32x4*)(xr + c) = y; }
    }
}

__device__ void phase_merge(const Params& p, int l, int nrows) {
    const int tid_ = otid(); const int lane = tid_ & 63, gw = blockIdx.x * 8 + (tid_ >> 6), nw = gridDim.x * 8;
    bf16_t* H = (bf16_t*)(p.ws + WS_H); const bf16_t* OB = (const bf16_t*)(p.ws + WS_OB); const bf16_t* P = (const bf16_t*)(p.ws + WS_P);
    const bool isgla = lane >= 32;
    const int gcol = isgla ? (2560 + 16 * lane) : (1536 + 16 * lane);
    const float* gnp = p.gla_norm_g + l * 128 + ((16 * lane) & 127);
    float gn[16];
#pragma unroll
    for (int j = 0; j < 16; ++j) gn[j] = gnp[j];
    bf16x8 nf0, nf1, nb0, nb1, ng0, ng1;
    nf0 = nf1 = nb0 = nb1 = ng0 = ng1 = (bf16x8){0, 0, 0, 0, 0, 0, 0, 0};
#define MERGE_LOAD(mm) do { nf0 = *(const bf16x8*)(H + (size_t)(mm) * DM + 16 * lane); nf1 = *(const bf16x8*)(H + (size_t)(mm) * DM + 16 * lane + 8); \
        nb0 = *(const bf16x8*)(OB + (size_t)(mm) * DM + 16 * lane); nb1 = *(const bf16x8*)(OB + (size_t)(mm) * DM + 16 * lane + 8); \
        ng0 = *(const bf16x8*)(P + (size_t)(mm) * INW + gcol); ng1 = *(const bf16x8*)(P + (size_t)(mm) * INW + gcol + 8); } while (0)
    if (gw < nrows) MERGE_LOAD(gw);
    for (int m = gw; m < nrows; m += nw) {
        const bf16x8 f0 = nf0, f1 = nf1, b0 = nb0, b1 = nb1, g0 = ng0, g1 = ng1;
        if (m + nw < nrows) MERGE_LOAD(m + nw);
        asm volatile("" ::: "memory");
        float r[16]; float s1 = 0.f, s2 = 0.f;
#pragma unroll
        for (int j = 0; j < 8; ++j) { r[j] = bf2f(f0[j]) + bf2f(b0[j]); r[8 + j] = bf2f(f1[j]) + bf2f(b1[j]); }
#ifdef SANITIZE
#pragma unroll
        for (int j = 0; j < 16; ++j) { if (!(fabsf(r[j]) < 1e30f)) r[j] = 0.f; }
#endif
#ifdef SKIP_GLA
        if (isgla) {
#pragma unroll
            for (int j = 0; j < 16; ++j) r[j] = 0.f; }
#endif
#ifdef SKIP_RET
        if (!isgla) {
#pragma unroll
            for (int j = 0; j < 16; ++j) r[j] = 0.f; }
#endif
#pragma unroll
        for (int j = 0; j < 16; ++j) { s1 += r[j]; s2 += r[j] * r[j]; }
#pragma unroll
        for (int o = 1; o <= 4; o <<= 1) { s1 += __shfl_xor(s1, o); s2 += __shfl_xor(s2, o); }
        float y[16];
        if (!isgla) {
            const float mu = s1 * (1.f / 128.f); float sv = 0.f;
#pragma unroll
            for (int j = 0; j < 16; ++j) { const float d = r[j] - mu; sv += d * d; }
#pragma unroll
            for (int o = 1; o <= 4; o <<= 1) sv += __shfl_xor(sv, o);
            const float rs = rsqrtf(sv * (1.f / 128.f) + 1e-6f);
#pragma unroll
            for (int j = 0; j < 16; ++j) y[j] = (r[j] - mu) * rs;
        } else {
            float sv = 0.f;
#pragma unroll
            for (int o = 1; o <= 4; o <<= 1) sv += __shfl_xor(sv, o);
            const float rs = rsqrtf(s2 * (1.f / 128.f) + 1e-6f);
#pragma unroll
            for (int j = 0; j < 16; ++j) y[j] = r[j] * rs * gn[j] + 0.f * sv;
        }
        u32x4 o0, o1;
#pragma unroll
        for (int j = 0; j < 8; ++j) { y[j] *= silu_f(bf2f(g0[j])); y[8 + j] *= silu_f(bf2f(g1[j])); }
        o0.x = cvt_pk_bf16(y[0], y[1]); o0.y = cvt_pk_bf16(y[2], y[3]); o0.z = cvt_pk_bf16(y[4], y[5]); o0.w = cvt_pk_bf16(y[6], y[7]);
        o1.x = cvt_pk_bf16(y[8], y[9]); o1.y = cvt_pk_bf16(y[10], y[11]); o1.z = cvt_pk_bf16(y[12], y[13]); o1.w = cvt_pk_bf16(y[14], y[15]);
        *(u32x4*)(H + (size_t)m * DM + 16 * lane) = o0; *(u32x4*)(H + (size_t)m * DM + 16 * lane + 8) = o1;
    }
}

#undef MERGE_LOAD
template <int DK, bool GLA>
__device__ __forceinline__ void scan_item(const Params& p, int l, unsigned char* lds, LAS unsigned char* lds3, int b, int h, int dir, int dvs) {
    constexpr int QS = DK + 8, TS = 72, NT = DK / 32, NKS = DK / 32;
    bf16_t* QD = (bf16_t*)lds;
    bf16_t* KI = QD + 64 * QS;
    bf16_t* ST = KI + 64 * QS;
    bf16_t* VR = ST + 64 * QS;
    bf16_t* SC = VR + 64 * TS;
    constexpr int KI_B = 64 * QS * 2, VR_B = 3 * 64 * QS * 2;
    float* DVEC = (float*)(SC + 64 * TS);
    float* CL = DVEC + DK;
    float* CUM = CL + DK;
    float* UP = CUM + 2 * 64 * 68;
    const int tid = otid(), lane = tid & 63, w = __builtin_amdgcn_readfirstlane(tid >> 6), fr = lane & 15, fq = lane >> 4;
    const bf16_t* P = (const bf16_t*)(p.ws + WS_P);
    bf16_t* O = (bf16_t*)(p.ws + (dir ? WS_OB : WS_H));
    const float* TABC = (const float*)(p.ws + WS_TAB); const float* TABS = TABC + 2048;
    const int ocol = (GLA ? 512 : 0) + 128 * h + 64 * dvs;
    const int qcol = GLA ? 2048 + 64 * h : 128 * h, kcol = GLA ? 2304 + 64 * h : 512 + 128 * h, vcol = (GLA ? 2560 : 1024) + 128 * h + 64 * dvs;
    float g = 0.f;
    if (!GLA) g = log1pf(-__expf(p.ret_decay[l * 8 + dir * 4 + h]));
    constexpr int NDK = DK / 64;
    const int dkt0 = NDK * (w >> 1), dvt0 = 2 * (w & 1);
    f32x4 S[NT];
#pragma unroll
    for (int i = 0; i < NT; ++i) S[i] = (f32x4){0.f, 0.f, 0.f, 0.f};
    __syncthreads();
    for (int i = tid; i < 64 * QS / 2; i += 512) ((unsigned*)ST)[i] = 0u;
    bf16x8 uph[2], upl[2]; float ubv[2];
    uph[0] = uph[1] = upl[0] = upl[1] = (bf16x8){0, 0, 0, 0, 0, 0, 0, 0}; ubv[0] = ubv[1] = 0.f;
    float* TT = UP;
    if (GLA) {
#pragma unroll
        for (int ci = 0; ci < 2; ++ci) {
            const int ch = 16 * (2 * (w & 1) + ci) + fr;
#pragma unroll
            for (int j = 0; j < 8; ++j) {
                const float val = (fq < 2) ? p.gate_up[((size_t)(l * 2 + dir) * 16 + 8 * fq + j) * 256 + 64 * h + ch] : 0.f;
                const bf16_t hi = f2bf(val); const float rem = val - bf2f((short)hi);
                uph[ci][j] = (short)hi; upl[ci][j] = (short)f2bf(rem);
            }
            ubv[ci] = p.gate_b[(l * 2 + dir) * 256 + 64 * h + ch];
        }
    } else {
        if (tid < DK) DVEC[tid] = __expf(64.f * g);
    }
    __syncthreads();
    const int s_a = tid >> 3, pr = tid & 7, c8a = (pr & 3) + 8 * (pr >> 2), c8g = tid & 7;
    bf16x8 nq1, nq2, nk1, nk2, nv1, nd0, nd1; f32x4 nc0, nc1, ns0, ns1;
    nq2 = nq1 = nk1 = nk2 = nv1 = nd0 = nd1 = (bf16x8){0, 0, 0, 0, 0, 0, 0, 0}; nc0 = nc1 = ns0 = ns1 = (f32x4){0.f, 0.f, 0.f, 0.f};
#define SCAN_STEP_GEOM(stp, isctx_, chunk_, m0_) \
    const bool isctx_ = (stp) < 4; \
    const int chunk_ = dir == 0 ? (isctx_ ? (stp) : (stp) - 4) : (isctx_ ? 3 - (stp) : 67 - (stp)); \
    const int m0_ = isctx_ ? (NLAT + b * CTXL + chunk_ * 64) : (b * SEQ + chunk_ * 64);
#define SCAN_ISSUE(stp) do { SCAN_STEP_GEOM(stp, ic_, ch_, mm_) \
        const bf16_t* rp_ = P + (size_t)(mm_ + s_a) * INW; \
        if (GLA) { \
            nq1 = *(const bf16x8*)(rp_ + qcol + 8 * c8g); nk1 = *(const bf16x8*)(rp_ + kcol + 8 * c8g); } \
        else { nq1 = *(const bf16x8*)(rp_ + qcol + 8 * c8a); nq2 = *(const bf16x8*)(rp_ + qcol + 8 * (c8a + 4)); \
            nk1 = *(const bf16x8*)(rp_ + kcol + 8 * c8a); nk2 = *(const bf16x8*)(rp_ + kcol + 8 * (c8a + 4)); \
            const int pos_ = ic_ ? 0 : ((pr >> 2) ? s_a : ch_); \
            nc0 = *(const f32x4*)(TABC + pos_ * 32 + 8 * (pr & 3)); nc1 = *(const f32x4*)(TABC + pos_ * 32 + 8 * (pr & 3) + 4); \
            ns0 = *(const f32x4*)(TABS + pos_ * 32 + 8 * (pr & 3)); ns1 = *(const f32x4*)(TABS + pos_ * 32 + 8 * (pr & 3) + 4); } \
        nv1 = *(const bf16x8*)(rp_ + vcol + 8 * c8g); } while (0)
#define SCAN_ISSUE_D(stp) do { SCAN_STEP_GEOM(stp, icd_, chd_, mmd_) (void)chd_; \
        if (GLA && fq < 2) { const bf16_t* dp_ = P + (size_t)(mmd_ + 16 * (w >> 1) + fr) * INW + 3584 + 16 * dir + 8 * fq; nd0 = *(const bf16x8*)dp_; } } while (0)
    auto gate_stage = [&](const bf16x8 dfrag, float* CUMb, float* TTb) {
        const int st = w >> 1;
#pragma unroll
        for (int ci = 0; ci < 2; ++ci) {
            const int ch = 16 * (2 * (w & 1) + ci) + fr;
            f32x4 z = __builtin_amdgcn_mfma_f32_16x16x32_bf16(dfrag, uph[ci], (f32x4){0.f, 0.f, 0.f, 0.f}, 0, 0, 0);
            z = __builtin_amdgcn_mfma_f32_16x16x32_bf16(dfrag, upl[ci], z, 0, 0, 0);
            float la[4], pz[4];
#pragma unroll
            for (int r = 0; r < 4; ++r) { const float zz = z[r] + ubv[ci]; la[r] = (fminf(zz, 0.f) - __logf(1.f + __expf(-fabsf(zz)))) * (1.0f / 16.0f); }
            float T, ex = 0.f;
            if (dir == 0) {
                pz[0] = la[0]; pz[1] = pz[0] + la[1]; pz[2] = pz[1] + la[2]; pz[3] = pz[2] + la[3]; T = pz[3];
                const float t1 = __shfl_up(T, 16), t2 = __shfl_up(T, 32), t3 = __shfl_up(T, 48);
                if (fq >= 1) ex += t1; if (fq >= 2) ex += t2; if (fq >= 3) ex += t3;
            } else {
                pz[3] = la[3]; pz[2] = pz[3] + la[2]; pz[1] = pz[2] + la[1]; pz[0] = pz[1] + la[0]; T = pz[0];
                const float t1 = __shfl_down(T, 16), t2 = __shfl_down(T, 32), t3 = __shfl_down(T, 48);
                if (fq <= 2) ex += t1; if (fq <= 1) ex += t2; if (fq == 0) ex += t3;
            }
            const float ttot = __shfl(T + ex, dir == 0 ? 48 + fr : fr);
#pragma unroll
            for (int r = 0; r < 4; ++r) CUMb[(16 * st + 4 * fq + r) * 68 + ch] = pz[r] + ex;
            if (fq == 0) TTb[st * 64 + ch] = ttot;
        }
    };
    SCAN_ISSUE(0);
    if (GLA) {
        SCAN_ISSUE_D(0);
        const bf16x8 dfirst = nd0;
        SCAN_ISSUE_D(1);
        gate_stage(dfirst, CUM, TT);
        __syncthreads();
    }
    for (int step = 0; step < 68; ++step) {
        SCAN_STEP_GEOM(step, isctx, chunk, m0)
        const bf16x8 q1 = nq1, q2 = nq2, k1 = nk1, k2 = nk2, v1 = nv1, d0 = nd0, d1 = nd1; const f32x4 tc0 = nc0, tc1 = nc1, ts0 = ns0, ts1 = ns1;
        { const int nstep = step + 1 < 68 ? step + 1 : 67; SCAN_ISSUE(nstep); }
        if (GLA) { const int dstep = step + 2 < 68 ? step + 2 : 67; SCAN_ISSUE_D(dstep); }
        (void)chunk; (void)d1;
        float* CUMc = CUM + (step & 1) * 64 * 68; float* TTc = TT + (step & 1) * 256;
        {
            const int s = s_a;
            if (!GLA) {
                const float cum = dir == 0 ? g * (float)(s + 1) : g * (float)(64 - s), cl = 64.f * g;
                const float eq = __expf(cum) * 0.08838834764831845f, eki = __expf(-cum); (void)cl;
                float cs[8], sn[8];
#pragma unroll
                for (int j = 0; j < 4; ++j) { cs[j] = isctx ? 1.f : tc0[j]; cs[4 + j] = isctx ? 1.f : tc1[j]; sn[j] = isctx ? 0.f : ts0[j]; sn[4 + j] = isctx ? 0.f : ts1[j]; }
                float qa[8], qb[8], ka[8], kb[8];
#pragma unroll
                for (int j = 0; j < 8; ++j) {
                    const float a1 = bf2f(q1[j]), a2 = bf2f(q2[j]), b1 = bf2f(k1[j]), b2 = bf2f(k2[j]);
                    qa[j] = a1 * cs[j] - a2 * sn[j]; qb[j] = a1 * sn[j] + a2 * cs[j];
                    ka[j] = b1 * cs[j] - b2 * sn[j]; kb[j] = b1 * sn[j] + b2 * cs[j];
                }
                u32x4 o;
                o.x = cvt_pk_bf16(qa[0] * eq, qa[1] * eq); o.y = cvt_pk_bf16(qa[2] * eq, qa[3] * eq); o.z = cvt_pk_bf16(qa[4] * eq, qa[5] * eq); o.w = cvt_pk_bf16(qa[6] * eq, qa[7] * eq);
                *(u32x4*)(QD + s * QS + 8 * c8a) = o;
                o.x = cvt_pk_bf16(qb[0] * eq, qb[1] * eq); o.y = cvt_pk_bf16(qb[2] * eq, qb[3] * eq); o.z = cvt_pk_bf16(qb[4] * eq, qb[5] * eq); o.w = cvt_pk_bf16(qb[6] * eq, qb[7] * eq);
                *(u32x4*)(QD + s * QS + 8 * (c8a + 4)) = o;
                o.x = cvt_pk_bf16(ka[0] * eki, ka[1] * eki); o.y = cvt_pk_bf16(ka[2] * eki, ka[3] * eki); o.z = cvt_pk_bf16(ka[4] * eki, ka[5] * eki); o.w = cvt_pk_bf16(ka[6] * eki, ka[7] * eki);
                *(u32x4*)(KI + s * QS + 8 * c8a) = o;
                o.x = cvt_pk_bf16(kb[0] * eki, kb[1] * eki); o.y = cvt_pk_bf16(kb[2] * eki, kb[3] * eki); o.z = cvt_pk_bf16(kb[4] * eki, kb[5] * eki); o.w = cvt_pk_bf16(kb[6] * eki, kb[7] * eki);
                *(u32x4*)(KI + s * QS + 8 * (c8a + 4)) = o;
            } else {
                const int c8 = c8g;
                f32x4 cu0 = *(const f32x4*)(CUMc + s * 68 + 8 * c8), cu1 = *(const f32x4*)(CUMc + s * 68 + 8 * c8 + 4);
                {
                    const int stile = w >> 1;
#pragma unroll
                    for (int t4 = 0; t4 < 4; ++t4) {
                        const bool inc = dir == 0 ? (t4 < stile) : (t4 > stile);
                        if (inc) { cu0 += *(const f32x4*)(TTc + t4 * 64 + 8 * c8); cu1 += *(const f32x4*)(TTc + t4 * 64 + 8 * c8 + 4); }
                    }
                }
                if (s == 0) {
                    f32x4 cl0 = (f32x4){0.f, 0.f, 0.f, 0.f}, cl1 = cl0;
#pragma unroll
                    for (int t4 = 0; t4 < 4; ++t4) { cl0 += *(const f32x4*)(TTc + t4 * 64 + 8 * c8); cl1 += *(const f32x4*)(TTc + t4 * 64 + 8 * c8 + 4); }
#pragma unroll
                    for (int j = 0; j < 4; ++j) { DVEC[8 * c8 + j] = __expf(cl0[j]); DVEC[8 * c8 + 4 + j] = __expf(cl1[j]); }
                }
                float qd[8], ki[8];
#pragma unroll
                for (int j = 0; j < 8; ++j) {
                    const float cu = j < 4 ? cu0[j & 3] : cu1[j & 3];
                    const float e = __expf(cu);
                    qd[j] = bf2f(q1[j]) * (0.125f * e); ki[j] = bf2f(k1[j]) * __builtin_amdgcn_rcpf(e);
                }
                u32x4 o;
                o.x = cvt_pk_bf16(qd[0], qd[1]); o.y = cvt_pk_bf16(qd[2], qd[3]); o.z = cvt_pk_bf16(qd[4], qd[5]); o.w = cvt_pk_bf16(qd[6], qd[7]);
                *(u32x4*)(QD + s * QS + 8 * c8) = o;
                o.x = cvt_pk_bf16(ki[0], ki[1]); o.y = cvt_pk_bf16(ki[2], ki[3]); o.z = cvt_pk_bf16(ki[4], ki[5]); o.w = cvt_pk_bf16(ki[6], ki[7]);
                *(u32x4*)(KI + s * QS + 8 * c8) = o;
            }
            *(bf16x8*)(VR + s * TS + 8 * c8g) = v1;
        }
        __syncthreads();
        bf16x8 qf[NKS];
        {
            const int tt = w >> 1;
#pragma unroll
            for (int ks = 0; ks < NKS; ++ks) qf[ks] = *(const bf16x8*)(QD + (16 * tt + fr) * QS + 32 * ks + 8 * fq);
#pragma unroll
            for (int si = 0; si < 2; ++si) {
                const int st = 2 * (w & 1) + si;
                f32x4 acc = (f32x4){0.f, 0.f, 0.f, 0.f};
#pragma unroll
                for (int ks = 0; ks < NKS; ++ks) {
                    const bf16x8 a = *(const bf16x8*)(KI + (16 * st + fr) * QS + 32 * ks + 8 * fq);
                    acc = __builtin_amdgcn_mfma_f32_16x16x32_bf16(a, qf[ks], acc, 0, 0, 0);
                }
                const int t = 16 * tt + fr, s0 = 16 * st + 4 * fq;
                float v[4];
#pragma unroll
                for (int r = 0; r < 4; ++r) { const int s = s0 + r; const bool keep = dir == 0 ? (s <= t) : (s > t); v[r] = keep ? acc[r] : 0.f; }
                u32x2 w2; w2.x = cvt_pk_bf16(v[0], v[1]); w2.y = cvt_pk_bf16(v[2], v[3]);
                *(u32x2*)(SC + t * TS + s0) = w2;
            }
        }
        __syncthreads();
        if (GLA && step + 1 < 68) gate_stage(d0, CUM + ((step + 1) & 1) * 64 * 68, TT + ((step + 1) & 1) * 256);
        {
            const int tt = w >> 1;
            bf16x8 scf[2], kitf[NDK][2], vtf[2][2];
            const int trow = 8 * fq + (fr >> 2), tcol = 4 * (fr & 3);
#pragma unroll
            for (int ks = 0; ks < 2; ++ks) {
                scf[ks] = *(const bf16x8*)(SC + (16 * tt + fr) * TS + 32 * ks + 8 * fq);
#pragma unroll
                for (int a = 0; a < NDK; ++a) {
                    const s16x4 lo = __builtin_amdgcn_ds_read_tr16_b64_v4i16((LAS s16x4*)(lds3 + KI_B + ((32 * ks + trow) * QS + 16 * (dkt0 + a) + tcol) * 2));
                    const s16x4 hi = __builtin_amdgcn_ds_read_tr16_b64_v4i16((LAS s16x4*)(lds3 + KI_B + ((32 * ks + 4 + trow) * QS + 16 * (dkt0 + a) + tcol) * 2));
                    kitf[a][ks] = __builtin_shufflevector(lo, hi, 0, 1, 2, 3, 4, 5, 6, 7);
                }
#pragma unroll
                for (int c = 0; c < 2; ++c) {
                    const s16x4 lo = __builtin_amdgcn_ds_read_tr16_b64_v4i16((LAS s16x4*)(lds3 + VR_B + ((32 * ks + trow) * TS + 16 * (dvt0 + c) + tcol) * 2));
                    const s16x4 hi = __builtin_amdgcn_ds_read_tr16_b64_v4i16((LAS s16x4*)(lds3 + VR_B + ((32 * ks + 4 + trow) * TS + 16 * (dvt0 + c) + tcol) * 2));
                    vtf[c][ks] = __builtin_shufflevector(lo, hi, 0, 1, 2, 3, 4, 5, 6, 7);
                }
            }
#pragma unroll
            for (int di = 0; di < 2; ++di) {
                const int dvt = dvt0 + di;
                f32x4 acc = (f32x4){0.f, 0.f, 0.f, 0.f};
#pragma unroll
                for (int ks = 0; ks < 2; ++ks) acc = __builtin_amdgcn_mfma_f32_16x16x32_bf16(vtf[di][ks], scf[ks], acc, 0, 0, 0);
#pragma unroll
                for (int ks = 0; ks < NKS; ++ks) {
                    const bf16x8 a = *(const bf16x8*)(ST + (16 * dvt + fr) * QS + 32 * ks + 8 * fq);
                    acc = __builtin_amdgcn_mfma_f32_16x16x32_bf16(a, qf[ks], acc, 0, 0, 0);
                }
                u32x2 w2; w2.x = cvt_pk_bf16(acc[0], acc[1]); w2.y = cvt_pk_bf16(acc[2], acc[3]);
                *(u32x2*)(O + (size_t)(m0 + 16 * tt + fr) * DM + ocol + 16 * dvt + 4 * fq) = w2;
            }
#pragma unroll
            for (int a = 0; a < NDK; ++a) {
                const f32x4 dv4 = *(const f32x4*)(DVEC + 16 * (dkt0 + a) + 4 * fq);
#pragma unroll
                for (int c = 0; c < 2; ++c) {
#pragma unroll
                    for (int ks = 0; ks < 2; ++ks) S[a * 2 + c] = __builtin_amdgcn_mfma_f32_16x16x32_bf16(kitf[a][ks], vtf[c][ks], S[a * 2 + c], 0, 0, 0);
                    S[a * 2 + c] = S[a * 2 + c] * dv4;
                }
            }
        }
        __syncthreads();
#pragma unroll
        for (int a = 0; a < NDK; ++a)
#pragma unroll
            for (int c = 0; c < 2; ++c) {
                u32x2 w2; w2.x = cvt_pk_bf16(S[a * 2 + c][0], S[a * 2 + c][1]); w2.y = cvt_pk_bf16(S[a * 2 + c][2], S[a * 2 + c][3]);
                *(u32x2*)(ST + (16 * (dvt0 + c) + fr) * QS + 16 * (dkt0 + a) + 4 * fq) = w2;
            }
    }
    __syncthreads();
#undef SCAN_STEP_GEOM
#undef SCAN_ISSUE
#undef SCAN_ISSUE_D
}
__device__ void phase_scan(const Params& p, int l, unsigned char* lds) {
    for (int it = blockIdx.x; it < 256; it += gridDim.x) {
        const int isgla = it & 1, r = it >> 1;
        const int dvs = r & 1, dir = (r >> 1) & 1, h = (r >> 2) & 3, b = r >> 4;
#ifdef SKIP_GLA
        if (isgla) continue;
#endif
#ifdef SKIP_RET
        if (!isgla) continue;
#endif
        if (isgla) scan_item<64, true>(p, l, lds, (LAS unsigned char*)lds, b, h, dir, dvs);
        else scan_item<128, false>(p, l, lds, (LAS unsigned char*)lds, b, h, dir, dvs);
    }
}

#define XB_TMO      128
#define XB_XCNT(j)  (256  + 64 * (j))
#define XB_XSUB(j)  (1280 + 64 * (j))
#define XB_XGEN(j)  (2304 + 64 * (j))
#define XB_TOP      3328
#define XB_TOPGEN   3392
#define XCD_BAR_WORDS 3456
#define XB_SPIN_CAP (1u << 20)
__device__ __forceinline__ unsigned xb_ld(unsigned* p)              { return __hip_atomic_load(p, __ATOMIC_RELAXED, __HIP_MEMORY_SCOPE_AGENT); }
__device__ __forceinline__ unsigned xb_add(unsigned* p, unsigned v) { return __hip_atomic_fetch_add(p, v, __ATOMIC_RELAXED, __HIP_MEMORY_SCOPE_AGENT); }
__device__ __forceinline__ unsigned xb_xcc_id() { return (unsigned)__builtin_amdgcn_s_getreg((3 << 11) | 20) & 0xFu; }
#define XB_SPIN(cond, bar) do { unsigned _sp = 0; while (cond) { __builtin_amdgcn_s_sleep(1); \
    if ((++_sp & 255u) == 0u) { if (xb_ld(&(bar)[XB_TMO])) break; if (_sp > XB_SPIN_CAP) { atomicAdd(&(bar)[XB_TMO], 1u); break; } } } } while (0)
struct XcdBarrier { unsigned* bar; unsigned x; volatile LAS unsigned* st; };
__device__ __forceinline__ XcdBarrier xcd_barrier_post(unsigned* bar, volatile LAS unsigned* st) {
    XcdBarrier b; b.bar = bar; b.x = xb_xcc_id(); b.st = st;
    if (threadIdx.x == 0) (void)xb_add(&bar[XB_XCNT(b.x)], 1u);
    return b;
}
__device__ __forceinline__ void xcd_barrier_complete(unsigned* bar, unsigned x, unsigned& nloc, unsigned& nx) {
    const unsigned G = gridDim.x * gridDim.y * gridDim.z;
    unsigned sum, cnt, mine, sp = 0u;
    for (;;) {
        sum = 0u; cnt = 0u; mine = 0u;
#pragma unroll
        for (unsigned j = 0; j < 16; ++j) { const unsigned c = xb_ld(&bar[XB_XCNT(j)]); sum += c; cnt += (c > 0u) ? 1u : 0u; mine = (j == x) ? c : mine; }
        if (sum == G) break;
        __builtin_amdgcn_s_sleep(1);
        if ((++sp & 255u) == 0u) { if (xb_ld(&bar[XB_TMO])) break; if (sp > XB_SPIN_CAP) { atomicAdd(&bar[XB_TMO], 1u); break; } }
    }
    nloc = mine > 0u ? mine : 1u; nx = cnt > 0u ? cnt : 1u;
}
__device__ __forceinline__ void xcd_barrier(const XcdBarrier& b) {
    asm volatile("s_waitcnt vmcnt(0)" ::: "memory");
    __syncthreads();
    if (threadIdx.x == 0) {
        unsigned* bar = b.bar;
        __builtin_amdgcn_s_waitcnt(0);
        unsigned nloc = b.st[0], nx = b.st[1];
        if (nloc == 0u) { xcd_barrier_complete(bar, b.x, nloc, nx); b.st[0] = nloc; b.st[1] = nx; }
        const unsigned old = xb_add(&bar[XB_XSUB(b.x)], 1u);
        const unsigned gen = old / nloc;
        if (old + 1u == (gen + 1u) * nloc) {
            __builtin_amdgcn_fence(__ATOMIC_RELEASE, "agent");
            asm volatile("s_waitcnt vmcnt(0)" ::: "memory");
            const unsigned og = xb_add(&bar[XB_TOP], 1u);
            const unsigned tg = og / nx;
            if (og + 1u == (tg + 1u) * nx) xb_add(&bar[XB_TOPGEN], 1u);
            else XB_SPIN(xb_ld(&bar[XB_TOPGEN]) == tg, bar);
            __builtin_amdgcn_fence(__ATOMIC_ACQUIRE, "agent");
            xb_add(&bar[XB_XGEN(b.x)], 1u);
            asm volatile("s_waitcnt vmcnt(0)" ::: "memory");
        } else {
            XB_SPIN(xb_ld(&bar[XB_XGEN(b.x)]) == gen, bar);
            __builtin_amdgcn_fence(__ATOMIC_ACQUIRE, "agent");
            asm volatile("s_waitcnt vmcnt(0)" ::: "memory");
        }
    }
    __syncthreads();
}

__global__ void __launch_bounds__(512, 2) fwd_megakernel(Params p) {
    extern __shared__ __attribute__((aligned(16))) unsigned char shm[];
    cg::grid_group grid = cg::this_grid();
    const float* MOD = (const float*)(p.ws + WS_MOD);
    volatile LAS unsigned* xst = (volatile LAS unsigned*)((LAS unsigned char*)shm + 131072);
    if (threadIdx.x == 0) { xst[0] = 0u; xst[1] = 0u; xst[2] = 0u; xst[3] = 0u; }
    __syncthreads();
    const XcdBarrier xbar = xcd_barrier_post((unsigned*)(p.ws + WS_BAR), xst);
    for (int ph = p.ph_lo; ph < p.ph_hi; ++ph) {
        if (ph == 0) phase_prep(p, shm);
        else if (ph == NPHASE - 1) phase_final(p);
        else {
            const int l = (ph - 1) >> 3, sub = (ph - 1) & 7;
            const float* mod_l = MOD + (size_t)l * 9 * 6 * DM;
            const float* xin_lat = l == 0 ? p.x : p.out; const float* xin_ctx = l == 0 ? p.ctx : (const float*)(p.ws + WS_XCTX);
            float* xo_lat = p.out; float* xo_ctx = (float*)(p.ws + WS_XCTX);
            const int mrows = l == 0 ? MTOT : NLAT;
            bf16_t* H = (bf16_t*)(p.ws + WS_H); bf16_t* Pm = (bf16_t*)(p.ws + WS_P);
            pg8::StaticOrder S;
            if (sub == 0) phase_norm(p, xin_lat, xin_ctx, p.norm1_g + l * DM, mod_l, 0, MTOT, l == 1 ? (const float*)(p.ws + WS_SLAB) : nullptr, MOD + 8 * 6 * DM + 5 * DM);
#ifndef NO_G1
            else if (sub == 1) { pg8::Gemm g{H, (const bf16_t*)(p.ws + WS_WIN) + (size_t)l * INWP * DM, MTOT, INWP, DM, DM}; S.init(g.M, g.N, gridDim.x, blockIdx.x);
                EpiP E{Pm}; pg8::gemm_phase(( LAS unsigned char*)shm, g, S, E); }
#endif
#ifndef NO_SCAN
            else if (sub == 2) phase_scan(p, l, shm);
#endif
            else if (sub == 3) phase_merge(p, l, mrows);
#ifndef NO_G2
            else if (sub == 4) { pg8::Gemm g{H, (const bf16_t*)(p.ws + WS_WOUT) + (size_t)l * DM * DM, mrows, DM, DM, DM}; S.init(g.M, g.N, gridDim.x, blockIdx.x);
                EpiRes E{xin_lat, xin_ctx, xo_lat, xo_ctx, mod_l + 2 * DM}; pg8::gemm_phase((LAS unsigned char*)shm, g, S, E);
                if (l == 0) {
                    const int nbusy = (MTOT / 256) * (DM / 256) - 2 * (int)gridDim.x;
                    if (nbusy < 0 || (int)gridDim.x - nbusy < 32) convert_weights(p, shm, NT_LAYER, 2 * NT_LAYER, blockIdx.x, gridDim.x);
                    else if ((int)blockIdx.x >= nbusy) convert_weights(p, shm, NT_LAYER, 2 * NT_LAYER, (int)blockIdx.x - nbusy, (int)gridDim.x - nbusy);
                } }
#endif
            else if (sub == 5) phase_norm(p, xo_lat, xo_ctx, p.norm2_g + l * DM, mod_l, 3 * DM, mrows, nullptr, nullptr);
#ifndef NO_G3
            else if (sub == 6) { pg8::Gemm g{H, (const bf16_t*)(p.ws + WS_W1) + (size_t)l * DFF * DM, mrows, DFF, DM, DM}; S.init(g.M, g.N, gridDim.x, blockIdx.x);
                EpiRelu2 E{Pm}; pg8::gemm_phase((LAS unsigned char*)shm, g, S, E); }
#endif
#ifndef NO_G4
            else if (sub == 7) { pg8::Gemm g{Pm, (const bf16_t*)(p.ws + WS_W2) + (size_t)l * DM * DFF, NLAT, DM, DFF, DFF}; S.init(g.M, g.N, gridDim.x, blockIdx.x);
                EpiRes E{xo_lat, xo_ctx, xo_lat, xo_ctx, mod_l + 5 * DM}; pg8::gemm_phase((LAS unsigned char*)shm, g, S, E);
                if (l == 0) {
                    pg8::Gemm g2{Pm + (size_t)NLAT * DFF, g.Bt, NCTX, DM, DFF / NSPLIT, DFF};
                    pg8::SplitOrder<NSPLIT, DFF / NSPLIT> S2; S2.G = gridDim.x; S2.c = blockIdx.x;
                    EpiSlab E2{(float*)(p.ws + WS_SLAB), NCTX}; pg8::gemm_phase((LAS unsigned char*)shm, g2, S2, E2);
                } }
#endif
        }
        if (ph + 1 < p.ph_hi) {
            if (p.ph_hi > NPHASE) grid.sync();
            xcd_barrier(xbar);
        }
    }
}

extern "C" void kernel_launch(void* const* d_in, const int* in_sizes, int n_in, void* d_out, int out_size, void* d_ws, size_t ws_size, hipStream_t stream) {
    static int grid_blocks = 0;
    if (!grid_blocks) {
        int dev = 0, cus = 0, per_cu = 0;
        hipGetDevice(&dev);
        hipDeviceGetAttribute(&cus, hipDeviceAttributeMultiprocessorCount, dev);
        if (hipFuncSetAttribute((const void*)fwd_megakernel, hipFuncAttributeMaxDynamicSharedMemorySize, LDS_BYTES) != hipSuccess) fprintf(stderr, "hipFuncSetAttribute failed\n");
        if (hipOccupancyMaxActiveBlocksPerMultiprocessor(&per_cu, (const void*)fwd_megakernel, 512, LDS_BYTES) != hipSuccess || per_cu < 1) { fprintf(stderr, "occupancy query: %d\n", per_cu); per_cu = 1; }
        (void)hipGetLastError();
        grid_blocks = cus * per_cu;
        if (ws_size < WS_SLAB + (size_t)NSPLIT * NCTX * DM * 4) fprintf(stderr, "workspace too small: %zu < %zu\n", ws_size, (size_t)WS_END);
    }
    Params p{};
    p.x = (const float*)d_in[0]; p.c = (const float*)d_in[1]; p.ctx = (const float*)d_in[2]; p.c_ctx = (const float*)d_in[3]; p.ada_w = (const float*)d_in[4];
    p.ada_b = (const float*)d_in[5]; p.norm1_g = (const float*)d_in[6]; p.w_in = (const float*)d_in[7]; p.ret_decay = (const float*)d_in[8];
    p.gate_up = (const float*)d_in[9]; p.gate_b = (const float*)d_in[10]; p.gla_norm_g = (const float*)d_in[11]; p.w_out = (const float*)d_in[12];
    p.norm2_g = (const float*)d_in[13]; p.w_mlp1 = (const float*)d_in[14]; p.w_mlp2 = (const float*)d_in[15]; p.final_g = (const float*)d_in[16];
    p.out = (float*)d_out; p.ws = (unsigned char*)d_ws;
    if (hipMemsetAsync((unsigned char*)d_ws + WS_BAR, 0, BAR_BYTES, stream) != hipSuccess) fprintf(stderr, "memset of barrier words failed\n");
#if MULTI
    for (int ph = 0; ph < NPHASE; ++ph) {
        p.ph_lo = ph; p.ph_hi = ph + 1;
        hipLaunchKernelGGL(fwd_megakernel, dim3(grid_blocks), dim3(512), LDS_BYTES, stream, p);
    }
#else
    p.ph_lo = 0; p.ph_hi = NPHASE;
    void* args[] = {&p};
    hipError_t e = hipLaunchCooperativeKernel((const void*)fwd_megakernel, dim3(grid_blocks), dim3(512), args, LDS_BYTES, stream);
    if (e != hipSuccess) fprintf(stderr, "cooperative launch failed: %s (grid %d)\n", hipGetErrorString(e), grid_blocks);
#endif
}
```

```cpp
#include <hip/hip_runtime.h>
#include <hip/hip_cooperative_groups.h>
#include <cstdio>
namespace cg = cooperative_groups;

#ifndef MULTI
#define MULTI 0
#endif

#define LAS __attribute__((address_space(3)))
typedef unsigned short bf16_t;
typedef short bf16x8 __attribute__((ext_vector_type(8)));
typedef short s16x4 __attribute__((ext_vector_type(4)));
typedef float f32x4 __attribute__((ext_vector_type(4)));
typedef unsigned u32x2 __attribute__((ext_vector_type(2)));
typedef unsigned u32x4 __attribute__((ext_vector_type(4)));

constexpr int DM = 1024, NB = 8, SEQ = 4096, CTXL = 256, NLAT = NB * SEQ, NCTX = NB * CTXL, MTOT = NLAT + NCTX;
constexpr int INW = 3616, INWP = 3840, DFF = 4096;
constexpr int NPHASE = 18;
constexpr int LDS_BYTES = 131072 + 16;

constexpr size_t WS_WIN = 0;
constexpr size_t WS_WOUT = WS_WIN + (size_t)2 * INWP * DM * 2;
constexpr size_t WS_W1 = WS_WOUT + (size_t)2 * DM * DM * 2;
constexpr size_t WS_W2 = WS_W1 + (size_t)2 * DFF * DM * 2;
constexpr size_t WS_MOD = WS_W2 + (size_t)2 * DM * DFF * 2;
constexpr size_t WS_TAB = WS_MOD + (size_t)2 * 9 * 6 * DM * 4;
constexpr size_t WS_XCTX = WS_TAB + (size_t)2 * 2048 * 4;
constexpr size_t WS_H = WS_XCTX + (size_t)NCTX * DM * 4;
constexpr size_t WS_P = WS_H + (size_t)MTOT * DM * 2;
constexpr size_t WS_OB = WS_P + (size_t)MTOT * INW * 2;
constexpr size_t WS_END = WS_OB + (size_t)MTOT * DM * 2;
static_assert((size_t)MTOT * DFF * 2 <= WS_END - WS_P, "hmlp alias");
constexpr size_t WS_BAR = WS_END;
constexpr size_t BAR_BYTES = 16384;
constexpr size_t WS_SLAB = WS_BAR + BAR_BYTES;
constexpr int NSPLIT = 8;
static_assert(WS_SLAB + (size_t)NSPLIT * NCTX * DM * 4 <= (size_t)536870912, "ws");

struct Params {
    const float* x; const float* c; const float* ctx; const float* c_ctx; const float* ada_w; const float* ada_b; const float* norm1_g;
    const float* w_in; const float* ret_decay; const float* gate_up; const float* gate_b; const float* gla_norm_g; const float* w_out;
    const float* norm2_g; const float* w_mlp1; const float* w_mlp2; const float* final_g;
    float* out; unsigned char* ws; int ph_lo, ph_hi;
};

typedef float f32x2_t __attribute__((ext_vector_type(2)));
typedef __bf16 bf16x2_t __attribute__((ext_vector_type(2)));
__device__ __forceinline__ unsigned cvt_pk_bf16(float lo, float hi) { f32x2_t v = {lo, hi}; bf16x2_t b = __builtin_convertvector(v, bf16x2_t); return __builtin_bit_cast(unsigned, b); }
__device__ __forceinline__ bf16_t f2bf(float f) { return (bf16_t)(cvt_pk_bf16(f, 0.f) & 0xffffu); }
__device__ __forceinline__ float bf2f(short b) { return __uint_as_float(((unsigned)(unsigned short)b) << 16); }
__device__ __forceinline__ int otid() { int t = threadIdx.x; asm volatile("" : "+v"(t)); return t; }
__device__ __forceinline__ float silu_f(float v) { return v / (1.f + __expf(-v)); }

namespace pg8 {
constexpr int STAGGER_TICKS = 0;
constexpr int BM = 256, BK = 64, HALF = 128, HTB = HALF * BK * 2, STAGE_BYTES = 8 * HTB, NXCD = 8, WGM = 8;
__host__ __device__ __forceinline__ int lds_byte(int r, int c) { const int st = (r >> 4) * 2 + (c >> 5), rr = r & 15, cc = c & 31, ob = rr * 64 + cc * 2; return st * 1024 + (ob ^ (((ob >> 9) & 1) << 5)); }
__host__ __device__ __forceinline__ void stage_rc(int b, int& R, int& C) { const int st = b / 1024, sb = b % 1024, swz = sb ^ (((sb >> 9) & 1) << 5); R = (st >> 1) * 16 + swz / 64; C = (st & 1) * 32 + (swz % 64) / 2; }
__host__ __device__ __forceinline__ int perm32(int rho) { const int n = rho >> 4, i = rho & 15; return 8 * (i >> 2) + 4 * n + (i & 3); }
struct Unit { int pm, pn, kofs, ks; };
struct Gemm { const bf16_t* A; const bf16_t* Bt; int M, N, K, ld; };
struct StaticOrder {
    int nM, nN, nwg, G, c;
    __host__ __device__ void init(int M, int N, int G_, int c_) { nM = M / BM; nN = N / BM; nwg = nM * nN; G = G_; c = c_; }
    __host__ __device__ bool next(int i, Unit& u) const {
        const long L = (long)i * G + c; if (L >= nwg) return false;
        int wgid = (int)L; { const int q = nwg / NXCD, r = nwg % NXCD, xcd = wgid % NXCD, off = wgid / NXCD; wgid = (xcd < r ? xcd * (q + 1) : r * (q + 1) + (xcd - r) * q) + off; }
        const int nig = WGM * nN, gid = wgid / nig, fm = gid * WGM, gsz = (nM - fm) < WGM ? (nM - fm) : WGM;
        u.pm = fm + ((wgid % nig) % gsz); u.pn = (wgid % nig) / gsz; u.kofs = 0; u.ks = 0; return true;
    }
    __device__ __forceinline__ void a_ready(const Unit&) const {}
    __device__ __forceinline__ void done(const Unit&) const {}
};

template <int NS, int KS> struct SplitOrder {
    int G, c;
    __device__ bool next(int i, Unit& u) const {
        const int idx = i * G + c; if (idx >= 32 * NS) return false;
        u.ks = idx % NS; const int t = idx / NS; u.pn = t & 3; u.pm = t >> 2; u.kofs = u.ks * KS * 2; return true;
    }
    __device__ __forceinline__ void a_ready(const Unit&) const {}
    __device__ __forceinline__ void done(const Unit&) const {}
};
template <class Epi, class Sched>
__device__ __forceinline__ void gemm_phase(LAS unsigned char* lds, const Gemm g, const Sched& S, const Epi& E) {
    const int tid = otid(), wid = __builtin_amdgcn_readfirstlane(tid >> 6), lane = tid & 63, wr = wid >> 2, wc = wid & 3, fr = lane & 15, fq = lane >> 4;
    const int K = g.ld, nt = g.K / BK;
    unsigned voffA[2], voffB[2];
#pragma unroll
    for (int i = 0; i < 2; ++i) { int R, C; stage_rc(tid * 16 + i * 8192, R, C); const int Rb = Epi::PERM ? ((R & ~31) + perm32(R & 31)) : R;
        voffA[i] = (unsigned)(R * K + C) * 2u; voffB[i] = (unsigned)(Rb * K + C) * 2u; }
    const size_t kstep = (size_t)(BK * 2);
    const size_t hstep = (size_t)HALF * K * 2;
    const size_t tstep = 2 * hstep;
    const unsigned ldsw = (unsigned)wid * 1024u;
    const int aoff = lds_byte(wr * 64 + fr, fq * 8), boff = lds_byte(wc * 32 + fr, fq * 8);
#define PG8_SA(b, h) (((b) * 2 + (h)) * HTB)
#define PG8_SB(b, h) ((4 + (b) * 2 + (h)) * HTB)
#define PG8_STAGE(bufoff, gbase, voff) do { _Pragma("unroll") for (int _i = 0; _i < 2; ++_i) \
        __builtin_amdgcn_global_load_lds((const unsigned*)((const char*)(gbase) + (voff)[_i]), (LAS unsigned*)(lds + (bufoff) + ldsw + _i * 8192), 16, 0, 0); } while (0)
#define PG8_LDA(dst, b, h) do { _Pragma("unroll") for (int m = 0; m < 4; ++m) _Pragma("unroll") for (int k = 0; k < 2; ++k) dst[m][k] = *(const LAS bf16x8*)(lds + PG8_SA(b, h) + aoff + m * 2048 + k * 1024); } while (0)
#define PG8_LDB(dst, b, h) do { _Pragma("unroll") for (int n = 0; n < 2; ++n) _Pragma("unroll") for (int k = 0; k < 2; ++k) dst[n][k] = *(const LAS bf16x8*)(lds + PG8_SB(b, h) + boff + n * 2048 + k * 1024); } while (0)
#define PG8_MMA(ai, bj, At, Bt) do { __builtin_amdgcn_s_setprio(1); _Pragma("unroll") for (int m = 0; m < 4; ++m) _Pragma("unroll") for (int n = 0; n < 2; ++n) _Pragma("unroll") for (int k = 0; k < 2; ++k) \
        acc[ai][bj][m][n] = __builtin_amdgcn_mfma_f32_16x16x32_bf16(Bt[n][k], At[m][k], acc[ai][bj][m][n], 0, 0, 0); __builtin_amdgcn_s_setprio(0); } while (0)
#define PG8_WAIT_V(n) asm volatile("s_waitcnt vmcnt(" #n ")" ::: "memory")
#define PG8_WAIT_L(n) asm volatile("s_waitcnt lgkmcnt(" #n ")" ::: "memory")
#define PG8_BAR __builtin_amdgcn_s_barrier()
#define PG8_SCHED __builtin_amdgcn_sched_barrier(0)
    Unit cur, nxt; int ui = 0;
    if (!S.next(0, cur)) return;
    if (STAGGER_TICKS > 0 && (blockIdx.x & 1)) {
        const unsigned long long t0 = __builtin_amdgcn_s_memrealtime();
        while (__builtin_amdgcn_s_memrealtime() - t0 < (unsigned long long)STAGGER_TICKS) __builtin_amdgcn_s_sleep(8);
    }
    f32x4 acc[2][2][4][2];
#pragma unroll
    for (int a = 0; a < 2; ++a)
#pragma unroll
        for (int b = 0; b < 2; ++b)
#pragma unroll
            for (int m = 0; m < 4; ++m)
#pragma unroll
                for (int n = 0; n < 2; ++n) acc[a][b][m][n] = (f32x4){0.f, 0.f, 0.f, 0.f};
    bf16x8 At[4][2], B0[2][2], B1[2][2];
    const char* cA = (const char*)g.A + (size_t)cur.pm * tstep + cur.kofs; const char* cB = (const char*)g.Bt + (size_t)cur.pn * tstep + cur.kofs;
    S.a_ready(cur);
    PG8_STAGE(PG8_SB(0, 0), cB, voffB); PG8_STAGE(PG8_SA(0, 0), cA, voffA); PG8_STAGE(PG8_SB(0, 1), cB + hstep, voffB); PG8_STAGE(PG8_SA(0, 1), cA + hstep, voffA);
    if (wr == 1) PG8_BAR;
    PG8_WAIT_V(4); PG8_BAR;
    PG8_STAGE(PG8_SB(1, 0), cB + kstep, voffB); PG8_STAGE(PG8_SA(1, 0), cA + kstep, voffA); PG8_STAGE(PG8_SB(1, 1), cB + hstep + kstep, voffB);
    PG8_WAIT_V(6); PG8_BAR;
    for (;;) {
        const bool has_next = S.next(ui + 1, nxt);
        const char* nA = has_next ? (const char*)g.A + (size_t)nxt.pm * tstep + nxt.kofs : cA; const char* nB = has_next ? (const char*)g.Bt + (size_t)nxt.pn * tstep + nxt.kofs : cB;
        for (int t = 0; t < nt; t += 2) {
            const bool last = (t == nt - 2);
            const char* a1 = cA + (size_t)(t + 1) * kstep;
            const char* a2 = last ? nA : cA + (size_t)(t + 2) * kstep; const char* b2 = last ? nB : cB + (size_t)(t + 2) * kstep;
            const char* a3 = a2 + kstep; const char* b3 = b2 + kstep;
            if (last && has_next) S.a_ready(nxt);
            PG8_LDB(B0, 0, 0); PG8_SCHED; PG8_LDA(At, 0, 0); PG8_STAGE(PG8_SA(1, 1), a1 + hstep, voffA);
            PG8_WAIT_L(8); PG8_BAR; PG8_WAIT_L(0); PG8_MMA(0, 0, At, B0); PG8_BAR; PG8_SCHED;
            PG8_LDB(B1, 0, 1); PG8_STAGE(PG8_SB(0, 0), b2, voffB);
            PG8_BAR; PG8_WAIT_L(0); PG8_MMA(0, 1, At, B1); PG8_BAR;
            PG8_LDA(At, 0, 1); PG8_STAGE(PG8_SA(0, 0), a2, voffA);
            PG8_BAR; PG8_WAIT_L(0); PG8_MMA(1, 0, At, B0); PG8_BAR; PG8_SCHED;
            PG8_STAGE(PG8_SB(0, 1), b2 + hstep, voffB);
            PG8_WAIT_V(6); PG8_BAR; PG8_MMA(1, 1, At, B1); PG8_BAR;
            PG8_LDB(B0, 1, 0); PG8_SCHED; PG8_LDA(At, 1, 0); PG8_STAGE(PG8_SA(0, 1), a2 + hstep, voffA);
            PG8_WAIT_L(8); PG8_BAR; PG8_WAIT_L(0); PG8_MMA(0, 0, At, B0); PG8_BAR; PG8_SCHED;
            PG8_LDB(B1, 1, 1); PG8_STAGE(PG8_SB(1, 0), b3, voffB);
            PG8_BAR; PG8_WAIT_L(0); PG8_MMA(0, 1, At, B1); PG8_BAR;
            PG8_LDA(At, 1, 1); PG8_STAGE(PG8_SA(1, 0), a3, voffA);
            PG8_BAR; PG8_WAIT_L(0); PG8_MMA(1, 0, At, B0); PG8_BAR; PG8_SCHED;
            PG8_STAGE(PG8_SB(1, 1), b3 + hstep, voffB);
            PG8_WAIT_V(6); PG8_BAR; PG8_MMA(1, 1, At, B1); PG8_BAR;
        }
        E(acc, cur, wr, wc, fr, fq);
        if (!has_next) break;
#pragma unroll
        for (int a = 0; a < 2; ++a)
#pragma unroll
            for (int b = 0; b < 2; ++b)
#pragma unroll
                for (int m = 0; m < 4; ++m)
#pragma unroll
                    for (int n = 0; n < 2; ++n) acc[a][b][m][n] = (f32x4){0.f, 0.f, 0.f, 0.f};
        cur = nxt; cA = nA; cB = nB; ++ui;
    }
    PG8_WAIT_V(0);
    if (wr == 0) PG8_BAR;
    PG8_BAR;
#undef PG8_SA
#undef PG8_SB
#undef PG8_STAGE
#undef PG8_LDA
#undef PG8_LDB
#undef PG8_MMA
#undef PG8_WAIT_V
#undef PG8_WAIT_L
#undef PG8_BAR
#undef PG8_SCHED
}
}

struct EpiP {
    static constexpr bool PERM = true;
    bf16_t* P;
    __device__ __forceinline__ void operator()(const f32x4 (&acc)[2][2][4][2], const pg8::Unit& u, int wr, int wc, int fr, int fq) const {
        const int row0 = u.pm * 256 + wr * 64 + fr, col0 = u.pn * 256 + wc * 32 + 8 * fq;
#pragma unroll
        for (int ai = 0; ai < 2; ++ai)
#pragma unroll
            for (int m = 0; m < 4; ++m) { bf16_t* rowp = P + (size_t)(row0 + ai * 128 + m * 16) * INW;
#pragma unroll
                for (int bj = 0; bj < 2; ++bj) { const int c = col0 + bj * 128; const f32x4 v0 = acc[ai][bj][m][0], v1 = acc[ai][bj][m][1];
                    if (c < INW) { u32x4 w4; w4.x = cvt_pk_bf16(v0[0], v0[1]); w4.y = cvt_pk_bf16(v0[2], v0[3]); w4.z = cvt_pk_bf16(v1[0], v1[1]); w4.w = cvt_pk_bf16(v1[2], v1[3]); *(u32x4*)(rowp + c) = w4; } } }
    }
};
struct EpiRelu2 {
    static constexpr bool PERM = true;
    bf16_t* O;
    __device__ __forceinline__ void operator()(const f32x4 (&acc)[2][2][4][2], const pg8::Unit& u, int wr, int wc, int fr, int fq) const {
        const int row0 = u.pm * 256 + wr * 64 + fr, col0 = u.pn * 256 + wc * 32 + 8 * fq;
#pragma unroll
        for (int ai = 0; ai < 2; ++ai)
#pragma unroll
            for (int m = 0; m < 4; ++m) { bf16_t* rowp = O + (size_t)(row0 + ai * 128 + m * 16) * DFF;
#pragma unroll
                for (int bj = 0; bj < 2; ++bj) { const int c = col0 + bj * 128; f32x4 v0 = acc[ai][bj][m][0], v1 = acc[ai][bj][m][1];
#pragma unroll
                    for (int j = 0; j < 4; ++j) { const float r0 = fmaxf(v0[j], 0.f), r1 = fmaxf(v1[j], 0.f); v0[j] = r0 * r0; v1[j] = r1 * r1; }
                    u32x4 w4; w4.x = cvt_pk_bf16(v0[0], v0[1]); w4.y = cvt_pk_bf16(v0[2], v0[3]); w4.z = cvt_pk_bf16(v1[0], v1[1]); w4.w = cvt_pk_bf16(v1[2], v1[3]); *(u32x4*)(rowp + c) = w4; } }
    }
};
struct EpiRes {
    static constexpr bool PERM = false;
    const float* xin_lat; const float* xin_ctx; float* xout_lat; float* xout_ctx; const float* gate;
    __device__ __forceinline__ void operator()(const f32x4 (&acc)[2][2][4][2], const pg8::Unit& u, int wr, int wc, int fr, int fq) const {
        const int row0 = u.pm * 256 + wr * 64 + fr, col0 = u.pn * 256 + wc * 32 + 4 * fq;
        const int rb = u.pm * 256;
        const bool isctx = rb >= NLAT;
        const int bidx = isctx ? 8 : (rb >> 12);
        const float* xi = isctx ? xin_ctx - (size_t)NLAT * DM : xin_lat;
        float* xo = isctx ? xout_ctx - (size_t)NLAT * DM : xout_lat;
        const float* gp = gate + (size_t)bidx * 6 * DM;
        f32x4 gv[2][2];
#pragma unroll
        for (int bj = 0; bj < 2; ++bj)
#pragma unroll
            for (int n = 0; n < 2; ++n) gv[bj][n] = *(const f32x4*)(gp + col0 + bj * 128 + n * 16);
#pragma unroll
        for (int ai = 0; ai < 2; ++ai) {
            f32x4 xv[4][2][2];
#pragma unroll
            for (int m = 0; m < 4; ++m) { const size_t ro = (size_t)(row0 + ai * 128 + m * 16) * DM;
#pragma unroll
                for (int bj = 0; bj < 2; ++bj)
#pragma unroll
                    for (int n = 0; n < 2; ++n) xv[m][bj][n] = *(const f32x4*)(xi + ro + col0 + bj * 128 + n * 16); }
#pragma unroll
            for (int m = 0; m < 4; ++m) { const size_t ro = (size_t)(row0 + ai * 128 + m * 16) * DM;
#pragma unroll
                for (int bj = 0; bj < 2; ++bj)
#pragma unroll
                    for (int n = 0; n < 2; ++n) *(f32x4*)(xo + ro + col0 + bj * 128 + n * 16) = xv[m][bj][n] + gv[bj][n] * acc[ai][bj][m][n]; }
        }
    }
};
struct EpiSlab {
    static constexpr bool PERM = false;
    float* slab; int rows;
    __device__ __forceinline__ void operator()(const f32x4 (&acc)[2][2][4][2], const pg8::Unit& u, int wr, int wc, int fr, int fq) const {
        const int row0 = u.pm * 256 + wr * 64 + fr, col0 = u.pn * 256 + wc * 32 + 4 * fq;
        float* base = slab + (size_t)u.ks * rows * DM;
#pragma unroll
        for (int ai = 0; ai < 2; ++ai)
#pragma unroll
            for (int m = 0; m < 4; ++m) { float* rowp = base + (size_t)(row0 + ai * 128 + m * 16) * DM + col0;
#pragma unroll
                for (int bj = 0; bj < 2; ++bj)
#pragma unroll
                    for (int n = 0; n < 2; ++n) *(f32x4*)(rowp + bj * 128 + n * 16) = acc[ai][bj][m][n]; }
    }
};

struct TileDesc { const float* src; bf16_t* dst; int K, N, k0, n0; };
__device__ __forceinline__ TileDesc tile_desc(const Params& p, int t) {
    constexpr int T_IN = 16 * 60, T_OUT = 16 * 16, T_1 = 16 * 64, T_2 = 64 * 16, T_L = T_IN + T_OUT + T_1 + T_2;
    const int l = t / T_L; int r = t % T_L; TileDesc d;
    if (r < T_IN) { d.src = p.w_in + (size_t)l * DM * INW; d.K = DM; d.N = INW; d.dst = (bf16_t*)(p.ws + WS_WIN) + (size_t)l * INWP * DM; d.k0 = (r / 60) * 64; d.n0 = (r % 60) * 64; }
    else if ((r -= T_IN) < T_OUT) { d.src = p.w_out + (size_t)l * DM * DM; d.K = DM; d.N = DM; d.dst = (bf16_t*)(p.ws + WS_WOUT) + (size_t)l * DM * DM; d.k0 = (r / 16) * 64; d.n0 = (r % 16) * 64; }
    else if ((r -= T_OUT) < T_1) { d.src = p.w_mlp1 + (size_t)l * DM * DFF; d.K = DM; d.N = DFF; d.dst = (bf16_t*)(p.ws + WS_W1) + (size_t)l * DFF * DM; d.k0 = (r / 64) * 64; d.n0 = (r % 64) * 64; }
    else { r -= T_1; d.src = p.w_mlp2 + (size_t)l * DFF * DM; d.K = DFF; d.N = DM; d.dst = (bf16_t*)(p.ws + WS_W2) + (size_t)l * DM * DFF; d.k0 = (r / 16) * 64; d.n0 = (r % 16) * 64; }
    return d;
}
__device__ __forceinline__ void tile_load(const TileDesc& d, int tid, f32x4 (&v)[2]) {
    const int r = tid >> 4, n = d.n0 + 4 * (tid & 15); const bool in = n < d.N; const int nc = in ? n : 0;
#pragma unroll
    for (int i = 0; i < 2; ++i) { const f32x4 t = *(const f32x4*)(d.src + (size_t)(d.k0 + r + 32 * i) * d.N + nc); v[i] = in ? t : (f32x4){0.f, 0.f, 0.f, 0.f}; }
}
__device__ __forceinline__ void tile_put(const f32x4 (&v)[2], int tid, float* tile) {
    const int r = tid >> 4, c = 4 * (tid & 15);
#pragma unroll
    for (int i = 0; i < 2; ++i)
#pragma unroll
        for (int j = 0; j < 4; ++j) tile[(r + 32 * i) * 65 + c + j] = v[i][j];
}
__device__ __forceinline__ void tile_store(const TileDesc& d, int tid, const float* tile) {
    const int n = tid >> 3, kg = tid & 7; float f[8];
#pragma unroll
    for (int j = 0; j < 8; ++j) f[j] = tile[(8 * kg + j) * 65 + n];
    u32x4 o; o.x = cvt_pk_bf16(f[0], f[1]); o.y = cvt_pk_bf16(f[2], f[3]); o.z = cvt_pk_bf16(f[4], f[5]); o.w = cvt_pk_bf16(f[6], f[7]);
    *(u32x4*)(d.dst + (size_t)(d.n0 + n) * d.K + d.k0 + 8 * kg) = o;
}
constexpr int NT_LAYER = 16 * 60 + 16 * 16 + 16 * 64 + 64 * 16;
constexpr int NT_EARLY = 16 * 60 + 16 * 16;
__device__ void convert_weights(const Params& p, unsigned char* lds, int t_lo, int t_hi, int rank, int nranks) {
    float* tile = (float*)lds; float* tile2 = tile + 64 * 65 + 32;
    const int tid = otid();
    for (int t = t_lo + rank; t < t_hi; t += 2 * nranks) {
        const int t2 = t + nranks; const bool has2 = t2 < t_hi;
        const TileDesc da = tile_desc(p, t), db = tile_desc(p, has2 ? t2 : t);
        f32x4 va[2], vb[2];
        tile_load(da, tid, va); tile_load(db, tid, vb);
        tile_put(va, tid, tile); tile_put(vb, tid, tile2);
        __syncthreads();
        tile_store(da, tid, tile); if (has2) tile_store(db, tid, tile2);
        __syncthreads();
    }
}
__device__ void phase_prep(const Params& p, unsigned char* lds) {
    float* tile = (float*)lds; float* tile2 = tile + 64 * 65 + 32;
    const int tid = otid();
    convert_weights(p, lds, 0, NT_EARLY, blockIdx.x, gridDim.x);
    float* red = (float*)lds;
    float* scv = red + 8 * 9 * 64;
    const int w = tid >> 6, lane = tid & 63;
    if (blockIdx.x < 2 * 96) {
        __syncthreads();
        for (int i = tid; i < 9 * DM; i += 512) { const float cv = (i < 8 * DM) ? p.c[i] : p.c_ctx[i - 8 * DM]; scv[i] = silu_f(cv); }
        __syncthreads();
    }
    for (int it = blockIdx.x; it < 2 * 96; it += gridDim.x) {
        const int l = it / 96, j0 = (it % 96) * 64;
        f32x4 a[9];
#pragma unroll
        for (int r = 0; r < 9; ++r) a[r] = (f32x4){0.f, 0.f, 0.f, 0.f};
        const int cg = lane & 15, kq = lane >> 4;
        const float* wp = p.ada_w + (size_t)l * DM * 6 * DM + (size_t)(w * 128 + kq) * 6 * DM + j0 + 4 * cg;
        for (int kk0 = 0; kk0 < 32; kk0 += 8) {
            f32x4 wv[8];
#pragma unroll
            for (int u = 0; u < 8; ++u) wv[u] = *(const f32x4*)(wp + (size_t)(kk0 + u) * 4 * 6 * DM);
            asm volatile("" ::: "memory");
#pragma unroll
            for (int u = 0; u < 8; ++u) { const int k = w * 128 + 4 * (kk0 + u) + kq;
#pragma unroll
                for (int r = 0; r < 9; ++r) a[r] += wv[u] * scv[r * DM + k]; }
        }
#pragma unroll
        for (int r = 0; r < 9; ++r)
#pragma unroll
            for (int c = 0; c < 4; ++c) { float t = a[r][c]; t += __shfl_xor(t, 16); t += __shfl_xor(t, 32); a[r][c] = t; }
        __syncthreads();
        if (kq == 0) {
#pragma unroll
            for (int r = 0; r < 9; ++r) *(f32x4*)(red + (w * 9 + r) * 64 + 4 * cg) = a[r];
        }
        __syncthreads();
        for (int idx = tid; idx < 9 * 64; idx += 512) { const int r = idx >> 6, ln = idx & 63; float sacc = 0.f;
#pragma unroll
            for (int ww = 0; ww < 8; ++ww) sacc += red[(ww * 9 + r) * 64 + ln];
            ((float*)(p.ws + WS_MOD))[((size_t)l * 9 + r) * 6 * DM + j0 + ln] = sacc + p.ada_b[(size_t)l * 6 * DM + j0 + ln]; }
    }
    if (blockIdx.x == gridDim.x - 1) {
        float* tab = (float*)(p.ws + WS_TAB);
        for (int idx = tid; idx < 2048; idx += 512) { const int pos = idx >> 5, i = idx & 31; const float inv = powf(10000.0f, -(float)i / 32.0f); const float ang = (float)pos * inv;
            tab[idx] = cosf(ang); tab[2048 + idx] = sinf(ang); }
    }
    __syncthreads();
}

__device__ __forceinline__ const float* xrow(const float* lat, const float* ctx, int m) { return m < NLAT ? lat + (size_t)m * DM : ctx + (size_t)(m - NLAT) * DM; }
__device__ void phase_norm(const Params& p, const float* xl, const float* xc, const float* g, const float* mod_l, int sh_off, int nrows,
                           const float* slab, const float* slab_gate) {
    const int tid_ = otid(); const int lane = tid_ & 63, gw = blockIdx.x * 8 + (tid_ >> 6), nw = gridDim.x * 8;
    bf16_t* H = (bf16_t*)(p.ws + WS_H);
    f32x4 nv[4], gg4[4];
#pragma unroll
    for (int i = 0; i < 4; ++i) { nv[i] = (f32x4){0.f, 0.f, 0.f, 0.f}; gg4[i] = *(const f32x4*)(g + 4 * lane + 256 * i); }
    if (gw < nrows) { const float* xr = xrow(xl, xc, gw);
#pragma unroll
        for (int i = 0; i < 4; ++i) nv[i] = *(const f32x4*)(xr + 4 * lane + 256 * i); }
    for (int m = gw; m < nrows; m += nw) {
        const int b = m < NLAT ? (m >> 12) : 8;
        const float* sh = mod_l + (size_t)b * 6 * DM + sh_off; const float* sc = sh + DM;
        f32x4 v[4]; float ss = 0.f;
#pragma unroll
        for (int i = 0; i < 4; ++i) v[i] = nv[i];
        if (m + nw < nrows) { const float* xr = xrow(xl, xc, m + nw);
#pragma unroll
            for (int i = 0; i < 4; ++i) nv[i] = *(const f32x4*)(xr + 4 * lane + 256 * i); }
        f32x4 sc4[4], sh4[4];
#pragma unroll
        for (int i = 0; i < 4; ++i) { sc4[i] = *(const f32x4*)(sc + 4 * lane + 256 * i); sh4[i] = *(const f32x4*)(sh + 4 * lane + 256 * i); }
        asm volatile("" ::: "memory");
#pragma unroll
        for (int i = 0; i < 4; ++i) {
            if (slab != nullptr && m >= NLAT) {
                f32x4 sl[NSPLIT];
#pragma unroll
                for (int ks = 0; ks < NSPLIT; ++ks) sl[ks] = *(const f32x4*)(slab + ((size_t)ks * NCTX + (m - NLAT)) * DM + 4 * lane + 256 * i);
                const f32x4 acc4 = ((sl[0] + sl[1]) + (sl[2] + sl[3])) + ((sl[4] + sl[5]) + (sl[6] + sl[7]));
                v[i] += *(const f32x4*)(slab_gate + 4 * lane + 256 * i) * acc4;
            }
            ss += v[i][0] * v[i][0] + v[i][1] * v[i][1] + v[i][2] * v[i][2] + v[i][3] * v[i][3]; }
#pragma unroll
        for (int o = 32; o >= 1; o >>= 1) ss += __shfl_xor(ss, o);
        const float rinv = rsqrtf(ss * (1.0f / DM) + 1e-6f);
#pragma unroll
        for (int i = 0; i < 4; ++i) { const int c = 4 * lane + 256 * i; const f32x4 gg = gg4[i], s1 = sc4[i], s0 = sh4[i];
            f32x4 y;
#pragma unroll
            for (int j = 0; j < 4; ++j) y[j] = (v[i][j] * rinv * gg[j]) * (1.f + s1[j]) + s0[j];
            u32x2 w2; w2.x = cvt_pk_bf16(y[0], y[1]); w2.y = cvt_pk_bf16(y[2], y[3]); *(u32x2*)(H + (size_t)m * DM + c) = w2; }
    }
}
__device__ void phase_final(const Params& p) {
    const int tid_ = otid(); const int lane = tid_ & 63, gw = blockIdx.x * 8 + (tid_ >> 6), nw = gridDim.x * 8;
    f32x4 nv[4], gg4[4];
#pragma unroll
    for (int i = 0; i < 4; ++i) { nv[i] = (f32x4){0.f, 0.f, 0.f, 0.f}; gg4[i] = *(const f32x4*)(p.final_g + 4 * lane + 256 * i); }
    if (gw < NLAT) {
#pragma unroll
        for (int i = 0; i < 4; ++i) nv[i] = *(const f32x4*)(p.out + (size_t)gw * DM + 4 * lane + 256 * i); }
    for (int m = gw; m < NLAT; m += nw) {
        float* xr = p.out + (size_t)m * DM;
        f32x4 v[4]; float ss = 0.f;
#pragma unroll
        for (int i = 0; i < 4; ++i) v[i] = nv[i];
        if (m + nw < NLAT) {
#pragma unroll
            for (int i = 0; i < 4; ++i) nv[i] = *(const f32x4*)(p.out + (size_t)(m + nw) * DM + 4 * lane + 256 * i); }
        asm volatile("" ::: "memory");
#pragma unroll
        for (int i = 0; i < 4; ++i) ss += v[i][0] * v[i][0] + v[i][1] * v[i][1] + v[i][2] * v[i][2] + v[i][3] * v[i][3];
#pragma unroll
        for (int o = 32; o >= 1; o >>= 1) ss += __shfl_xor(ss, o);
        const float rinv = rsqrtf(ss * (1.0f / DM) + 1e-6f);
#pragma unroll
        for (int i = 0; i < 4; ++i) { const int c = 4 * lane + 256 * i;
            f32x4 y;
#pragma unroll
            for (int j = 0; j < 4; ++j) y[j] = v[i][j] * rinv * gg4[i][j];
            *(f32x4*)(xr + c) = y; }
    }
}

__device__ void phase_merge(const Params& p, int l, int nrows) {
    const int tid_ = otid(); const int lane = tid_ & 63, gw = blockIdx.x * 8 + (tid_ >> 6), nw = gridDim.x * 8;
    bf16_t* H = (bf16_t*)(p.ws + WS_H); const bf16_t* OB = (const bf16_t*)(p.ws + WS_OB); const bf16_t* P = (const bf16_t*)(p.ws + WS_P);
    const bool isgla = lane >= 32;
    const int gcol = isgla ? (2560 + 16 * lane) : (1536 + 16 * lane);
    const float* gnp = p.gla_norm_g + l * 128 + ((16 * lane) & 127);
    float gn[16];
#pragma unroll
    for (int j = 0; j < 16; ++j) gn[j] = gnp[j];
    bf16x8 nf0, nf1, nb0, nb1, ng0, ng1;
    nf0 = nf1 = nb0 = nb1 = ng0 = ng1 = (bf16x8){0, 0, 0, 0, 0, 0, 0, 0};
#define MERGE_LOAD(mm) do { nf0 = *(const bf16x8*)(H + (size_t)(mm) * DM + 16 * lane); nf1 = *(const bf16x8*)(H + (size_t)(mm) * DM + 16 * lane + 8); \
        nb0 = *(const bf16x8*)(OB + (size_t)(mm) * DM + 16 * lane); nb1 = *(const bf16x8*)(OB + (size_t)(mm) * DM + 16 * lane + 8); \
        ng0 = *(const bf16x8*)(P + (size_t)(mm) * INW + gcol); ng1 = *(const bf16x8*)(P + (size_t)(mm) * INW + gcol + 8); } while (0)
    if (gw < nrows) MERGE_LOAD(gw);
    for (int m = gw; m < nrows; m += nw) {
        const bf16x8 f0 = nf0, f1 = nf1, b0 = nb0, b1 = nb1, g0 = ng0, g1 = ng1;
        if (m + nw < nrows) MERGE_LOAD(m + nw);
        asm volatile("" ::: "memory");
        float r[16]; float s1 = 0.f, s2 = 0.f;
#pragma unroll
        for (int j = 0; j < 8; ++j) { r[j] = bf2f(f0[j]) + bf2f(b0[j]); r[8 + j] = bf2f(f1[j]) + bf2f(b1[j]); }
#ifdef SANITIZE
#pragma unroll
        for (int j = 0; j < 16; ++j) { if (!(fabsf(r[j]) < 1e30f)) r[j] = 0.f; }
#endif
#ifdef SKIP_GLA
        if (isgla) {
#pragma unroll
            for (int j = 0; j < 16; ++j) r[j] = 0.f; }
#endif
#ifdef SKIP_RET
        if (!isgla) {
#pragma unroll
            for (int j = 0; j < 16; ++j) r[j] = 0.f; }
#endif
#pragma unroll
        for (int j = 0; j < 16; ++j) { s1 += r[j]; s2 += r[j] * r[j]; }
#pragma unroll
        for (int o = 1; o <= 4; o <<= 1) { s1 += __shfl_xor(s1, o); s2 += __shfl_xor(s2, o); }
        float y[16];
        if (!isgla) {
            const float mu = s1 * (1.f / 128.f); float sv = 0.f;
#pragma unroll
            for (int j = 0; j < 16; ++j) { const float d = r[j] - mu; sv += d * d; }
#pragma unroll
            for (int o = 1; o <= 4; o <<= 1) sv += __shfl_xor(sv, o);
            const float rs = rsqrtf(sv * (1.f / 128.f) + 1e-6f);
#pragma unroll
            for (int j = 0; j < 16; ++j) y[j] = (r[j] - mu) * rs;
        } else {
            float sv = 0.f;
#pragma unroll
            for (int o = 1; o <= 4; o <<= 1) sv += __shfl_xor(sv, o);
            const float rs = rsqrtf(s2 * (1.f / 128.f) + 1e-6f);
#pragma unroll
            for (int j = 0; j < 16; ++j) y[j] = r[j] * rs * gn[j] + 0.f * sv;
        }
        u32x4 o0, o1;
#pragma unroll
        for (int j = 0; j < 8; ++j) { y[j] *= silu_f(bf2f(g0[j])); y[8 + j] *= silu_f(bf2f(g1[j])); }
        o0.x = cvt_pk_bf16(y[0], y[1]); o0.y = cvt_pk_bf16(y[2], y[3]); o0.z = cvt_pk_bf16(y[4], y[5]); o0.w = cvt_pk_bf16(y[6], y[7]);
        o1.x = cvt_pk_bf16(y[8], y[9]); o1.y = cvt_pk_bf16(y[10], y[11]); o1.z = cvt_pk_bf16(y[12], y[13]); o1.w = cvt_pk_bf16(y[14], y[15]);
        *(u32x4*)(H + (size_t)m * DM + 16 * lane) = o0; *(u32x4*)(H + (size_t)m * DM + 16 * lane + 8) = o1;
    }
}

#undef MERGE_LOAD
template <int DK, bool GLA>
__device__ __forceinline__ void scan_item(const Params& p, int l, unsigned char* lds, LAS unsigned char* lds3, int b, int h, int dir, int dvs) {
    constexpr int QS = DK + 8, TS = 72, NT = DK / 32, NKS = DK / 32;
    bf16_t* QD = (bf16_t*)lds;
    bf16_t* KI = QD + 64 * QS;
    bf16_t* ST = KI + 64 * QS;
    bf16_t* VR = ST + 64 * QS;
    bf16_t* SC = VR + 64 * TS;
    constexpr int KI_B = 64 * QS * 2, VR_B = 3 * 64 * QS * 2;
    float* DVEC = (float*)(SC + 64 * TS);
    float* CL = DVEC + DK;
    float* CUM = CL + DK;
    float* UP = CUM + 2 * 64 * 68;
    const int tid = otid(), lane = tid & 63, w = __builtin_amdgcn_readfirstlane(tid >> 6), fr = lane & 15, fq = lane >> 4;
    const bf16_t* P = (const bf16_t*)(p.ws + WS_P);
    bf16_t* O = (bf16_t*)(p.ws + (dir ? WS_OB : WS_H));
    const float* TABC = (const float*)(p.ws + WS_TAB); const float* TABS = TABC + 2048;
    const int ocol = (GLA ? 512 : 0) + 128 * h + 64 * dvs;
    const int qcol = GLA ? 2048 + 64 * h : 128 * h, kcol = GLA ? 2304 + 64 * h : 512 + 128 * h, vcol = (GLA ? 2560 : 1024) + 128 * h + 64 * dvs;
    float g = 0.f;
    if (!GLA) g = log1pf(-__expf(p.ret_decay[l * 8 + dir * 4 + h]));
    constexpr int NDK = DK / 64;
    const int dkt0 = NDK * (w >> 1), dvt0 = 2 * (w & 1);
    f32x4 S[NT];
#pragma unroll
    for (int i = 0; i < NT; ++i) S[i] = (f32x4){0.f, 0.f, 0.f, 0.f};
    __syncthreads();
    for (int i = tid; i < 64 * QS / 2; i += 512) ((unsigned*)ST)[i] = 0u;
    bf16x8 uph[2], upl[2]; float ubv[2];
    uph[0] = uph[1] = upl[0] = upl[1] = (bf16x8){0, 0, 0, 0, 0, 0, 0, 0}; ubv[0] = ubv[1] = 0.f;
    float* TT = UP;
    if (GLA) {
#pragma unroll
        for (int ci = 0; ci < 2; ++ci) {
            const int ch = 16 * (2 * (w & 1) + ci) + fr;
#pragma unroll
            for (int j = 0; j < 8; ++j) {
                const float val = (fq < 2) ? p.gate_up[((size_t)(l * 2 + dir) * 16 + 8 * fq + j) * 256 + 64 * h + ch] : 0.f;
                const bf16_t hi = f2bf(val); const float rem = val - bf2f((short)hi);
                uph[ci][j] = (short)hi; upl[ci][j] = (short)f2bf(rem);
            }
            ubv[ci] = p.gate_b[(l * 2 + dir) * 256 + 64 * h + ch];
        }
    } else {
        if (tid < DK) DVEC[tid] = __expf(64.f * g);
    }
    __syncthreads();
    const int s_a = tid >> 3, pr = tid & 7, c8a = (pr & 3) + 8 * (pr >> 2), c8g = tid & 7;
    bf16x8 nq1, nq2, nk1, nk2, nv1, nd0, nd1; f32x4 nc0, nc1, ns0, ns1;
    nq2 = nq1 = nk1 = nk2 = nv1 = nd0 = nd1 = (bf16x8){0, 0, 0, 0, 0, 0, 0, 0}; nc0 = nc1 = ns0 = ns1 = (f32x4){0.f, 0.f, 0.f, 0.f};
#define SCAN_STEP_GEOM(stp, isctx_, chunk_, m0_) \
    const bool isctx_ = (stp) < 4; \
    const int chunk_ = dir == 0 ? (isctx_ ? (stp) : (stp) - 4) : (isctx_ ? 3 - (stp) : 67 - (stp)); \
    const int m0_ = isctx_ ? (NLAT + b * CTXL + chunk_ * 64) : (b * SEQ + chunk_ * 64);
#define SCAN_ISSUE(stp) do { SCAN_STEP_GEOM(stp, ic_, ch_, mm_) \
        const bf16_t* rp_ = P + (size_t)(mm_ + s_a) * INW; \
        if (GLA) { \
            nq1 = *(const bf16x8*)(rp_ + qcol + 8 * c8g); nk1 = *(const bf16x8*)(rp_ + kcol + 8 * c8g); } \
        else { nq1 = *(const bf16x8*)(rp_ + qcol + 8 * c8a); nq2 = *(const bf16x8*)(rp_ + qcol + 8 * (c8a + 4)); \
            nk1 = *(const bf16x8*)(rp_ + kcol + 8 * c8a); nk2 = *(const bf16x8*)(rp_ + kcol + 8 * (c8a + 4)); \
            const int pos_ = ic_ ? 0 : ((pr >> 2) ? s_a : ch_); \
            nc0 = *(const f32x4*)(TABC + pos_ * 32 + 8 * (pr & 3)); nc1 = *(const f32x4*)(TABC + pos_ * 32 + 8 * (pr & 3) + 4); \
            ns0 = *(const f32x4*)(TABS + pos_ * 32 + 8 * (pr & 3)); ns1 = *(const f32x4*)(TABS + pos_ * 32 + 8 * (pr & 3) + 4); } \
        nv1 = *(const bf16x8*)(rp_ + vcol + 8 * c8g); } while (0)
#define SCAN_ISSUE_D(stp) do { SCAN_STEP_GEOM(stp, icd_, chd_, mmd_) (void)chd_; \
        if (GLA && fq < 2) { const bf16_t* dp_ = P + (size_t)(mmd_ + 16 * (w >> 1) + fr) * INW + 3584 + 16 * dir + 8 * fq; nd0 = *(const bf16x8*)dp_; } } while (0)
    auto gate_stage = [&](const bf16x8 dfrag, float* CUMb, float* TTb) {
        const int st = w >> 1;
#pragma unroll
        for (int ci = 0; ci < 2; ++ci) {
            const int ch = 16 * (2 * (w & 1) + ci) + fr;
            f32x4 z = __builtin_amdgcn_mfma_f32_16x16x32_bf16(dfrag, uph[ci], (f32x4){0.f, 0.f, 0.f, 0.f}, 0, 0, 0);
            z = __builtin_amdgcn_mfma_f32_16x16x32_bf16(dfrag, upl[ci], z, 0, 0, 0);
            float la[4], pz[4];
#pragma unroll
            for (int r = 0; r < 4; ++r) { const float zz = z[r] + ubv[ci]; la[r] = (fminf(zz, 0.f) - __logf(1.f + __expf(-fabsf(zz)))) * (1.0f / 16.0f); }
            float T, ex = 0.f;
            if (dir == 0) {
                pz[0] = la[0]; pz[1] = pz[0] + la[1]; pz[2] = pz[1] + la[2]; pz[3] = pz[2] + la[3]; T = pz[3];
                const float t1 = __shfl_up(T, 16), t2 = __shfl_up(T, 32), t3 = __shfl_up(T, 48);
                if (fq >= 1) ex += t1; if (fq >= 2) ex += t2; if (fq >= 3) ex += t3;
            } else {
                pz[3] = la[3]; pz[2] = pz[3] + la[2]; pz[1] = pz[2] + la[1]; pz[0] = pz[1] + la[0]; T = pz[0];
                const float t1 = __shfl_down(T, 16), t2 = __shfl_down(T, 32), t3 = __shfl_down(T, 48);
                if (fq <= 2) ex += t1; if (fq <= 1) ex += t2; if (fq == 0) ex += t3;
            }
            const float ttot = __shfl(T + ex, dir == 0 ? 48 + fr : fr);
#pragma unroll
            for (int r = 0; r < 4; ++r) CUMb[(16 * st + 4 * fq + r) * 68 + ch] = pz[r] + ex;
            if (fq == 0) TTb[st * 64 + ch] = ttot;
        }
    };
    SCAN_ISSUE(0);
    if (GLA) {
        SCAN_ISSUE_D(0);
        const bf16x8 dfirst = nd0;
        SCAN_ISSUE_D(1);
        gate_stage(dfirst, CUM, TT);
        __syncthreads();
    }
    for (int step = 0; step < 68; ++step) {
        SCAN_STEP_GEOM(step, isctx, chunk, m0)
        const bf16x8 q1 = nq1, q2 = nq2, k1 = nk1, k2 = nk2, v1 = nv1, d0 = nd0, d1 = nd1; const f32x4 tc0 = nc0, tc1 = nc1, ts0 = ns0, ts1 = ns1;
        { const int nstep = step + 1 < 68 ? step + 1 : 67; SCAN_ISSUE(nstep); }
        if (GLA) { const int dstep = step + 2 < 68 ? step + 2 : 67; SCAN_ISSUE_D(dstep); }
        (void)chunk; (void)d1;
        float* CUMc = CUM + (step & 1) * 64 * 68; float* TTc = TT + (step & 1) * 256;
        {
            const int s = s_a;
            if (!GLA) {
                const float cum = dir == 0 ? g * (float)(s + 1) : g * (float)(64 - s), cl = 64.f * g;
                const float eq = __expf(cum) * 0.08838834764831845f, eki = __expf(-cum); (void)cl;
                float cs[8], sn[8];
#pragma unroll
                for (int j = 0; j < 4; ++j) { cs[j] = isctx ? 1.f : tc0[j]; cs[4 + j] = isctx ? 1.f : tc1[j]; sn[j] = isctx ? 0.f : ts0[j]; sn[4 + j] = isctx ? 0.f : ts1[j]; }
                float qa[8], qb[8], ka[8], kb[8];
#pragma unroll
                for (int j = 0; j < 8; ++j) {
                    const float a1 = bf2f(q1[j]), a2 = bf2f(q2[j]), b1 = bf2f(k1[j]), b2 = bf2f(k2[j]);
                    qa[j] = a1 * cs[j] - a2 * sn[j]; qb[j] = a1 * sn[j] + a2 * cs[j];
                    ka[j] = b1 * cs[j] - b2 * sn[j]; kb[j] = b1 * sn[j] + b2 * cs[j];
                }
                u32x4 o;
                o.x = cvt_pk_bf16(qa[0] * eq, qa[1] * eq); o.y = cvt_pk_bf16(qa[2] * eq, qa[3] * eq); o.z = cvt_pk_bf16(qa[4] * eq, qa[5] * eq); o.w = cvt_pk_bf16(qa[6] * eq, qa[7] * eq);
                *(u32x4*)(QD + s * QS + 8 * c8a) = o;
                o.x = cvt_pk_bf16(qb[0] * eq, qb[1] * eq); o.y = cvt_pk_bf16(qb[2] * eq, qb[3] * eq); o.z = cvt_pk_bf16(qb[4] * eq, qb[5] * eq); o.w = cvt_pk_bf16(qb[6] * eq, qb[7] * eq);
                *(u32x4*)(QD + s * QS + 8 * (c8a + 4)) = o;
                o.x = cvt_pk_bf16(ka[0] * eki, ka[1] * eki); o.y = cvt_pk_bf16(ka[2] * eki, ka[3] * eki); o.z = cvt_pk_bf16(ka[4] * eki, ka[5] * eki); o.w = cvt_pk_bf16(ka[6] * eki, ka[7] * eki);
                *(u32x4*)(KI + s * QS + 8 * c8a) = o;
                o.x = cvt_pk_bf16(kb[0] * eki, kb[1] * eki); o.y = cvt_pk_bf16(kb[2] * eki, kb[3] * eki); o.z = cvt_pk_bf16(kb[4] * eki, kb[5] * eki); o.w = cvt_pk_bf16(kb[6] * eki, kb[7] * eki);
                *(u32x4*)(KI + s * QS + 8 * (c8a + 4)) = o;
            } else {
                const int c8 = c8g;
                f32x4 cu0 = *(const f32x4*)(CUMc + s * 68 + 8 * c8), cu1 = *(const f32x4*)(CUMc + s * 68 + 8 * c8 + 4);
                {
                    const int stile = w >> 1;
#pragma unroll
                    for (int t4 = 0; t4 < 4; ++t4) {
                        const bool inc = dir == 0 ? (t4 < stile) : (t4 > stile);
                        if (inc) { cu0 += *(const f32x4*)(TTc + t4 * 64 + 8 * c8); cu1 += *(const f32x4*)(TTc + t4 * 64 + 8 * c8 + 4); }
                    }
                }
                if (s == 0) {
                    f32x4 cl0 = (f32x4){0.f, 0.f, 0.f, 0.f}, cl1 = cl0;
#pragma unroll
                    for (int t4 = 0; t4 < 4; ++t4) { cl0 += *(const f32x4*)(TTc + t4 * 64 + 8 * c8); cl1 += *(const f32x4*)(TTc + t4 * 64 + 8 * c8 + 4); }
#pragma unroll
                    for (int j = 0; j < 4; ++j) { DVEC[8 * c8 + j] = __expf(cl0[j]); DVEC[8 * c8 + 4 + j] = __expf(cl1[j]); }
                }
                float qd[8], ki[8];
#pragma unroll
                for (int j = 0; j < 8; ++j) {
                    const float cu = j < 4 ? cu0[j & 3] : cu1[j & 3];
                    const float e = __expf(cu);
                    qd[j] = bf2f(q1[j]) * (0.125f * e); ki[j] = bf2f(k1[j]) * __builtin_amdgcn_rcpf(e);
                }
                u32x4 o;
                o.x = cvt_pk_bf16(qd[0], qd[1]); o.y = cvt_pk_bf16(qd[2], qd[3]); o.z = cvt_pk_bf16(qd[4], qd[5]); o.w = cvt_pk_bf16(qd[6], qd[7]);
                *(u32x4*)(QD + s * QS + 8 * c8) = o;
                o.x = cvt_pk_bf16(ki[0], ki[1]); o.y = cvt_pk_bf16(ki[2], ki[3]); o.z = cvt_pk_bf16(ki[4], ki[5]); o.w = cvt_pk_bf16(ki[6], ki[7]);
                *(u32x4*)(KI + s * QS + 8 * c8) = o;
            }
            *(bf16x8*)(VR + s * TS + 8 * c8g) = v1;
        }
        __syncthreads();
        bf16x8 qf[NKS];
        {
            const int tt = w >> 1;
#pragma unroll
            for (int ks = 0; ks < NKS; ++ks) qf[ks] = *(const bf16x8*)(QD + (16 * tt + fr) * QS + 32 * ks + 8 * fq);
#pragma unroll
            for (int si = 0; si < 2; ++si) {
                const int st = 2 * (w & 1) + si;
                f32x4 acc = (f32x4){0.f, 0.f, 0.f, 0.f};
#pragma unroll
                for (int ks = 0; ks < NKS; ++ks) {
                    const bf16x8 a = *(const bf16x8*)(KI + (16 * st + fr) * QS + 32 * ks + 8 * fq);
                    acc = __builtin_amdgcn_mfma_f32_16x16x32_bf16(a, qf[ks], acc, 0, 0, 0);
                }
                const int t = 16 * tt + fr, s0 = 16 * st + 4 * fq;
                float v[4];
#pragma unroll
                for (int r = 0; r < 4; ++r) { const int s = s0 + r; const bool keep = dir == 0 ? (s <= t) : (s > t); v[r] = keep ? acc[r] : 0.f; }
                u32x2 w2; w2.x = cvt_pk_bf16(v[0], v[1]); w2.y = cvt_pk_bf16(v[2], v[3]);
                *(u32x2*)(SC + t * TS + s0) = w2;
            }
        }
        __syncthreads();
        if (GLA && step + 1 < 68) gate_stage(d0, CUM + ((step + 1) & 1) * 64 * 68, TT + ((step + 1) & 1) * 256);
        {
            const int tt = w >> 1;
            bf16x8 scf[2], kitf[NDK][2], vtf[2][2];
            const int trow = 8 * fq + (fr >> 2), tcol = 4 * (fr & 3);
#pragma unroll
            for (int ks = 0; ks < 2; ++ks) {
                scf[ks] = *(const bf16x8*)(SC + (16 * tt + fr) * TS + 32 * ks + 8 * fq);
#pragma unroll
                for (int a = 0; a < NDK; ++a) {
                    const s16x4 lo = __builtin_amdgcn_ds_read_tr16_b64_v4i16((LAS s16x4*)(lds3 + KI_B + ((32 * ks + trow) * QS + 16 * (dkt0 + a) + tcol) * 2));
                    const s16x4 hi = __builtin_amdgcn_ds_read_tr16_b64_v4i16((LAS s16x4*)(lds3 + KI_B + ((32 * ks + 4 + trow) * QS + 16 * (dkt0 + a) + tcol) * 2));
                    kitf[a][ks] = __builtin_shufflevector(lo, hi, 0, 1, 2, 3, 4, 5, 6, 7);
                }
#pragma unroll
                for (int c = 0; c < 2; ++c) {
                    const s16x4 lo = __builtin_amdgcn_ds_read_tr16_b64_v4i16((LAS s16x4*)(lds3 + VR_B + ((32 * ks + trow) * TS + 16 * (dvt0 + c) + tcol) * 2));
                    const s16x4 hi = __builtin_amdgcn_ds_read_tr16_b64_v4i16((LAS s16x4*)(lds3 + VR_B + ((32 * ks + 4 + trow) * TS + 16 * (dvt0 + c) + tcol) * 2));
                    vtf[c][ks] = __builtin_shufflevector(lo, hi, 0, 1, 2, 3, 4, 5, 6, 7);
                }
            }
#pragma unroll
            for (int di = 0; di < 2; ++di) {
                const int dvt = dvt0 + di;
                f32x4 acc = (f32x4){0.f, 0.f, 0.f, 0.f};
#pragma unroll
                for (int ks = 0; ks < 2; ++ks) acc = __builtin_amdgcn_mfma_f32_16x16x32_bf16(vtf[di][ks], scf[ks], acc, 0, 0, 0);
#pragma unroll
                for (int ks = 0; ks < NKS; ++ks) {
                    const bf16x8 a = *(const bf16x8*)(ST + (16 * dvt + fr) * QS + 32 * ks + 8 * fq);
                    acc = __builtin_amdgcn_mfma_f32_16x16x32_bf16(a, qf[ks], acc, 0, 0, 0);
                }
                u32x2 w2; w2.x = cvt_pk_bf16(acc[0], acc[1]); w2.y = cvt_pk_bf16(acc[2], acc[3]);
                *(u32x2*)(O + (size_t)(m0 + 16 * tt + fr) * DM + ocol + 16 * dvt + 4 * fq) = w2;
            }
#pragma unroll
            for (int a = 0; a < NDK; ++a) {
                const f32x4 dv4 = *(const f32x4*)(DVEC + 16 * (dkt0 + a) + 4 * fq);
#pragma unroll
                for (int c = 0; c < 2; ++c) {
#pragma unroll
                    for (int ks = 0; ks < 2; ++ks) S[a * 2 + c] = __builtin_amdgcn_mfma_f32_16x16x32_bf16(kitf[a][ks], vtf[c][ks], S[a * 2 + c], 0, 0, 0);
                    S[a * 2 + c] = S[a * 2 + c] * dv4;
                }
            }
        }
        __syncthreads();
#pragma unroll
        for (int a = 0; a < NDK; ++a)
#pragma unroll
            for (int c = 0; c < 2; ++c) {
                u32x2 w2; w2.x = cvt_pk_bf16(S[a * 2 + c][0], S[a * 2 + c][1]); w2.y = cvt_pk_bf16(S[a * 2 + c][2], S[a * 2 + c][3]);
                *(u32x2*)(ST + (16 * (dvt0 + c) + fr) * QS + 16 * (dkt0 + a) + 4 * fq) = w2;
            }
    }
    __syncthreads();
#undef SCAN_STEP_GEOM
#undef SCAN_ISSUE
#undef SCAN_ISSUE_D
}
__device__ void phase_scan(const Params& p, int l, unsigned char* lds) {
    for (int it = blockIdx.x; it < 256; it += gridDim.x) {
        const int isgla = it & 1, r = it >> 1;
        const int dvs = r & 1, dir = (r >> 1) & 1, h = (r >> 2) & 3, b = r >> 4;
#ifdef SKIP_GLA
        if (isgla) continue;
#endif
#ifdef SKIP_RET
        if (!isgla) continue;
#endif
        if (isgla) scan_item<64, true>(p, l, lds, (LAS unsigned char*)lds, b, h, dir, dvs);
        else scan_item<128, false>(p, l, lds, (LAS unsigned char*)lds, b, h, dir, dvs);
    }
}

#define XB_TMO      128
#define XB_XCNT(j)  (256  + 64 * (j))
#define XB_XSUB(j)  (1280 + 64 * (j))
#define XB_XGEN(j)  (2304 + 64 * (j))
#define XB_TOP      3328
#define XB_TOPGEN   3392
#define XCD_BAR_WORDS 3456
#define XB_SPIN_CAP (1u << 20)
__device__ __forceinline__ unsigned xb_ld(unsigned* p)              { return __hip_atomic_load(p, __ATOMIC_RELAXED, __HIP_MEMORY_SCOPE_AGENT); }
__device__ __forceinline__ unsigned xb_add(unsigned* p, unsigned v) { return __hip_atomic_fetch_add(p, v, __ATOMIC_RELAXED, __HIP_MEMORY_SCOPE_AGENT); }
__device__ __forceinline__ unsigned xb_xcc_id() { return (unsigned)__builtin_amdgcn_s_getreg((3 << 11) | 20) & 0xFu; }
#define XB_SPIN(cond, bar) do { unsigned _sp = 0; while (cond) { __builtin_amdgcn_s_sleep(1); \
    if ((++_sp & 255u) == 0u) { if (xb_ld(&(bar)[XB_TMO])) break; if (_sp > XB_SPIN_CAP) { atomicAdd(&(bar)[XB_TMO], 1u); break; } } } } while (0)
struct XcdBarrier { unsigned* bar; unsigned x; volatile LAS unsigned* st; };
__device__ __forceinline__ XcdBarrier xcd_barrier_post(unsigned* bar, volatile LAS unsigned* st) {
    XcdBarrier b; b.bar = bar; b.x = xb_xcc_id(); b.st = st;
    if (threadIdx.x == 0) (void)xb_add(&bar[XB_XCNT(b.x)], 1u);
    return b;
}
__device__ __forceinline__ void xcd_barrier_complete(unsigned* bar, unsigned x, unsigned& nloc, unsigned& nx) {
    const unsigned G = gridDim.x * gridDim.y * gridDim.z;
    unsigned sum, cnt, mine, sp = 0u;
    for (;;) {
        sum = 0u; cnt = 0u; mine = 0u;
#pragma unroll
        for (unsigned j = 0; j < 16; ++j) { const unsigned c = xb_ld(&bar[XB_XCNT(j)]); sum += c; cnt += (c > 0u) ? 1u : 0u; mine = (j == x) ? c : mine; }
        if (sum == G) break;
        __builtin_amdgcn_s_sleep(1);
        if ((++sp & 255u) == 0u) { if (xb_ld(&bar[XB_TMO])) break; if (sp > XB_SPIN_CAP) { atomicAdd(&bar[XB_TMO], 1u); break; } }
    }
    nloc = mine > 0u ? mine : 1u; nx = cnt > 0u ? cnt : 1u;
}
__device__ __forceinline__ void xcd_barrier(const XcdBarrier& b) {
    asm volatile("s_waitcnt vmcnt(0)" ::: "memory");
    __syncthreads();
    if (threadIdx.x == 0) {
        unsigned* bar = b.bar;
        __builtin_amdgcn_s_waitcnt(0);
        unsigned nloc = b.st[0], nx = b.st[1];
        if (nloc == 0u) { xcd_barrier_complete(bar, b.x, nloc, nx); b.st[0] = nloc; b.st[1] = nx; }
        const unsigned old = xb_add(&bar[XB_XSUB(b.x)], 1u);
        const unsigned gen = old / nloc;
        if (old + 1u == (gen + 1u) * nloc) {
            __builtin_amdgcn_fence(__ATOMIC_RELEASE, "agent");
            asm volatile("s_waitcnt vmcnt(0)" ::: "memory");
            const unsigned og = xb_add(&bar[XB_TOP], 1u);
            const unsigned tg = og / nx;
            if (og + 1u == (tg + 1u) * nx) xb_add(&bar[XB_TOPGEN], 1u);
            else XB_SPIN(xb_ld(&bar[XB_TOPGEN]) == tg, bar);
            __builtin_amdgcn_fence(__ATOMIC_ACQUIRE, "agent");
            xb_add(&bar[XB_XGEN(b.x)], 1u);
            asm volatile("s_waitcnt vmcnt(0)" ::: "memory");
        } else {
            XB_SPIN(xb_ld(&bar[XB_XGEN(b.x)]) == gen, bar);
            __builtin_amdgcn_fence(__ATOMIC_ACQUIRE, "agent");
            asm volatile("s_waitcnt vmcnt(0)" ::: "memory");
        }
    }
    __syncthreads();
}

__global__ void __launch_bounds__(512, 2) fwd_megakernel(Params p) {
    extern __shared__ __attribute__((aligned(16))) unsigned char shm[];
    cg::grid_group grid = cg::this_grid();
    const float* MOD = (const float*)(p.ws + WS_MOD);
    volatile LAS unsigned* xst = (volatile LAS unsigned*)((LAS unsigned char*)shm + 131072);
    if (threadIdx.x == 0) { xst[0] = 0u; xst[1] = 0u; xst[2] = 0u; xst[3] = 0u; }
    __syncthreads();
    const XcdBarrier xbar = xcd_barrier_post((unsigned*)(p.ws + WS_BAR), xst);
    for (int ph = p.ph_lo; ph < p.ph_hi; ++ph) {
        if (ph == 0) phase_prep(p, shm);
        else if (ph == NPHASE - 1) phase_final(p);
        else {
            const int l = (ph - 1) >> 3, sub = (ph - 1) & 7;
            const float* mod_l = MOD + (size_t)l * 9 * 6 * DM;
            const float* xin_lat = l == 0 ? p.x : p.out; const float* xin_ctx = l == 0 ? p.ctx : (const float*)(p.ws + WS_XCTX);
            float* xo_lat = p.out; float* xo_ctx = (float*)(p.ws + WS_XCTX);
            const int mrows = l == 0 ? MTOT : NLAT;
            bf16_t* H = (bf16_t*)(p.ws + WS_H); bf16_t* Pm = (bf16_t*)(p.ws + WS_P);
            pg8::StaticOrder S;
            if (sub == 0) phase_norm(p, xin_lat, xin_ctx, p.norm1_g + l * DM, mod_l, 0, MTOT, l == 1 ? (const float*)(p.ws + WS_SLAB) : nullptr, MOD + 8 * 6 * DM + 5 * DM);
#ifndef NO_G1
            else if (sub == 1) { pg8::Gemm g{H, (const bf16_t*)(p.ws + WS_WIN) + (size_t)l * INWP * DM, MTOT, INWP, DM, DM}; S.init(g.M, g.N, gridDim.x, blockIdx.x);
                EpiP E{Pm}; pg8::gemm_phase(( LAS unsigned char*)shm, g, S, E); }
#endif
#ifndef NO_SCAN
            else if (sub == 2) phase_scan(p, l, shm);
#endif
            else if (sub == 3) phase_merge(p, l, mrows);
#ifndef NO_G2
            else if (sub == 4) { pg8::Gemm g{H, (const bf16_t*)(p.ws + WS_WOUT) + (size_t)l * DM * DM, mrows, DM, DM, DM}; S.init(g.M, g.N, gridDim.x, blockIdx.x);
                EpiRes E{xin_lat, xin_ctx, xo_lat, xo_ctx, mod_l + 2 * DM}; pg8::gemm_phase((LAS unsigned char*)shm, g, S, E);
                if (l == 0) {
                    const int nbusy = (MTOT / 256) * (DM / 256) - 2 * (int)gridDim.x;
                    if (nbusy < 0 || (int)gridDim.x - nbusy < 32) convert_weights(p, shm, NT_EARLY, 2 * NT_LAYER, blockIdx.x, gridDim.x);
                    else if ((int)blockIdx.x >= nbusy) convert_weights(p, shm, NT_EARLY, 2 * NT_LAYER, (int)blockIdx.x - nbusy, (int)gridDim.x - nbusy);
                } }
#endif
            else if (sub == 5) phase_norm(p, xo_lat, xo_ctx, p.norm2_g + l * DM, mod_l, 3 * DM, mrows, nullptr, nullptr);
#ifndef NO_G3
            else if (sub == 6) { pg8::Gemm g{H, (const bf16_t*)(p.ws + WS_W1) + (size_t)l * DFF * DM, mrows, DFF, DM, DM}; S.init(g.M, g.N, gridDim.x, blockIdx.x);
                EpiRelu2 E{Pm}; pg8::gemm_phase((LAS unsigned char*)shm, g, S, E); }
#endif
#ifndef NO_G4
            else if (sub == 7) { pg8::Gemm g{Pm, (const bf16_t*)(p.ws + WS_W2) + (size_t)l * DM * DFF, NLAT, DM, DFF, DFF}; S.init(g.M, g.N, gridDim.x, blockIdx.x);
                EpiRes E{xo_lat, xo_ctx, xo_lat, xo_ctx, mod_l + 5 * DM}; pg8::gemm_phase((LAS unsigned char*)shm, g, S, E);
                if (l == 0) {
                    pg8::Gemm g2{Pm + (size_t)NLAT * DFF, g.Bt, NCTX, DM, DFF / NSPLIT, DFF};
                    pg8::SplitOrder<NSPLIT, DFF / NSPLIT> S2; S2.G = gridDim.x; S2.c = blockIdx.x;
                    EpiSlab E2{(float*)(p.ws + WS_SLAB), NCTX}; pg8::gemm_phase((LAS unsigned char*)shm, g2, S2, E2);
                } }
#endif
        }
        if (ph + 1 < p.ph_hi) {
            if (p.ph_hi > NPHASE) grid.sync();
            xcd_barrier(xbar);
        }
    }
}

extern "C" void kernel_launch(void* const* d_in, const int* in_sizes, int n_in, void* d_out, int out_size, void* d_ws, size_t ws_size, hipStream_t stream) {
    static int grid_blocks = 0;
    if (!grid_blocks) {
        int dev = 0, cus = 0, per_cu = 0;
        hipGetDevice(&dev);
        hipDeviceGetAttribute(&cus, hipDeviceAttributeMultiprocessorCount, dev);
        if (hipFuncSetAttribute((const void*)fwd_megakernel, hipFuncAttributeMaxDynamicSharedMemorySize, LDS_BYTES) != hipSuccess) fprintf(stderr, "hipFuncSetAttribute failed\n");
        if (hipOccupancyMaxActiveBlocksPerMultiprocessor(&per_cu, (const void*)fwd_megakernel, 512, LDS_BYTES) != hipSuccess || per_cu < 1) { fprintf(stderr, "occupancy query: %d\n", per_cu); per_cu = 1; }
        (void)hipGetLastError();
        grid_blocks = cus * per_cu;
        if (ws_size < WS_SLAB + (size_t)NSPLIT * NCTX * DM * 4) fprintf(stderr, "workspace too small: %zu < %zu\n", ws_size, (size_t)WS_END);
    }
    Params p{};
    p.x = (const float*)d_in[0]; p.c = (const float*)d_in[1]; p.ctx = (const float*)d_in[2]; p.c_ctx = (const float*)d_in[3]; p.ada_w = (const float*)d_in[4];
    p.ada_b = (const float*)d_in[5]; p.norm1_g = (const float*)d_in[6]; p.w_in = (const float*)d_in[7]; p.ret_decay = (const float*)d_in[8];
    p.gate_up = (const float*)d_in[9]; p.gate_b = (const float*)d_in[10]; p.gla_norm_g = (const float*)d_in[11]; p.w_out = (const float*)d_in[12];
    p.norm2_g = (const float*)d_in[13]; p.w_mlp1 = (const float*)d_in[14]; p.w_mlp2 = (const float*)d_in[15]; p.final_g = (const float*)d_in[16];
    p.out = (float*)d_out; p.ws = (unsigned char*)d_ws;
    if (hipMemsetAsync((unsigned char*)d_ws + WS_BAR, 0, BAR_BYTES, stream) != hipSuccess) fprintf(stderr, "memset of barrier words failed\n");
#if MULTI
    for (int ph = 0; ph < NPHASE; ++ph) {
        p.ph_lo = ph; p.ph_hi = ph + 1;
        hipLaunchKernelGGL(fwd_megakernel, dim3(grid_blocks), dim3(512), LDS_BYTES, stream, p);
    }
#else
    p.ph_lo = 0; p.ph_hi = NPHASE;
    void* args[] = {&p};
    hipError_t e = hipLaunchCooperativeKernel((const void*)fwd_megakernel, dim3(grid_blocks), dim3(512), args, LDS_BYTES, stream);
    if (e != hipSuccess) fprintf(stderr, "cooperative launch failed: %s (grid %d)\n", hipGetErrorString(e), grid_blocks);
#endif
}
```

```cpp
#include <hip/hip_runtime.h>
#include <hip/hip_cooperative_groups.h>
#include <cstdio>
namespace cg = cooperative_groups;

#ifndef MULTI
#define MULTI 0
#endif

#define LAS __attribute__((address_space(3)))
typedef unsigned short bf16_t;
typedef short bf16x8 __attribute__((ext_vector_type(8)));
typedef short s16x4 __attribute__((ext_vector_type(4)));
typedef float f32x4 __attribute__((ext_vector_type(4)));
typedef unsigned u32x2 __attribute__((ext_vector_type(2)));
typedef unsigned u32x4 __attribute__((ext_vector_type(4)));

constexpr int DM = 1024, NB = 8, SEQ = 4096, CTXL = 256, NLAT = NB * SEQ, NCTX = NB * CTXL, MTOT = NLAT + NCTX;
constexpr int INW = 3616, INWP = 3840, DFF = 4096;
constexpr int NPHASE = 18;
constexpr int LDS_BYTES = 131072 + 16;

constexpr size_t WS_WIN = 0;
constexpr size_t WS_WOUT = WS_WIN + (size_t)2 * INWP * DM * 2;
constexpr size_t WS_W1 = WS_WOUT + (size_t)2 * DM * DM * 2;
constexpr size_t WS_W2 = WS_W1 + (size_t)2 * DFF * DM * 2;
constexpr size_t WS_MOD = WS_W2 + (size_t)2 * DM * DFF * 2;
constexpr size_t WS_TAB = WS_MOD + (size_t)2 * 9 * 6 * DM * 4;
constexpr size_t WS_XCTX = WS_TAB + (size_t)2 * 2048 * 4;
constexpr size_t WS_H = WS_XCTX + (size_t)NCTX * DM * 4;
constexpr size_t WS_P = WS_H + (size_t)MTOT * DM * 2;
constexpr size_t WS_OB = WS_P + (size_t)MTOT * INW * 2;
constexpr size_t WS_END = WS_OB + (size_t)MTOT * DM * 2;
static_assert((size_t)MTOT * DFF * 2 <= WS_END - WS_P, "hmlp alias");
constexpr size_t WS_BAR = WS_END;
constexpr size_t BAR_BYTES = 16384;
constexpr size_t WS_SLAB = WS_BAR + BAR_BYTES;
constexpr int NSPLIT = 8;
static_assert(WS_SLAB + (size_t)NSPLIT * NCTX * DM * 4 <= (size_t)536870912, "ws");

struct Params {
    const float* x; const float* c; const float* ctx; const float* c_ctx; const float* ada_w; const float* ada_b; const float* norm1_g;
    const float* w_in; const float* ret_decay; const float* gate_up; const float* gate_b; const float* gla_norm_g; const float* w_out;
    const float* norm2_g; const float* w_mlp1; const float* w_mlp2; const float* final_g;
    float* out; unsigned char* ws; int ph_lo, ph_hi;
};

typedef float f32x2_t __attribute__((ext_vector_type(2)));
typedef __bf16 bf16x2_t __attribute__((ext_vector_type(2)));
__device__ __forceinline__ unsigned cvt_pk_bf16(float lo, float hi) { f32x2_t v = {lo, hi}; bf16x2_t b = __builtin_convertvector(v, bf16x2_t); return __builtin_bit_cast(unsigned, b); }
__device__ __forceinline__ bf16_t f2bf(float f) { return (bf16_t)(cvt_pk_bf16(f, 0.f) & 0xffffu); }
__device__ __forceinline__ float bf2f(short b) { return __uint_as_float(((unsigned)(unsigned short)b) << 16); }
__device__ __forceinline__ int otid() { int t = threadIdx.x; asm volatile("" : "+v"(t)); return t; }
__device__ __forceinline__ float silu_f(float v) { return v / (1.f + __expf(-v)); }

namespace pg8 {
constexpr int STAGGER_TICKS = 0;
constexpr int BM = 256, BK = 64, HALF = 128, HTB = HALF * BK * 2, STAGE_BYTES = 8 * HTB, NXCD = 8, WGM = 8;
__host__ __device__ __forceinline__ int lds_byte(int r, int c) { const int st = (r >> 4) * 2 + (c >> 5), rr = r & 15, cc = c & 31, ob = rr * 64 + cc * 2; return st * 1024 + (ob ^ (((ob >> 9) & 1) << 5)); }
__host__ __device__ __forceinline__ void stage_rc(int b, int& R, int& C) { const int st = b / 1024, sb = b % 1024, swz = sb ^ (((sb >> 9) & 1) << 5); R = (st >> 1) * 16 + swz / 64; C = (st & 1) * 32 + (swz % 64) / 2; }
__host__ __device__ __forceinline__ int perm32(int rho) { const int n = rho >> 4, i = rho & 15; return 8 * (i >> 2) + 4 * n + (i & 3); }
struct Unit { int pm, pn, kofs, ks; };
struct Gemm { const bf16_t* A; const bf16_t* Bt; int M, N, K, ld; };
struct StaticOrder {
    int nM, nN, nwg, G, c;
    __host__ __device__ void init(int M, int N, int G_, int c_) { nM = M / BM; nN = N / BM; nwg = nM * nN; G = G_; c = c_; }
    __host__ __device__ bool next(int i, Unit& u) const {
        const long L = (long)i * G + c; if (L >= nwg) return false;
        int wgid = (int)L; { const int q = nwg / NXCD, r = nwg % NXCD, xcd = wgid % NXCD, off = wgid / NXCD; wgid = (xcd < r ? xcd * (q + 1) : r * (q + 1) + (xcd - r) * q) + off; }
        const int nig = WGM * nN, gid = wgid / nig, fm = gid * WGM, gsz = (nM - fm) < WGM ? (nM - fm) : WGM;
        u.pm = fm + ((wgid % nig) % gsz); u.pn = (wgid % nig) / gsz; u.kofs = 0; u.ks = 0; return true;
    }
    __device__ __forceinline__ void a_ready(const Unit&) const {}
    __device__ __forceinline__ void done(const Unit&) const {}
};

template <int NS, int KS> struct SplitOrder {
    int G, c;
    __device__ bool next(int i, Unit& u) const {
        const int idx = i * G + c; if (idx >= 32 * NS) return false;
        u.ks = idx % NS; const int t = idx / NS; u.pn = t & 3; u.pm = t >> 2; u.kofs = u.ks * KS * 2; return true;
    }
    __device__ __forceinline__ void a_ready(const Unit&) const {}
    __device__ __forceinline__ void done(const Unit&) const {}
};
template <class Epi, class Sched>
__device__ __forceinline__ void gemm_phase(LAS unsigned char* lds, const Gemm g, const Sched& S, const Epi& E) {
    const int tid = otid(), wid = __builtin_amdgcn_readfirstlane(tid >> 6), lane = tid & 63, wr = wid >> 2, wc = wid & 3, fr = lane & 15, fq = lane >> 4;
    const int K = g.ld, nt = g.K / BK;
    unsigned voffA[2], voffB[2];
#pragma unroll
    for (int i = 0; i < 2; ++i) { int R, C; stage_rc(tid * 16 + i * 8192, R, C); const int Rb = Epi::PERM ? ((R & ~31) + perm32(R & 31)) : R;
        voffA[i] = (unsigned)(R * K + C) * 2u; voffB[i] = (unsigned)(Rb * K + C) * 2u; }
    const size_t kstep = (size_t)(BK * 2);
    const size_t hstep = (size_t)HALF * K * 2;
    const size_t tstep = 2 * hstep;
    const unsigned ldsw = (unsigned)wid * 1024u;
    const int aoff = lds_byte(wr * 64 + fr, fq * 8), boff = lds_byte(wc * 32 + fr, fq * 8);
#define PG8_SA(b, h) (((b) * 2 + (h)) * HTB)
#define PG8_SB(b, h) ((4 + (b) * 2 + (h)) * HTB)
#define PG8_STAGE(bufoff, gbase, voff) do { _Pragma("unroll") for (int _i = 0; _i < 2; ++_i) \
        __builtin_amdgcn_global_load_lds((const unsigned*)((const char*)(gbase) + (voff)[_i]), (LAS unsigned*)(lds + (bufoff) + ldsw + _i * 8192), 16, 0, 0); } while (0)
#define PG8_LDA(dst, b, h) do { _Pragma("unroll") for (int m = 0; m < 4; ++m) _Pragma("unroll") for (int k = 0; k < 2; ++k) dst[m][k] = *(const LAS bf16x8*)(lds + PG8_SA(b, h) + aoff + m * 2048 + k * 1024); } while (0)
#define PG8_LDB(dst, b, h) do { _Pragma("unroll") for (int n = 0; n < 2; ++n) _Pragma("unroll") for (int k = 0; k < 2; ++k) dst[n][k] = *(const LAS bf16x8*)(lds + PG8_SB(b, h) + boff + n * 2048 + k * 1024); } while (0)
#define PG8_MMA(ai, bj, At, Bt) do { __builtin_amdgcn_s_setprio(1); _Pragma("unroll") for (int m = 0; m < 4; ++m) _Pragma("unroll") for (int n = 0; n < 2; ++n) _Pragma("unroll") for (int k = 0; k < 2; ++k) \
        acc[ai][bj][m][n] = __builtin_amdgcn_mfma_f32_16x16x32_bf16(Bt[n][k], At[m][k], acc[ai][bj][m][n], 0, 0, 0); __builtin_amdgcn_s_setprio(0); } while (0)
#define PG8_WAIT_V(n) asm volatile("s_waitcnt vmcnt(" #n ")" ::: "memory")
#define PG8_WAIT_L(n) asm volatile("s_waitcnt lgkmcnt(" #n ")" ::: "memory")
#define PG8_BAR __builtin_amdgcn_s_barrier()
#define PG8_SCHED __builtin_amdgcn_sched_barrier(0)
    Unit cur, nxt; int ui = 0;
    if (!S.next(0, cur)) return;
    if (STAGGER_TICKS > 0 && (blockIdx.x & 1)) {
        const unsigned long long t0 = __builtin_amdgcn_s_memrealtime();
        while (__builtin_amdgcn_s_memrealtime() - t0 < (unsigned long long)STAGGER_TICKS) __builtin_amdgcn_s_sleep(8);
    }
    f32x4 acc[2][2][4][2];
#pragma unroll
    for (int a = 0; a < 2; ++a)
#pragma unroll
        for (int b = 0; b < 2; ++b)
#pragma unroll
            for (int m = 0; m < 4; ++m)
#pragma unroll
                for (int n = 0; n < 2; ++n) acc[a][b][m][n] = (f32x4){0.f, 0.f, 0.f, 0.f};
    bf16x8 At[4][2], B0[2][2], B1[2][2];
    const char* cA = (const char*)g.A + (size_t)cur.pm * tstep + cur.kofs; const char* cB = (const char*)g.Bt + (size_t)cur.pn * tstep + cur.kofs;
    S.a_ready(cur);
    PG8_STAGE(PG8_SB(0, 0), cB, voffB); PG8_STAGE(PG8_SA(0, 0), cA, voffA); PG8_STAGE(PG8_SB(0, 1), cB + hstep, voffB); PG8_STAGE(PG8_SA(0, 1), cA + hstep, voffA);
    if (wr == 1) PG8_BAR;
    PG8_WAIT_V(4); PG8_BAR;
    PG8_STAGE(PG8_SB(1, 0), cB + kstep, voffB); PG8_STAGE(PG8_SA(1, 0), cA + kstep, voffA); PG8_STAGE(PG8_SB(1, 1), cB + hstep + kstep, voffB);
    PG8_WAIT_V(6); PG8_BAR;
    for (;;) {
        const bool has_next = S.next(ui + 1, nxt);
        const char* nA = has_next ? (const char*)g.A + (size_t)nxt.pm * tstep + nxt.kofs : cA; const char* nB = has_next ? (const char*)g.Bt + (size_t)nxt.pn * tstep + nxt.kofs : cB;
        for (int t = 0; t < nt; t += 2) {
            const bool last = (t == nt - 2);
            const char* a1 = cA + (size_t)(t + 1) * kstep;
            const char* a2 = last ? nA : cA + (size_t)(t + 2) * kstep; const char* b2 = last ? nB : cB + (size_t)(t + 2) * kstep;
            const char* a3 = a2 + kstep; const char* b3 = b2 + kstep;
            if (last && has_next) S.a_ready(nxt);
            PG8_LDB(B0, 0, 0); PG8_SCHED; PG8_LDA(At, 0, 0); PG8_STAGE(PG8_SA(1, 1), a1 + hstep, voffA);
            PG8_WAIT_L(8); PG8_BAR; PG8_WAIT_L(0); PG8_MMA(0, 0, At, B0); PG8_BAR; PG8_SCHED;
            PG8_LDB(B1, 0, 1); PG8_STAGE(PG8_SB(0, 0), b2, voffB);
            PG8_BAR; PG8_WAIT_L(0); PG8_MMA(0, 1, At, B1); PG8_BAR;
            PG8_LDA(At, 0, 1); PG8_STAGE(PG8_SA(0, 0), a2, voffA);
            PG8_BAR; PG8_WAIT_L(0); PG8_MMA(1, 0, At, B0); PG8_BAR; PG8_SCHED;
            PG8_STAGE(PG8_SB(0, 1), b2 + hstep, voffB);
            PG8_WAIT_V(6); PG8_BAR; PG8_MMA(1, 1, At, B1); PG8_BAR;
            PG8_LDB(B0, 1, 0); PG8_SCHED; PG8_LDA(At, 1, 0); PG8_STAGE(PG8_SA(0, 1), a2 + hstep, voffA);
            PG8_WAIT_L(8); PG8_BAR; PG8_WAIT_L(0); PG8_MMA(0, 0, At, B0); PG8_BAR; PG8_SCHED;
            PG8_LDB(B1, 1, 1); PG8_STAGE(PG8_SB(1, 0), b3, voffB);
            PG8_BAR; PG8_WAIT_L(0); PG8_MMA(0, 1, At, B1); PG8_BAR;
            PG8_LDA(At, 1, 1); PG8_STAGE(PG8_SA(1, 0), a3, voffA);
            PG8_BAR; PG8_WAIT_L(0); PG8_MMA(1, 0, At, B0); PG8_BAR; PG8_SCHED;
            PG8_STAGE(PG8_SB(1, 1), b3 + hstep, voffB);
            PG8_WAIT_V(6); PG8_BAR; PG8_MMA(1, 1, At, B1); PG8_BAR;
        }
        E(acc, cur, wr, wc, fr, fq);
        if (!has_next) break;
#pragma unroll
        for (int a = 0; a < 2; ++a)
#pragma unroll
            for (int b = 0; b < 2; ++b)
#pragma unroll
                for (int m = 0; m < 4; ++m)
#pragma unroll
                    for (int n = 0; n < 2; ++n) acc[a][b][m][n] = (f32x4){0.f, 0.f, 0.f, 0.f};
        cur = nxt; cA = nA; cB = nB; ++ui;
    }
    PG8_WAIT_V(0);
    if (wr == 0) PG8_BAR;
    PG8_BAR;
#undef PG8_SA
#undef PG8_SB
#undef PG8_STAGE
#undef PG8_LDA
#undef PG8_LDB
#undef PG8_MMA
#undef PG8_WAIT_V
#undef PG8_WAIT_L
#undef PG8_BAR
#undef PG8_SCHED
}
}

struct EpiP {
    static constexpr bool PERM = true;
    bf16_t* P;
    __device__ __forceinline__ void operator()(const f32x4 (&acc)[2][2][4][2], const pg8::Unit& u, int wr, int wc, int fr, int fq) const {
        const int row0 = u.pm * 256 + wr * 64 + fr, col0 = u.pn * 256 + wc * 32 + 8 * fq;
#pragma unroll
        for (int ai = 0; ai < 2; ++ai)
#pragma unroll
            for (int m = 0; m < 4; ++m) { bf16_t* rowp = P + (size_t)(row0 + ai * 128 + m * 16) * INW;
#pragma unroll
                for (int bj = 0; bj < 2; ++bj) { const int c = col0 + bj * 128; const f32x4 v0 = acc[ai][bj][m][0], v1 = acc[ai][bj][m][1];
                    if (c < INW) { u32x4 w4; w4.x = cvt_pk_bf16(v0[0], v0[1]); w4.y = cvt_pk_bf16(v0[2], v0[3]); w4.z = cvt_pk_bf16(v1[0], v1[1]); w4.w = cvt_pk_bf16(v1[2], v1[3]); *(u32x4*)(rowp + c) = w4; } } }
    }
};
struct EpiRelu2 {
    static constexpr bool PERM = true;
    bf16_t* O;
    __device__ __forceinline__ void operator()(const f32x4 (&acc)[2][2][4][2], const pg8::Unit& u, int wr, int wc, int fr, int fq) const {
        const int row0 = u.pm * 256 + wr * 64 + fr, col0 = u.pn * 256 + wc * 32 + 8 * fq;
#pragma unroll
        for (int ai = 0; ai < 2; ++ai)
#pragma unroll
            for (int m = 0; m < 4; ++m) { bf16_t* rowp = O + (size_t)(row0 + ai * 128 + m * 16) * DFF;
#pragma unroll
                for (int bj = 0; bj < 2; ++bj) { const int c = col0 + bj * 128; f32x4 v0 = acc[ai][bj][m][0], v1 = acc[ai][bj][m][1];
#pragma unroll
                    for (int j = 0; j < 4; ++j) { const float r0 = fmaxf(v0[j], 0.f), r1 = fmaxf(v1[j], 0.f); v0[j] = r0 * r0; v1[j] = r1 * r1; }
                    u32x4 w4; w4.x = cvt_pk_bf16(v0[0], v0[1]); w4.y = cvt_pk_bf16(v0[2], v0[3]); w4.z = cvt_pk_bf16(v1[0], v1[1]); w4.w = cvt_pk_bf16(v1[2], v1[3]); *(u32x4*)(rowp + c) = w4; } }
    }
};
struct EpiRes {
    static constexpr bool PERM = false;
    const float* xin_lat; const float* xin_ctx; float* xout_lat; float* xout_ctx; const float* gate;
    __device__ __forceinline__ void operator()(const f32x4 (&acc)[2][2][4][2], const pg8::Unit& u, int wr, int wc, int fr, int fq) const {
        const int row0 = u.pm * 256 + wr * 64 + fr, col0 = u.pn * 256 + wc * 32 + 4 * fq;
        const int rb = u.pm * 256;
        const bool isctx = rb >= NLAT;
        const int bidx = isctx ? 8 : (rb >> 12);
        const float* xi = isctx ? xin_ctx - (size_t)NLAT * DM : xin_lat;
        float* xo = isctx ? xout_ctx - (size_t)NLAT * DM : xout_lat;
        const float* gp = gate + (size_t)bidx * 6 * DM;
        f32x4 gv[2][2];
#pragma unroll
        for (int bj = 0; bj < 2; ++bj)
#pragma unroll
            for (int n = 0; n < 2; ++n) gv[bj][n] = *(const f32x4*)(gp + col0 + bj * 128 + n * 16);
#pragma unroll
        for (int ai = 0; ai < 2; ++ai) {
            f32x4 xv[4][2][2];
#pragma unroll
            for (int m = 0; m < 4; ++m) { const size_t ro = (size_t)(row0 + ai * 128 + m * 16) * DM;
#pragma unroll
                for (int bj = 0; bj < 2; ++bj)
#pragma unroll
                    for (int n = 0; n < 2; ++n) xv[m][bj][n] = *(const f32x4*)(xi + ro + col0 + bj * 128 + n * 16); }
#pragma unroll
            for (int m = 0; m < 4; ++m) { const size_t ro = (size_t)(row0 + ai * 128 + m * 16) * DM;
#pragma unroll
                for (int bj = 0; bj < 2; ++bj)
#pragma unroll
                    for (int n = 0; n < 2; ++n) *(f32x4*)(xo + ro + col0 + bj * 128 + n * 16) = xv[m][bj][n] + gv[bj][n] * acc[ai][bj][m][n]; }
        }
    }
};
struct EpiSlab {
    static constexpr bool PERM = false;
    bf16_t* slab; int rows;
    __device__ __forceinline__ void operator()(const f32x4 (&acc)[2][2][4][2], const pg8::Unit& u, int wr, int wc, int fr, int fq) const {
        const int row0 = u.pm * 256 + wr * 64 + fr, col0 = u.pn * 256 + wc * 32 + 4 * fq;
        bf16_t* base = slab + (size_t)u.ks * rows * DM;
#pragma unroll
        for (int ai = 0; ai < 2; ++ai)
#pragma unroll
            for (int m = 0; m < 4; ++m) { bf16_t* rowp = base + (size_t)(row0 + ai * 128 + m * 16) * DM + col0;
#pragma unroll
                for (int bj = 0; bj < 2; ++bj)
#pragma unroll
                    for (int n = 0; n < 2; ++n) { const f32x4 a4 = acc[ai][bj][m][n]; u32x2 w2; w2.x = cvt_pk_bf16(a4[0], a4[1]); w2.y = cvt_pk_bf16(a4[2], a4[3]); *(u32x2*)(rowp + bj * 128 + n * 16) = w2; } }
    }
};

struct TileDesc { const float* src; bf16_t* dst; int K, N, k0, n0; };
__device__ __forceinline__ TileDesc tile_desc(const Params& p, int t) {
    constexpr int T_IN = 16 * 60, T_OUT = 16 * 16, T_1 = 16 * 64, T_2 = 64 * 16, T_L = T_IN + T_OUT + T_1 + T_2;
    const int l = t / T_L; int r = t % T_L; TileDesc d;
    if (r < T_IN) { d.src = p.w_in + (size_t)l * DM * INW; d.K = DM; d.N = INW; d.dst = (bf16_t*)(p.ws + WS_WIN) + (size_t)l * INWP * DM; d.k0 = (r / 60) * 64; d.n0 = (r % 60) * 64; }
    else if ((r -= T_IN) < T_OUT) { d.src = p.w_out + (size_t)l * DM * DM; d.K = DM; d.N = DM; d.dst = (bf16_t*)(p.ws + WS_WOUT) + (size_t)l * DM * DM; d.k0 = (r / 16) * 64; d.n0 = (r % 16) * 64; }
    else if ((r -= T_OUT) < T_1) { d.src = p.w_mlp1 + (size_t)l * DM * DFF; d.K = DM; d.N = DFF; d.dst = (bf16_t*)(p.ws + WS_W1) + (size_t)l * DFF * DM; d.k0 = (r / 64) * 64; d.n0 = (r % 64) * 64; }
    else { r -= T_1; d.src = p.w_mlp2 + (size_t)l * DFF * DM; d.K = DFF; d.N = DM; d.dst = (bf16_t*)(p.ws + WS_W2) + (size_t)l * DM * DFF; d.k0 = (r / 16) * 64; d.n0 = (r % 16) * 64; }
    return d;
}
__device__ __forceinline__ void tile_load(const TileDesc& d, int tid, f32x4 (&v)[2]) {
    const int r = tid >> 4, n = d.n0 + 4 * (tid & 15); const bool in = n < d.N; const int nc = in ? n : 0;
#pragma unroll
    for (int i = 0; i < 2; ++i) { const f32x4 t = *(const f32x4*)(d.src + (size_t)(d.k0 + r + 32 * i) * d.N + nc); v[i] = in ? t : (f32x4){0.f, 0.f, 0.f, 0.f}; }
}
__device__ __forceinline__ void tile_put(const f32x4 (&v)[2], int tid, float* tile) {
    const int r = tid >> 4, c = 4 * (tid & 15);
#pragma unroll
    for (int i = 0; i < 2; ++i)
#pragma unroll
        for (int j = 0; j < 4; ++j) tile[(r + 32 * i) * 65 + c + j] = v[i][j];
}
__device__ __forceinline__ void tile_store(const TileDesc& d, int tid, const float* tile) {
    const int n = tid >> 3, kg = tid & 7; float f[8];
#pragma unroll
    for (int j = 0; j < 8; ++j) f[j] = tile[(8 * kg + j) * 65 + n];
    u32x4 o; o.x = cvt_pk_bf16(f[0], f[1]); o.y = cvt_pk_bf16(f[2], f[3]); o.z = cvt_pk_bf16(f[4], f[5]); o.w = cvt_pk_bf16(f[6], f[7]);
    *(u32x4*)(d.dst + (size_t)(d.n0 + n) * d.K + d.k0 + 8 * kg) = o;
}
constexpr int NT_LAYER = 16 * 60 + 16 * 16 + 16 * 64 + 64 * 16;
constexpr int NT_EARLY = 16 * 60 + 16 * 16;
__device__ void convert_weights(const Params& p, unsigned char* lds, int t_lo, int t_hi, int rank, int nranks) {
    float* tile = (float*)lds; float* tile2 = tile + 64 * 65 + 32;
    const int tid = otid();
    for (int t = t_lo + rank; t < t_hi; t += 2 * nranks) {
        const int t2 = t + nranks; const bool has2 = t2 < t_hi;
        const TileDesc da = tile_desc(p, t), db = tile_desc(p, has2 ? t2 : t);
        f32x4 va[2], vb[2];
        tile_load(da, tid, va); tile_load(db, tid, vb);
        tile_put(va, tid, tile); tile_put(vb, tid, tile2);
        __syncthreads();
        tile_store(da, tid, tile); if (has2) tile_store(db, tid, tile2);
        __syncthreads();
    }
}
__device__ void phase_prep(const Params& p, unsigned char* lds) {
    float* tile = (float*)lds; float* tile2 = tile + 64 * 65 + 32;
    const int tid = otid();
    convert_weights(p, lds, 0, NT_EARLY, blockIdx.x, gridDim.x);
    float* red = (float*)lds;
    float* scv = red + 8 * 9 * 64;
    const int w = tid >> 6, lane = tid & 63;
    if (blockIdx.x < 2 * 96) {
        __syncthreads();
        for (int i = tid; i < 9 * DM; i += 512) { const float cv = (i < 8 * DM) ? p.c[i] : p.c_ctx[i - 8 * DM]; scv[i] = silu_f(cv); }
        __syncthreads();
    }
    for (int it = blockIdx.x; it < 2 * 96; it += gridDim.x) {
        const int l = it / 96, j0 = (it % 96) * 64;
        f32x4 a[9];
#pragma unroll
        for (int r = 0; r < 9; ++r) a[r] = (f32x4){0.f, 0.f, 0.f, 0.f};
        const int cg = lane & 15, kq = lane >> 4;
        const float* wp = p.ada_w + (size_t)l * DM * 6 * DM + (size_t)(w * 128 + kq) * 6 * DM + j0 + 4 * cg;
        for (int kk0 = 0; kk0 < 32; kk0 += 8) {
            f32x4 wv[8];
#pragma unroll
            for (int u = 0; u < 8; ++u) wv[u] = *(const f32x4*)(wp + (size_t)(kk0 + u) * 4 * 6 * DM);
            asm volatile("" ::: "memory");
#pragma unroll
            for (int u = 0; u < 8; ++u) { const int k = w * 128 + 4 * (kk0 + u) + kq;
#pragma unroll
                for (int r = 0; r < 9; ++r) a[r] += wv[u] * scv[r * DM + k]; }
        }
#pragma unroll
        for (int r = 0; r < 9; ++r)
#pragma unroll
            for (int c = 0; c < 4; ++c) { float t = a[r][c]; t += __shfl_xor(t, 16); t += __shfl_xor(t, 32); a[r][c] = t; }
        __syncthreads();
        if (kq == 0) {
#pragma unroll
            for (int r = 0; r < 9; ++r) *(f32x4*)(red + (w * 9 + r) * 64 + 4 * cg) = a[r];
        }
        __syncthreads();
        for (int idx = tid; idx < 9 * 64; idx += 512) { const int r = idx >> 6, ln = idx & 63; float sacc = 0.f;
#pragma unroll
            for (int ww = 0; ww < 8; ++ww) sacc += red[(ww * 9 + r) * 64 + ln];
            ((float*)(p.ws + WS_MOD))[((size_t)l * 9 + r) * 6 * DM + j0 + ln] = sacc + p.ada_b[(size_t)l * 6 * DM + j0 + ln]; }
    }
    if (blockIdx.x == gridDim.x - 1) {
        float* tab = (float*)(p.ws + WS_TAB);
        for (int idx = tid; idx < 2048; idx += 512) { const int pos = idx >> 5, i = idx & 31; const float inv = powf(10000.0f, -(float)i / 32.0f); const float ang = (float)pos * inv;
            tab[idx] = cosf(ang); tab[2048 + idx] = sinf(ang); }
    }
    __syncthreads();
}

__device__ __forceinline__ const float* xrow(const float* lat, const float* ctx, int m) { return m < NLAT ? lat + (size_t)m * DM : ctx + (size_t)(m - NLAT) * DM; }
__device__ void phase_norm(const Params& p, const float* xl, const float* xc, const float* g, const float* mod_l, int sh_off, int nrows,
                           const float* slab, const float* slab_gate) {
    const int tid_ = otid(); const int lane = tid_ & 63, gw = blockIdx.x * 8 + (tid_ >> 6), nw = gridDim.x * 8;
    bf16_t* H = (bf16_t*)(p.ws + WS_H);
    f32x4 nv[4], gg4[4];
#pragma unroll
    for (int i = 0; i < 4; ++i) { nv[i] = (f32x4){0.f, 0.f, 0.f, 0.f}; gg4[i] = *(const f32x4*)(g + 4 * lane + 256 * i); }
    if (gw < nrows) { const float* xr = xrow(xl, xc, gw);
#pragma unroll
        for (int i = 0; i < 4; ++i) nv[i] = *(const f32x4*)(xr + 4 * lane + 256 * i); }
    for (int m = gw; m < nrows; m += nw) {
        const int b = m < NLAT ? (m >> 12) : 8;
        const float* sh = mod_l + (size_t)b * 6 * DM + sh_off; const float* sc = sh + DM;
        f32x4 v[4]; float ss = 0.f;
#pragma unroll
        for (int i = 0; i < 4; ++i) v[i] = nv[i];
        if (m + nw < nrows) { const float* xr = xrow(xl, xc, m + nw);
#pragma unroll
            for (int i = 0; i < 4; ++i) nv[i] = *(const f32x4*)(xr + 4 * lane + 256 * i); }
        f32x4 sc4[4], sh4[4];
#pragma unroll
        for (int i = 0; i < 4; ++i) { sc4[i] = *(const f32x4*)(sc + 4 * lane + 256 * i); sh4[i] = *(const f32x4*)(sh + 4 * lane + 256 * i); }
        asm volatile("" ::: "memory");
#pragma unroll
        for (int i = 0; i < 4; ++i) {
            if (slab != nullptr && m >= NLAT) {
                u32x2 sr[NSPLIT]; f32x4 sl[NSPLIT];
#pragma unroll
                for (int ks = 0; ks < NSPLIT; ++ks) sr[ks] = *(const u32x2*)((const bf16_t*)slab + ((size_t)ks * NCTX + (m - NLAT)) * DM + 4 * lane + 256 * i);
#pragma unroll
                for (int ks = 0; ks < NSPLIT; ++ks) { sl[ks][0] = __uint_as_float(sr[ks].x << 16); sl[ks][1] = __uint_as_float(sr[ks].x & 0xffff0000u); sl[ks][2] = __uint_as_float(sr[ks].y << 16); sl[ks][3] = __uint_as_float(sr[ks].y & 0xffff0000u); }
                const f32x4 acc4 = ((sl[0] + sl[1]) + (sl[2] + sl[3])) + ((sl[4] + sl[5]) + (sl[6] + sl[7]));
                v[i] += *(const f32x4*)(slab_gate + 4 * lane + 256 * i) * acc4;
            }
            ss += v[i][0] * v[i][0] + v[i][1] * v[i][1] + v[i][2] * v[i][2] + v[i][3] * v[i][3]; }
#pragma unroll
        for (int o = 32; o >= 1; o >>= 1) ss += __shfl_xor(ss, o);
        const float rinv = rsqrtf(ss * (1.0f / DM) + 1e-6f);
#pragma unroll
        for (int i = 0; i < 4; ++i) { const int c = 4 * lane + 256 * i; const f32x4 gg = gg4[i], s1 = sc4[i], s0 = sh4[i];
            f32x4 y;
#pragma unroll
            for (int j = 0; j < 4; ++j) y[j] = (v[i][j] * rinv * gg[j]) * (1.f + s1[j]) + s0[j];
            u32x2 w2; w2.x = cvt_pk_bf16(y[0], y[1]); w2.y = cvt_pk_bf16(y[2], y[3]); *(u32x2*)(H + (size_t)m * DM + c) = w2; }
    }
}
__device__ void phase_final(const Params& p) {
    const int tid_ = otid(); const int lane = tid_ & 63, gw = blockIdx.x * 8 + (tid_ >> 6), nw = gridDim.x * 8;
    f32x4 nv[4], gg4[4];
#pragma unroll
    for (int i = 0; i < 4; ++i) { nv[i] = (f32x4){0.f, 0.f, 0.f, 0.f}; gg4[i] = *(const f32x4*)(p.final_g + 4 * lane + 256 * i); }
    if (gw < NLAT) {
#pragma unroll
        for (int i = 0; i < 4; ++i) nv[i] = *(const f32x4*)(p.out + (size_t)gw * DM + 4 * lane + 256 * i); }
    for (int m = gw; m < NLAT; m += nw) {
        float* xr = p.out + (size_t)m * DM;
        f32x4 v[4]; float ss = 0.f;
#pragma unroll
        for (int i = 0; i < 4; ++i) v[i] = nv[i];
        if (m + nw < NLAT) {
#pragma unroll
            for (int i = 0; i < 4; ++i) nv[i] = *(const f32x4*)(p.out + (size_t)(m + nw) * DM + 4 * lane + 256 * i); }
        asm volatile("" ::: "memory");
#pragma unroll
        for (int i = 0; i < 4; ++i) ss += v[i][0] * v[i][0] + v[i][1] * v[i][1] + v[i][2] * v[i][2] + v[i][3] * v[i][3];
#pragma unroll
        for (int o = 32; o >= 1; o >>= 1) ss += __shfl_xor(ss, o);
        const float rinv = rsqrtf(ss * (1.0f / DM) + 1e-6f);
#pragma unroll
        for (int i = 0; i < 4; ++i) { const int c = 4 * lane + 256 * i;
            f32x4 y;
#pragma unroll
            for (int j = 0; j < 4; ++j) y[j] = v[i][j] * rinv * gg4[i][j];
            *(f32x4*)(xr + c) = y; }
    }
}

__device__ void phase_merge(const Params& p, int l, int nrows) {
    const int tid_ = otid(); const int lane = tid_ & 63, gw = blockIdx.x * 8 + (tid_ >> 6), nw = gridDim.x * 8;
    bf16_t* H = (bf16_t*)(p.ws + WS_H); const bf16_t* OB = (const bf16_t*)(p.ws + WS_OB); const bf16_t* P = (const bf16_t*)(p.ws + WS_P);
    const bool isgla = lane >= 32;
    const int gcol = isgla ? (2560 + 16 * lane) : (1536 + 16 * lane);
    const float* gnp = p.gla_norm_g + l * 128 + ((16 * lane) & 127);
    float gn[16];
#pragma unroll
    for (int j = 0; j < 16; ++j) gn[j] = gnp[j];
    bf16x8 nf0, nf1, nb0, nb1, ng0, ng1;
    nf0 = nf1 = nb0 = nb1 = ng0 = ng1 = (bf16x8){0, 0, 0, 0, 0, 0, 0, 0};
#define MERGE_LOAD(mm) do { nf0 = *(const bf16x8*)(H + (size_t)(mm) * DM + 16 * lane); nf1 = *(const bf16x8*)(H + (size_t)(mm) * DM + 16 * lane + 8); \
        nb0 = *(const bf16x8*)(OB + (size_t)(mm) * DM + 16 * lane); nb1 = *(const bf16x8*)(OB + (size_t)(mm) * DM + 16 * lane + 8); \
        ng0 = *(const bf16x8*)(P + (size_t)(mm) * INW + gcol); ng1 = *(const bf16x8*)(P + (size_t)(mm) * INW + gcol + 8); } while (0)
    if (gw < nrows) MERGE_LOAD(gw);
    for (int m = gw; m < nrows; m += nw) {
        const bf16x8 f0 = nf0, f1 = nf1, b0 = nb0, b1 = nb1, g0 = ng0, g1 = ng1;
        if (m + nw < nrows) MERGE_LOAD(m + nw);
        asm volatile("" ::: "memory");
        float r[16]; float s1 = 0.f, s2 = 0.f;
#pragma unroll
        for (int j = 0; j < 8; ++j) { r[j] = bf2f(f0[j]) + bf2f(b0[j]); r[8 + j] = bf2f(f1[j]) + bf2f(b1[j]); }
#ifdef SANITIZE
#pragma unroll
        for (int j = 0; j < 16; ++j) { if (!(fabsf(r[j]) < 1e30f)) r[j] = 0.f; }
#endif
#ifdef SKIP_GLA
        if (isgla) {
#pragma unroll
            for (int j = 0; j < 16; ++j) r[j] = 0.f; }
#endif
#ifdef SKIP_RET
        if (!isgla) {
#pragma unroll
            for (int j = 0; j < 16; ++j) r[j] = 0.f; }
#endif
#pragma unroll
        for (int j = 0; j < 16; ++j) { s1 += r[j]; s2 += r[j] * r[j]; }
#pragma unroll
        for (int o = 1; o <= 4; o <<= 1) { s1 += __shfl_xor(s1, o); s2 += __shfl_xor(s2, o); }
        float y[16];
        if (!isgla) {
            const float mu = s1 * (1.f / 128.f); float sv = 0.f;
#pragma unroll
            for (int j = 0; j < 16; ++j) { const float d = r[j] - mu; sv += d * d; }
#pragma unroll
            for (int o = 1; o <= 4; o <<= 1) sv += __shfl_xor(sv, o);
            const float rs = rsqrtf(sv * (1.f / 128.f) + 1e-6f);
#pragma unroll
            for (int j = 0; j < 16; ++j) y[j] = (r[j] - mu) * rs;
        } else {
            float sv = 0.f;
#pragma unroll
            for (int o = 1; o <= 4; o <<= 1) sv += __shfl_xor(sv, o);
            const float rs = rsqrtf(s2 * (1.f / 128.f) + 1e-6f);
#pragma unroll
            for (int j = 0; j < 16; ++j) y[j] = r[j] * rs * gn[j] + 0.f * sv;
        }
        u32x4 o0, o1;
#pragma unroll
        for (int j = 0; j < 8; ++j) { y[j] *= silu_f(bf2f(g0[j])); y[8 + j] *= silu_f(bf2f(g1[j])); }
        o0.x = cvt_pk_bf16(y[0], y[1]); o0.y = cvt_pk_bf16(y[2], y[3]); o0.z = cvt_pk_bf16(y[4], y[5]); o0.w = cvt_pk_bf16(y[6], y[7]);
        o1.x = cvt_pk_bf16(y[8], y[9]); o1.y = cvt_pk_bf16(y[10], y[11]); o1.z = cvt_pk_bf16(y[12], y[13]); o1.w = cvt_pk_bf16(y[14], y[15]);
        *(u32x4*)(H + (size_t)m * DM + 16 * lane) = o0; *(u32x4*)(H + (size_t)m * DM + 16 * lane + 8) = o1;
    }
}

#undef MERGE_LOAD
template <int DK, bool GLA>
__device__ __forceinline__ void scan_item(const Params& p, int l, unsigned char* lds, LAS unsigned char* lds3, int b, int h, int dir, int dvs) {
    constexpr int QS = DK + 8, TS = 72, NT = DK / 32, NKS = DK / 32;
    bf16_t* QD = (bf16_t*)lds;
    bf16_t* KI = QD + 64 * QS;
    bf16_t* ST = KI + 64 * QS;
    bf16_t* VR = ST + 64 * QS;
    bf16_t* SC = VR + 64 * TS;
    constexpr int KI_B = 64 * QS * 2, VR_B = 3 * 64 * QS * 2;
    float* DVEC = (float*)(SC + 64 * TS);
    float* CL = DVEC + DK;
    float* CUM = CL + DK;
    float* UP = CUM + 2 * 64 * 68;
    const int tid = otid(), lane = tid & 63, w = __builtin_amdgcn_readfirstlane(tid >> 6), fr = lane & 15, fq = lane >> 4;
    const bf16_t* P = (const bf16_t*)(p.ws + WS_P);
    bf16_t* O = (bf16_t*)(p.ws + (dir ? WS_OB : WS_H));
    const float* TABC = (const float*)(p.ws + WS_TAB); const float* TABS = TABC + 2048;
    const int ocol = (GLA ? 512 : 0) + 128 * h + 64 * dvs;
    const int qcol = GLA ? 2048 + 64 * h : 128 * h, kcol = GLA ? 2304 + 64 * h : 512 + 128 * h, vcol = (GLA ? 2560 : 1024) + 128 * h + 64 * dvs;
    float g = 0.f;
    if (!GLA) g = log1pf(-__expf(p.ret_decay[l * 8 + dir * 4 + h]));
    constexpr int NDK = DK / 64;
    const int dkt0 = NDK * (w >> 1), dvt0 = 2 * (w & 1);
    f32x4 S[NT];
#pragma unroll
    for (int i = 0; i < NT; ++i) S[i] = (f32x4){0.f, 0.f, 0.f, 0.f};
    __syncthreads();
    for (int i = tid; i < 64 * QS / 2; i += 512) ((unsigned*)ST)[i] = 0u;
    bf16x8 uph[2], upl[2]; float ubv[2];
    uph[0] = uph[1] = upl[0] = upl[1] = (bf16x8){0, 0, 0, 0, 0, 0, 0, 0}; ubv[0] = ubv[1] = 0.f;
    float* TT = UP;
    if (GLA) {
#pragma unroll
        for (int ci = 0; ci < 2; ++ci) {
            const int ch = 16 * (2 * (w & 1) + ci) + fr;
#pragma unroll
            for (int j = 0; j < 8; ++j) {
                const float val = (fq < 2) ? p.gate_up[((size_t)(l * 2 + dir) * 16 + 8 * fq + j) * 256 + 64 * h + ch] : 0.f;
                const bf16_t hi = f2bf(val); const float rem = val - bf2f((short)hi);
                uph[ci][j] = (short)hi; upl[ci][j] = (short)f2bf(rem);
            }
            ubv[ci] = p.gate_b[(l * 2 + dir) * 256 + 64 * h + ch];
        }
    } else {
        if (tid < DK) DVEC[tid] = __expf(64.f * g);
    }
    __syncthreads();
    const int s_a = tid >> 3, pr = tid & 7, c8a = (pr & 3) + 8 * (pr >> 2), c8g = tid & 7;
    bf16x8 nq1, nq2, nk1, nk2, nv1, nd0, nd1; f32x4 nc0, nc1, ns0, ns1;
    nq2 = nq1 = nk1 = nk2 = nv1 = nd0 = nd1 = (bf16x8){0, 0, 0, 0, 0, 0, 0, 0}; nc0 = nc1 = ns0 = ns1 = (f32x4){0.f, 0.f, 0.f, 0.f};
#define SCAN_STEP_GEOM(stp, isctx_, chunk_, m0_) \
    const bool isctx_ = (stp) < 4; \
    const int chunk_ = dir == 0 ? (isctx_ ? (stp) : (stp) - 4) : (isctx_ ? 3 - (stp) : 67 - (stp)); \
    const int m0_ = isctx_ ? (NLAT + b * CTXL + chunk_ * 64) : (b * SEQ + chunk_ * 64);
#define SCAN_ISSUE(stp) do { SCAN_STEP_GEOM(stp, ic_, ch_, mm_) \
        const bf16_t* rp_ = P + (size_t)(mm_ + s_a) * INW; \
        if (GLA) { \
            nq1 = *(const bf16x8*)(rp_ + qcol + 8 * c8g); nk1 = *(const bf16x8*)(rp_ + kcol + 8 * c8g); } \
        else { nq1 = *(const bf16x8*)(rp_ + qcol + 8 * c8a); nq2 = *(const bf16x8*)(rp_ + qcol + 8 * (c8a + 4)); \
            nk1 = *(const bf16x8*)(rp_ + kcol + 8 * c8a); nk2 = *(const bf16x8*)(rp_ + kcol + 8 * (c8a + 4)); \
            const int pos_ = ic_ ? 0 : ((pr >> 2) ? s_a : ch_); \
            nc0 = *(const f32x4*)(TABC + pos_ * 32 + 8 * (pr & 3)); nc1 = *(const f32x4*)(TABC + pos_ * 32 + 8 * (pr & 3) + 4); \
            ns0 = *(const f32x4*)(TABS + pos_ * 32 + 8 * (pr & 3)); ns1 = *(const f32x4*)(TABS + pos_ * 32 + 8 * (pr & 3) + 4); } \
        nv1 = *(const bf16x8*)(rp_ + vcol + 8 * c8g); } while (0)
#define SCAN_ISSUE_D(stp) do { SCAN_STEP_GEOM(stp, icd_, chd_, mmd_) (void)chd_; \
        if (GLA && fq < 2) { const bf16_t* dp_ = P + (size_t)(mmd_ + 16 * (w >> 1) + fr) * INW + 3584 + 16 * dir + 8 * fq; nd0 = *(const bf16x8*)dp_; } } while (0)
    auto gate_stage = [&](const bf16x8 dfrag, float* CUMb, float* TTb) {
        const int st = w >> 1;
#pragma unroll
        for (int ci = 0; ci < 2; ++ci) {
            const int ch = 16 * (2 * (w & 1) + ci) + fr;
            f32x4 z = __builtin_amdgcn_mfma_f32_16x16x32_bf16(dfrag, uph[ci], (f32x4){0.f, 0.f, 0.f, 0.f}, 0, 0, 0);
            z = __builtin_amdgcn_mfma_f32_16x16x32_bf16(dfrag, upl[ci], z, 0, 0, 0);
            float la[4], pz[4];
#pragma unroll
            for (int r = 0; r < 4; ++r) { const float zz = z[r] + ubv[ci]; la[r] = (fminf(zz, 0.f) - __logf(1.f + __expf(-fabsf(zz)))) * (1.0f / 16.0f); }
            float T, ex = 0.f;
            if (dir == 0) {
                pz[0] = la[0]; pz[1] = pz[0] + la[1]; pz[2] = pz[1] + la[2]; pz[3] = pz[2] + la[3]; T = pz[3];
                const float t1 = __shfl_up(T, 16), t2 = __shfl_up(T, 32), t3 = __shfl_up(T, 48);
                if (fq >= 1) ex += t1; if (fq >= 2) ex += t2; if (fq >= 3) ex += t3;
            } else {
                pz[3] = la[3]; pz[2] = pz[3] + la[2]; pz[1] = pz[2] + la[1]; pz[0] = pz[1] + la[0]; T = pz[0];
                const float t1 = __shfl_down(T, 16), t2 = __shfl_down(T, 32), t3 = __shfl_down(T, 48);
                if (fq <= 2) ex += t1; if (fq <= 1) ex += t2; if (fq == 0) ex += t3;
            }
            const float ttot = __shfl(T + ex, dir == 0 ? 48 + fr : fr);
#pragma unroll
            for (int r = 0; r < 4; ++r) CUMb[(16 * st + 4 * fq + r) * 68 + ch] = pz[r] + ex;
            if (fq == 0) TTb[st * 64 + ch] = ttot;
        }
    };
    SCAN_ISSUE(0);
    if (GLA) {
        SCAN_ISSUE_D(0);
        const bf16x8 dfirst = nd0;
        SCAN_ISSUE_D(1);
        gate_stage(dfirst, CUM, TT);
        __syncthreads();
    }
    for (int step = 0; step < 68; ++step) {
        SCAN_STEP_GEOM(step, isctx, chunk, m0)
        const bf16x8 q1 = nq1, q2 = nq2, k1 = nk1, k2 = nk2, v1 = nv1, d0 = nd0, d1 = nd1; const f32x4 tc0 = nc0, tc1 = nc1, ts0 = ns0, ts1 = ns1;
        { const int nstep = step + 1 < 68 ? step + 1 : 67; SCAN_ISSUE(nstep); }
        if (GLA) { const int dstep = step + 2 < 68 ? step + 2 : 67; SCAN_ISSUE_D(dstep); }
        (void)chunk; (void)d1;
        float* CUMc = CUM + (step & 1) * 64 * 68; float* TTc = TT + (step & 1) * 256;
        {
            const int s = s_a;
            if (!GLA) {
                const float cum = dir == 0 ? g * (float)(s + 1) : g * (float)(64 - s), cl = 64.f * g;
                const float eq = __expf(cum) * 0.08838834764831845f, eki = __expf(-cum); (void)cl;
                float cs[8], sn[8];
#pragma unroll
                for (int j = 0; j < 4; ++j) { cs[j] = isctx ? 1.f : tc0[j]; cs[4 + j] = isctx ? 1.f : tc1[j]; sn[j] = isctx ? 0.f : ts0[j]; sn[4 + j] = isctx ? 0.f : ts1[j]; }
                float qa[8], qb[8], ka[8], kb[8];
#pragma unroll
                for (int j = 0; j < 8; ++j) {
                    const float a1 = bf2f(q1[j]), a2 = bf2f(q2[j]), b1 = bf2f(k1[j]), b2 = bf2f(k2[j]);
                    qa[j] = a1 * cs[j] - a2 * sn[j]; qb[j] = a1 * sn[j] + a2 * cs[j];
                    ka[j] = b1 * cs[j] - b2 * sn[j]; kb[j] = b1 * sn[j] + b2 * cs[j];
                }
                u32x4 o;
                o.x = cvt_pk_bf16(qa[0] * eq, qa[1] * eq); o.y = cvt_pk_bf16(qa[2] * eq, qa[3] * eq); o.z = cvt_pk_bf16(qa[4] * eq, qa[5] * eq); o.w = cvt_pk_bf16(qa[6] * eq, qa[7] * eq);
                *(u32x4*)(QD + s * QS + 8 * c8a) = o;
                o.x = cvt_pk_bf16(qb[0] * eq, qb[1] * eq); o.y = cvt_pk_bf16(qb[2] * eq, qb[3] * eq); o.z = cvt_pk_bf16(qb[4] * eq, qb[5] * eq); o.w = cvt_pk_bf16(qb[6] * eq, qb[7] * eq);
                *(u32x4*)(QD + s * QS + 8 * (c8a + 4)) = o;
                o.x = cvt_pk_bf16(ka[0] * eki, ka[1] * eki); o.y = cvt_pk_bf16(ka[2] * eki, ka[3] * eki); o.z = cvt_pk_bf16(ka[4] * eki, ka[5] * eki); o.w = cvt_pk_bf16(ka[6] * eki, ka[7] * eki);
                *(u32x4*)(KI + s * QS + 8 * c8a) = o;
                o.x = cvt_pk_bf16(kb[0] * eki, kb[1] * eki); o.y = cvt_pk_bf16(kb[2] * eki, kb[3] * eki); o.z = cvt_pk_bf16(kb[4] * eki, kb[5] * eki); o.w = cvt_pk_bf16(kb[6] * eki, kb[7] * eki);
                *(u32x4*)(KI + s * QS + 8 * (c8a + 4)) = o;
            } else {
                const int c8 = c8g;
                f32x4 cu0 = *(const f32x4*)(CUMc + s * 68 + 8 * c8), cu1 = *(const f32x4*)(CUMc + s * 68 + 8 * c8 + 4);
                {
                    const int stile = w >> 1;
#pragma unroll
                    for (int t4 = 0; t4 < 4; ++t4) {
                        const bool inc = dir == 0 ? (t4 < stile) : (t4 > stile);
                        if (inc) { cu0 += *(const f32x4*)(TTc + t4 * 64 + 8 * c8); cu1 += *(const f32x4*)(TTc + t4 * 64 + 8 * c8 + 4); }
                    }
                }
                if (s == 0) {
                    f32x4 cl0 = (f32x4){0.f, 0.f, 0.f, 0.f}, cl1 = cl0;
#pragma unroll
                    for (int t4 = 0; t4 < 4; ++t4) { cl0 += *(const f32x4*)(TTc + t4 * 64 + 8 * c8); cl1 += *(const f32x4*)(TTc + t4 * 64 + 8 * c8 + 4); }
#pragma unroll
                    for (int j = 0; j < 4; ++j) { DVEC[8 * c8 + j] = __expf(cl0[j]); DVEC[8 * c8 + 4 + j] = __expf(cl1[j]); }
                }
                float qd[8], ki[8];
#pragma unroll
                for (int j = 0; j < 8; ++j) {
                    const float cu = j < 4 ? cu0[j & 3] : cu1[j & 3];
                    const float e = __expf(cu);
                    qd[j] = bf2f(q1[j]) * (0.125f * e); ki[j] = bf2f(k1[j]) * __builtin_amdgcn_rcpf(e);
                }
                u32x4 o;
                o.x = cvt_pk_bf16(qd[0], qd[1]); o.y = cvt_pk_bf16(qd[2], qd[3]); o.z = cvt_pk_bf16(qd[4], qd[5]); o.w = cvt_pk_bf16(qd[6], qd[7]);
                *(u32x4*)(QD + s * QS + 8 * c8) = o;
                o.x = cvt_pk_bf16(ki[0], ki[1]); o.y = cvt_pk_bf16(ki[2], ki[3]); o.z = cvt_pk_bf16(ki[4], ki[5]); o.w = cvt_pk_bf16(ki[6], ki[7]);
                *(u32x4*)(KI + s * QS + 8 * c8) = o;
            }
            *(bf16x8*)(VR + s * TS + 8 * c8g) = v1;
        }
        __syncthreads();
        bf16x8 qf[NKS];
        {
            const int tt = w >> 1;
#pragma unroll
            for (int ks = 0; ks < NKS; ++ks) qf[ks] = *(const bf16x8*)(QD + (16 * tt + fr) * QS + 32 * ks + 8 * fq);
#pragma unroll
            for (int si = 0; si < 2; ++si) {
                const int st = 2 * (w & 1) + si;
                f32x4 acc = (f32x4){0.f, 0.f, 0.f, 0.f};
#pragma unroll
                for (int ks = 0; ks < NKS; ++ks) {
                    const bf16x8 a = *(const bf16x8*)(KI + (16 * st + fr) * QS + 32 * ks + 8 * fq);
                    acc = __builtin_amdgcn_mfma_f32_16x16x32_bf16(a, qf[ks], acc, 0, 0, 0);
                }
                const int t = 16 * tt + fr, s0 = 16 * st + 4 * fq;
                float v[4];
#pragma unroll
                for (int r = 0; r < 4; ++r) { const int s = s0 + r; const bool keep = dir == 0 ? (s <= t) : (s > t); v[r] = keep ? acc[r] : 0.f; }
                u32x2 w2; w2.x = cvt_pk_bf16(v[0], v[1]); w2.y = cvt_pk_bf16(v[2], v[3]);
                *(u32x2*)(SC + t * TS + s0) = w2;
            }
        }
        __syncthreads();
        if (GLA && step + 1 < 68) gate_stage(d0, CUM + ((step + 1) & 1) * 64 * 68, TT + ((step + 1) & 1) * 256);
        {
            const int tt = w >> 1;
            bf16x8 scf[2], kitf[NDK][2], vtf[2][2];
            const int trow = 8 * fq + (fr >> 2), tcol = 4 * (fr & 3);
#pragma unroll
            for (int ks = 0; ks < 2; ++ks) {
                scf[ks] = *(const bf16x8*)(SC + (16 * tt + fr) * TS + 32 * ks + 8 * fq);
#pragma unroll
                for (int a = 0; a < NDK; ++a) {
                    const s16x4 lo = __builtin_amdgcn_ds_read_tr16_b64_v4i16((LAS s16x4*)(lds3 + KI_B + ((32 * ks + trow) * QS + 16 * (dkt0 + a) + tcol) * 2));
                    const s16x4 hi = __builtin_amdgcn_ds_read_tr16_b64_v4i16((LAS s16x4*)(lds3 + KI_B + ((32 * ks + 4 + trow) * QS + 16 * (dkt0 + a) + tcol) * 2));
                    kitf[a][ks] = __builtin_shufflevector(lo, hi, 0, 1, 2, 3, 4, 5, 6, 7);
                }
#pragma unroll
                for (int c = 0; c < 2; ++c) {
                    const s16x4 lo = __builtin_amdgcn_ds_read_tr16_b64_v4i16((LAS s16x4*)(lds3 + VR_B + ((32 * ks + trow) * TS + 16 * (dvt0 + c) + tcol) * 2));
                    const s16x4 hi = __builtin_amdgcn_ds_read_tr16_b64_v4i16((LAS s16x4*)(lds3 + VR_B + ((32 * ks + 4 + trow) * TS + 16 * (dvt0 + c) + tcol) * 2));
                    vtf[c][ks] = __builtin_shufflevector(lo, hi, 0, 1, 2, 3, 4, 5, 6, 7);
                }
            }
#pragma unroll
            for (int di = 0; di < 2; ++di) {
                const int dvt = dvt0 + di;
                f32x4 acc = (f32x4){0.f, 0.f, 0.f, 0.f};
#pragma unroll
                for (int ks = 0; ks < 2; ++ks) acc = __builtin_amdgcn_mfma_f32_16x16x32_bf16(vtf[di][ks], scf[ks], acc, 0, 0, 0);
#pragma unroll
                for (int ks = 0; ks < NKS; ++ks) {
                    const bf16x8 a = *(const bf16x8*)(ST + (16 * dvt + fr) * QS + 32 * ks + 8 * fq);
                    acc = __builtin_amdgcn_mfma_f32_16x16x32_bf16(a, qf[ks], acc, 0, 0, 0);
                }
                u32x2 w2; w2.x = cvt_pk_bf16(acc[0], acc[1]); w2.y = cvt_pk_bf16(acc[2], acc[3]);
                *(u32x2*)(O + (size_t)(m0 + 16 * tt + fr) * DM + ocol + 16 * dvt + 4 * fq) = w2;
            }
#pragma unroll
            for (int a = 0; a < NDK; ++a) {
                const f32x4 dv4 = *(const f32x4*)(DVEC + 16 * (dkt0 + a) + 4 * fq);
#pragma unroll
                for (int c = 0; c < 2; ++c) {
#pragma unroll
                    for (int ks = 0; ks < 2; ++ks) S[a * 2 + c] = __builtin_amdgcn_mfma_f32_16x16x32_bf16(kitf[a][ks], vtf[c][ks], S[a * 2 + c], 0, 0, 0);
                    S[a * 2 + c] = S[a * 2 + c] * dv4;
                }
            }
        }
        __syncthreads();
#pragma unroll
        for (int a = 0; a < NDK; ++a)
#pragma unroll
            for (int c = 0; c < 2; ++c) {
                u32x2 w2; w2.x = cvt_pk_bf16(S[a * 2 + c][0], S[a * 2 + c][1]); w2.y = cvt_pk_bf16(S[a * 2 + c][2], S[a * 2 + c][3]);
                *(u32x2*)(ST + (16 * (dvt0 + c) + fr) * QS + 16 * (dkt0 + a) + 4 * fq) = w2;
            }
    }
    __syncthreads();
#undef SCAN_STEP_GEOM
#undef SCAN_ISSUE
#undef SCAN_ISSUE_D
}
__device__ void phase_scan(const Params& p, int l, unsigned char* lds) {
    for (int it = blockIdx.x; it < 256; it += gridDim.x) {
        const int isgla = it & 1, r = it >> 1;
        const int dvs = r & 1, dir = (r >> 1) & 1, h = (r >> 2) & 3, b = r >> 4;
#ifdef SKIP_GLA
        if (isgla) continue;
#endif
#ifdef SKIP_RET
        if (!isgla) continue;
#endif
        if (isgla) scan_item<64, true>(p, l, lds, (LAS unsigned char*)lds, b, h, dir, dvs);
        else scan_item<128, false>(p, l, lds, (LAS unsigned char*)lds, b, h, dir, dvs);
    }
}

#define XB_TMO      128
#define XB_XCNT(j)  (256  + 64 * (j))
#define XB_XSUB(j)  (1280 + 64 * (j))
#define XB_XGEN(j)  (2304 + 64 * (j))
#define XB_TOP      3328
#define XB_TOPGEN   3392
#define XCD_BAR_WORDS 3456
#define XB_SPIN_CAP (1u << 20)
__device__ __forceinline__ unsigned xb_ld(unsigned* p)              { return __hip_atomic_load(p, __ATOMIC_RELAXED, __HIP_MEMORY_SCOPE_AGENT); }
__device__ __forceinline__ unsigned xb_add(unsigned* p, unsigned v) { return __hip_atomic_fetch_add(p, v, __ATOMIC_RELAXED, __HIP_MEMORY_SCOPE_AGENT); }
__device__ __forceinline__ unsigned xb_xcc_id() { return (unsigned)__builtin_amdgcn_s_getreg((3 << 11) | 20) & 0xFu; }
#define XB_SPIN(cond, bar) do { unsigned _sp = 0; while (cond) { __builtin_amdgcn_s_sleep(1); \
    if ((++_sp & 255u) == 0u) { if (xb_ld(&(bar)[XB_TMO])) break; if (_sp > XB_SPIN_CAP) { atomicAdd(&(bar)[XB_TMO], 1u); break; } } } } while (0)
struct XcdBarrier { unsigned* bar; unsigned x; volatile LAS unsigned* st; };
__device__ __forceinline__ XcdBarrier xcd_barrier_post(unsigned* bar, volatile LAS unsigned* st) {
    XcdBarrier b; b.bar = bar; b.x = xb_xcc_id(); b.st = st;
    if (threadIdx.x == 0) (void)xb_add(&bar[XB_XCNT(b.x)], 1u);
    return b;
}
__device__ __forceinline__ void xcd_barrier_complete(unsigned* bar, unsigned x, unsigned& nloc, unsigned& nx) {
    const unsigned G = gridDim.x * gridDim.y * gridDim.z;
    unsigned sum, cnt, mine, sp = 0u;
    for (;;) {
        sum = 0u; cnt = 0u; mine = 0u;
#pragma unroll
        for (unsigned j = 0; j < 16; ++j) { const unsigned c = xb_ld(&bar[XB_XCNT(j)]); sum += c; cnt += (c > 0u) ? 1u : 0u; mine = (j == x) ? c : mine; }
        if (sum == G) break;
        __builtin_amdgcn_s_sleep(1);
        if ((++sp & 255u) == 0u) { if (xb_ld(&bar[XB_TMO])) break; if (sp > XB_SPIN_CAP) { atomicAdd(&bar[XB_TMO], 1u); break; } }
    }
    nloc = mine > 0u ? mine : 1u; nx = cnt > 0u ? cnt : 1u;
}
__device__ __forceinline__ void xcd_barrier(const XcdBarrier& b) {
    asm volatile("s_waitcnt vmcnt(0)" ::: "memory");
    __syncthreads();
    if (threadIdx.x == 0) {
        unsigned* bar = b.bar;
        __builtin_amdgcn_s_waitcnt(0);
        unsigned nloc = b.st[0], nx = b.st[1];
        if (nloc == 0u) { xcd_barrier_complete(bar, b.x, nloc, nx); b.st[0] = nloc; b.st[1] = nx; }
        const unsigned old = xb_add(&bar[XB_XSUB(b.x)], 1u);
        const unsigned gen = old / nloc;
        if (old + 1u == (gen + 1u) * nloc) {
            __builtin_amdgcn_fence(__ATOMIC_RELEASE, "agent");
            asm volatile("s_waitcnt vmcnt(0)" ::: "memory");
            const unsigned og = xb_add(&bar[XB_TOP], 1u);
            const unsigned tg = og / nx;
            if (og + 1u == (tg + 1u) * nx) xb_add(&bar[XB_TOPGEN], 1u);
            else XB_SPIN(xb_ld(&bar[XB_TOPGEN]) == tg, bar);
            __builtin_amdgcn_fence(__ATOMIC_ACQUIRE, "agent");
            xb_add(&bar[XB_XGEN(b.x)], 1u);
            asm volatile("s_waitcnt vmcnt(0)" ::: "memory");
        } else {
            XB_SPIN(xb_ld(&bar[XB_XGEN(b.x)]) == gen, bar);
            __builtin_amdgcn_fence(__ATOMIC_ACQUIRE, "agent");
            asm volatile("s_waitcnt vmcnt(0)" ::: "memory");
        }
    }
    __syncthreads();
}

__global__ void __launch_bounds__(512, 2) fwd_megakernel(Params p) {
    extern __shared__ __attribute__((aligned(16))) unsigned char shm[];
    cg::grid_group grid = cg::this_grid();
    const float* MOD = (const float*)(p.ws + WS_MOD);
    volatile LAS unsigned* xst = (volatile LAS unsigned*)((LAS unsigned char*)shm + 131072);
    if (threadIdx.x == 0) { xst[0] = 0u; xst[1] = 0u; xst[2] = 0u; xst[3] = 0u; }
    __syncthreads();
    const XcdBarrier xbar = xcd_barrier_post((unsigned*)(p.ws + WS_BAR), xst);
    for (int ph = p.ph_lo; ph < p.ph_hi; ++ph) {
        if (ph == 0) phase_prep(p, shm);
        else if (ph == NPHASE - 1) phase_final(p);
        else {
            const int l = (ph - 1) >> 3, sub = (ph - 1) & 7;
            const float* mod_l = MOD + (size_t)l * 9 * 6 * DM;
            const float* xin_lat = l == 0 ? p.x : p.out; const float* xin_ctx = l == 0 ? p.ctx : (const float*)(p.ws + WS_XCTX);
            float* xo_lat = p.out; float* xo_ctx = (float*)(p.ws + WS_XCTX);
            const int mrows = l == 0 ? MTOT : NLAT;
            bf16_t* H = (bf16_t*)(p.ws + WS_H); bf16_t* Pm = (bf16_t*)(p.ws + WS_P);
            pg8::StaticOrder S;
            if (sub == 0) phase_norm(p, xin_lat, xin_ctx, p.norm1_g + l * DM, mod_l, 0, MTOT, l == 1 ? (const float*)(p.ws + WS_SLAB) : nullptr, MOD + 8 * 6 * DM + 5 * DM);
#ifndef NO_G1
            else if (sub == 1) { pg8::Gemm g{H, (const bf16_t*)(p.ws + WS_WIN) + (size_t)l * INWP * DM, MTOT, INWP, DM, DM}; S.init(g.M, g.N, gridDim.x, blockIdx.x);
                EpiP E{Pm}; pg8::gemm_phase(( LAS unsigned char*)shm, g, S, E); }
#endif
#ifndef NO_SCAN
            else if (sub == 2) phase_scan(p, l, shm);
#endif
            else if (sub == 3) phase_merge(p, l, mrows);
#ifndef NO_G2
            else if (sub == 4) { pg8::Gemm g{H, (const bf16_t*)(p.ws + WS_WOUT) + (size_t)l * DM * DM, mrows, DM, DM, DM}; S.init(g.M, g.N, gridDim.x, blockIdx.x);
                EpiRes E{xin_lat, xin_ctx, xo_lat, xo_ctx, mod_l + 2 * DM}; pg8::gemm_phase((LAS unsigned char*)shm, g, S, E);
                if (l == 0) {
                    const int nbusy = (MTOT / 256) * (DM / 256) - 2 * (int)gridDim.x;
                    if (nbusy < 0 || (int)gridDim.x - nbusy < 32) convert_weights(p, shm, NT_EARLY, 2 * NT_LAYER, blockIdx.x, gridDim.x);
                    else if ((int)blockIdx.x >= nbusy) convert_weights(p, shm, NT_EARLY, 2 * NT_LAYER, (int)blockIdx.x - nbusy, (int)gridDim.x - nbusy);
                } }
#endif
            else if (sub == 5) phase_norm(p, xo_lat, xo_ctx, p.norm2_g + l * DM, mod_l, 3 * DM, mrows, nullptr, nullptr);
#ifndef NO_G3
            else if (sub == 6) { pg8::Gemm g{H, (const bf16_t*)(p.ws + WS_W1) + (size_t)l * DFF * DM, mrows, DFF, DM, DM}; S.init(g.M, g.N, gridDim.x, blockIdx.x);
                EpiRelu2 E{Pm}; pg8::gemm_phase((LAS unsigned char*)shm, g, S, E); }
#endif
#ifndef NO_G4
            else if (sub == 7) { pg8::Gemm g{Pm, (const bf16_t*)(p.ws + WS_W2) + (size_t)l * DM * DFF, NLAT, DM, DFF, DFF}; S.init(g.M, g.N, gridDim.x, blockIdx.x);
                EpiRes E{xo_lat, xo_ctx, xo_lat, xo_ctx, mod_l + 5 * DM}; pg8::gemm_phase((LAS unsigned char*)shm, g, S, E);
                if (l == 0) {
                    pg8::Gemm g2{Pm + (size_t)NLAT * DFF, g.Bt, NCTX, DM, DFF / NSPLIT, DFF};
                    pg8::SplitOrder<NSPLIT, DFF / NSPLIT> S2; S2.G = gridDim.x; S2.c = blockIdx.x;
                    EpiSlab E2{(bf16_t*)(p.ws + WS_SLAB), NCTX}; pg8::gemm_phase((LAS unsigned char*)shm, g2, S2, E2);
                } }
#endif
        }
        if (ph + 1 < p.ph_hi) {
            if (p.ph_hi > NPHASE) grid.sync();
            xcd_barrier(xbar);
        }
    }
}

extern "C" void kernel_launch(void* const* d_in, const int* in_sizes, int n_in, void* d_out, int out_size, void* d_ws, size_t ws_size, hipStream_t stream) {
    static int grid_blocks = 0;
    if (!grid_blocks) {
        int dev = 0, cus = 0, per_cu = 0;
        hipGetDevice(&dev);
        hipDeviceGetAttribute(&cus, hipDeviceAttributeMultiprocessorCount, dev);
        if (hipFuncSetAttribute((const void*)fwd_megakernel, hipFuncAttributeMaxDynamicSharedMemorySize, LDS_BYTES) != hipSuccess) fprintf(stderr, "hipFuncSetAttribute failed\n");
        if (hipOccupancyMaxActiveBlocksPerMultiprocessor(&per_cu, (const void*)fwd_megakernel, 512, LDS_BYTES) != hipSuccess || per_cu < 1) { fprintf(stderr, "occupancy query: %d\n", per_cu); per_cu = 1; }
        (void)hipGetLastError();
        grid_blocks = cus * per_cu;
        if (ws_size < WS_SLAB + (size_t)NSPLIT * NCTX * DM * 4) fprintf(stderr, "workspace too small: %zu < %zu\n", ws_size, (size_t)WS_END);
    }
    Params p{};
    p.x = (const float*)d_in[0]; p.c = (const float*)d_in[1]; p.ctx = (const float*)d_in[2]; p.c_ctx = (const float*)d_in[3]; p.ada_w = (const float*)d_in[4];
    p.ada_b = (const float*)d_in[5]; p.norm1_g = (const float*)d_in[6]; p.w_in = (const float*)d_in[7]; p.ret_decay = (const float*)d_in[8];
    p.gate_up = (const float*)d_in[9]; p.gate_b = (const float*)d_in[10]; p.gla_norm_g = (const float*)d_in[11]; p.w_out = (const float*)d_in[12];
    p.norm2_g = (const float*)d_in[13]; p.w_mlp1 = (const float*)d_in[14]; p.w_mlp2 = (const float*)d_in[15]; p.final_g = (const float*)d_in[16];
    p.out = (float*)d_out; p.ws = (unsigned char*)d_ws;
    if (hipMemsetAsync((unsigned char*)d_ws + WS_BAR, 0, BAR_BYTES, stream) != hipSuccess) fprintf(stderr, "memset of barrier words failed\n");
#if MULTI
    for (int ph = 0; ph < NPHASE; ++ph) {
        p.ph_lo = ph; p.ph_hi = ph + 1;
        hipLaunchKernelGGL(fwd_megakernel, dim3(grid_blocks), dim3(512), LDS_BYTES, stream, p);
    }
#else
    p.ph_lo = 0; p.ph_hi = NPHASE;
    void* args[] = {&p};
    hipError_t e = hipLaunchCooperativeKernel((const void*)fwd_megakernel, dim3(grid_blocks), dim3(512), args, LDS_BYTES, stream);
    if (e != hipSuccess) fprintf(stderr, "cooperative launch failed: %s (grid %d)\n", hipGetErrorString(e), grid_blocks);
#endif
}
```
